# Optimizing an MI355X kernel written in HIP

```python
import jax, jax.numpy as jnp
from jax import lax
import numpy as np

D_MODEL = 2048
BATCH = 2
SEQ = 8192
DEPTH = 1

CHUNK = 64
D_BRANCH = D_MODEL // 2
HEAD_DIM = 64
RWKV_HEADS = D_BRANCH // HEAD_DIM
ATTN_HEADS = D_BRANCH // HEAD_DIM
LORA_DECAY = 64
LORA_ICLR = 64
DECAY_SCALE = 0.606531
PAST_CHUNKS = 8
PAST = PAST_CHUNKS * CHUNK
BAND = (PAST_CHUNKS + 1) * CHUNK
REL_CLIP = 256
N_BRANCH = 2
NORM_EPS = 1e-6
GN_EPS = 64e-5
IN_SIZES = (D_BRANCH,) * 8 + (D_MODEL,) * 2
D_IN = sum(IN_SIZES)

kernel_name = "hybrid_rwkv7_chunkattn_gated_block"


def _rms_norm(x, g):
    xf = x.astype(jnp.float32)
    y = xf * lax.rsqrt(jnp.mean(xf * xf, axis=-1, keepdims=True) + NORM_EPS)
    return (y * g.astype(jnp.float32)).astype(x.dtype)


def _shift(x):
    return jnp.pad(x, ((0, 0), (1, 0), (0, 0)))[:, :-1]


def _rwkv7_mixer(h, p_r, p_k, p_v, mu_rkv, mu_wa, w0, w1, w2, a0, a1, a2,
                 k_k, k_a, r_k, ln_x_g, ln_x_b):
    B, S, _ = h.shape
    H, N = RWKV_HEADS, HEAD_DIM
    f32 = jnp.float32
    r = p_r + (_shift(p_r) - p_r) * mu_rkv[0]
    k = p_k + (_shift(p_k) - p_k) * mu_rkv[1]
    v = p_v + (_shift(p_v) - p_v) * mu_rkv[2]
    dh = _shift(h) - h
    xw = h + dh * mu_wa[0]
    xa = h + dh * mu_wa[1]
    w = jnp.exp(-DECAY_SCALE * jax.nn.sigmoid((w0 + jnp.tanh(xw @ w1) @ w2).astype(f32)))
    a = jax.nn.sigmoid((a0 + (xa @ a1) @ a2).astype(f32))
    r = r.astype(f32)
    k = k.astype(f32)
    v = v.astype(f32)
    kk = (k * k_k.astype(f32)).reshape(B, S, H, N)
    kk = kk / jnp.maximum(jnp.sqrt(jnp.sum(kk * kk, axis=-1, keepdims=True)), 1e-12)
    k = k * (1.0 + (a - 1.0) * k_a.astype(f32))
    r4, k4, v4 = (t.reshape(B, S, H, N) for t in (r, k, v))
    w4, a4 = w.reshape(B, S, H, N), a.reshape(B, S, H, N)

    def step(state, inp):
        rt, wt, kt, vt, kkt, at = inp
        sa = jnp.einsum('bhvk,bhk->bhv', state, -kkt)
        state = (state * wt[:, :, None, :] + sa[..., None] * (kkt * at)[:, :, None, :]
                 + vt[..., :, None] * kt[..., None, :])
        yt = jnp.einsum('bhvk,bhk->bhv', state, rt)
        return state, yt

    seq_major = tuple(jnp.swapaxes(t, 0, 1) for t in (r4, w4, k4, v4, kk, a4))
    state0 = jnp.zeros((B, H, N, N), f32)
    _, y = lax.scan(step, state0, seq_major)
    y = jnp.swapaxes(y, 0, 1)
    mean = jnp.mean(y, axis=-1, keepdims=True)
    var = jnp.mean(jnp.square(y - mean), axis=-1, keepdims=True)
    y = ((y - mean) * lax.rsqrt(var + GN_EPS)).reshape(B, S, D_BRANCH)
    y = y * ln_x_g.astype(f32) + ln_x_b.astype(f32)
    bonus = jnp.sum(r4 * k4 * r_k.astype(f32), axis=-1, keepdims=True) * v4
    y = y + bonus.reshape(B, S, D_BRANCH)
    return y.astype(h.dtype)


def _chunk_band_attention(q, k, v, rel_bias):
    B, S, _ = q.shape
    H, Dh = ATTN_HEADS, HEAD_DIM
    n_chunks = S // CHUNK
    q = q.reshape(B, S, H, Dh) * (Dh ** -0.5)
    kp = jnp.pad(k.reshape(B, S, H, Dh), ((0, 0), (PAST, 0), (0, 0), (0, 0)))
    vp = jnp.pad(v.reshape(B, S, H, Dh), ((0, 0), (PAST, 0), (0, 0), (0, 0)))
    qi = jnp.arange(CHUNK)[:, None]
    kj = jnp.arange(BAND)[None, :]
    rel_idx = jnp.clip(qi - kj + PAST, -REL_CLIP, REL_CLIP) + REL_CLIP
    bias = rel_bias[:, rel_idx].astype(jnp.float32)
    key_offsets = jnp.arange(BAND) - PAST

    def one_chunk(c):
        start = c * CHUNK
        qc = lax.dynamic_slice_in_dim(q, start, CHUNK, axis=1)
        kc = lax.dynamic_slice_in_dim(kp, start, BAND, axis=1)
        vc = lax.dynamic_slice_in_dim(vp, start, BAND, axis=1)
        s = jnp.einsum('bqhd,bkhd->bhqk', qc, kc).astype(jnp.float32) + bias
        valid = (start + key_offsets) >= 0
        s = jnp.where(valid[None, None, None, :], s, jnp.float32(-1e30))
        p = jax.nn.softmax(s, axis=-1).astype(vc.dtype)
        return jnp.einsum('bhqk,bkhd->bqhd', p, vc)

    o = lax.map(one_chunk, jnp.arange(n_chunks))
    return jnp.moveaxis(o, 0, 1).reshape(B, S, H * Dh)


def setup_inputs(seed: int = 0) -> dict:
    key = jax.random.key(seed)
    ks = jax.random.split(key, 24)
    L, D, DB, H, N = DEPTH, D_MODEL, D_BRANCH, RWKV_HEADS, HEAD_DIM
    nrm = lambda k, shape, s: jax.random.normal(k, shape, jnp.float32) * s
    return {
        "x": nrm(ks[0], (BATCH, SEQ, D), 1.0),
        "pre_norm_g": 1.0 + nrm(ks[1], (L, D), 0.02),
        "post_norm_g": 1.0 + nrm(ks[2], (L, D), 0.02),
        "w_in": nrm(ks[3], (L, D, D_IN), D ** -0.5),
        "mu_rkv": jax.random.uniform(ks[4], (L, 3, DB), jnp.float32),
        "mu_wa": jax.random.uniform(ks[5], (L, 2, D), jnp.float32),
        "w0": -1.5 + nrm(ks[6], (L, DB), 1.0),
        "w1": nrm(ks[7], (L, D, LORA_DECAY), D ** -0.5),
        "w2": nrm(ks[8], (L, LORA_DECAY, DB), 0.5 * LORA_DECAY ** -0.5),
        "a0": nrm(ks[9], (L, DB), 0.3),
        "a1": nrm(ks[10], (L, D, LORA_ICLR), D ** -0.5),
        "a2": nrm(ks[11], (L, LORA_ICLR, DB), 0.5 * LORA_ICLR ** -0.5),
        "k_k": 0.85 + nrm(ks[12], (L, DB), 0.02),
        "k_a": 1.0 + nrm(ks[13], (L, DB), 0.02),
        "r_k": nrm(ks[14], (L, H, N), 0.1),
        "ln_x_g": 1.0 + nrm(ks[15], (L, DB), 0.02),
        "ln_x_b": nrm(ks[16], (L, DB), 0.02),
        "rel_bias": nrm(ks[17], (L, ATTN_HEADS, 2 * REL_CLIP + 1), 0.1),
        "w_branch_rwkv": nrm(ks[18], (L, DB, D), DB ** -0.5),
        "w_branch_attn": nrm(ks[19], (L, DB, D), DB ** -0.5),
        "b_merge": nrm(ks[20], (L, N_BRANCH, D), 0.1),
        "w_out": nrm(ks[21], (L, D, D), D ** -0.5),
    }


def reference(x, pre_norm_g, post_norm_g, w_in, mu_rkv, mu_wa, w0, w1, w2, a0, a1, a2,
              k_k, k_a, r_k, ln_x_g, ln_x_b, rel_bias, w_branch_rwkv, w_branch_attn,
              b_merge, w_out):
    split_points = np.cumsum(IN_SIZES)[:-1].tolist()
    for l in range(DEPTH):
        h = _rms_norm(x, pre_norm_g[l])
        proj = h @ w_in[l]
        p_r, p_k, p_v, z_r, q_a, k_a_att, v_a, z_a, m_r, m_a = jnp.split(
            proj, split_points, axis=-1)
        y_r = _rwkv7_mixer(h, p_r, p_k, p_v, mu_rkv[l], mu_wa[l], w0[l], w1[l], w2[l],
                           a0[l], a1[l], a2[l], k_k[l], k_a[l], r_k[l],
                           ln_x_g[l], ln_x_b[l]) * jax.nn.silu(z_r)
        y_a = _chunk_band_attention(q_a, k_a_att, v_a, rel_bias[l]) * jax.nn.silu(z_a)
        u_r = y_r @ w_branch_rwkv[l]
        u_a = y_a @ w_branch_attn[l]
        merged = (jax.nn.sigmoid(m_r + b_merge[l, 0]) * u_r
                  + jax.nn.sigmoid(m_a + b_merge[l, 1]) * u_a)
        o = merged @ w_out[l]
        x = x + _rms_norm(o, post_norm_g[l])
    return x
```

```cpp
#include <hip/hip_runtime.h>
#include <cstdio>
#include <cstdint>

#ifndef MK_N_LAUNCHES
#define MK_N_LAUNCHES 1
#endif
#ifndef WGM_P1
#define WGM_P1 6
#endif
#ifndef WGM_P6
#define WGM_P6 2
#endif
#ifndef WGM_P7
#define WGM_P7 2
#endif
#ifndef P1_ALIGN
#define P1_ALIGN true
#endif
#ifndef P1_SP2
#define P1_SP2 true
#endif
#ifndef XCD_REMAP
#define XCD_REMAP 1
#endif
#ifndef ROT_COLS
#define ROT_COLS 0
#endif
#ifndef PROBE_REP
#define PROBE_REP -1
#endif

#define LAS __attribute__((address_space(3)))
#define GAS __attribute__((address_space(1)))
typedef unsigned short bf16_t;
typedef short bf16x8 __attribute__((ext_vector_type(8)));
typedef short s16x4 __attribute__((ext_vector_type(4)));
typedef float f32x4 __attribute__((ext_vector_type(4)));
typedef float f32x2 __attribute__((ext_vector_type(2)));
typedef unsigned u32x4 __attribute__((ext_vector_type(4)));
typedef unsigned u32x2 __attribute__((ext_vector_type(2)));
typedef __bf16 bf16x2_t __attribute__((ext_vector_type(2)));

constexpr int BATCH = 2, SEQ = 8192, DM = 2048, DBR = 1024, NH = 16, HD = 64, CHUNK = 64, NCHUNK = SEQ / CHUNK, M = BATCH * SEQ;
constexpr int NPA = 8192, NPG = 4096, NPL = 256, NIN = NPA + NPG + NPL;
constexpr int PA_R = 0, PA_K = 1024, PA_V = 2048, PA_ZR = 3072, PA_Q = 4096, PA_KA = 5120, PA_VA = 6144, PA_ZA = 7168;
constexpr float NORM_EPS = 1e-6f, GN_EPS = 64e-5f, DECAY_SCALE = 0.606531f;
constexpr int NWAVES = 8, NTHREADS = 512;

constexpr size_t MiB = 1u << 20;
constexpr size_t WS_CTL = 0, CTL_ZERO_BYTES = 1 * MiB;
constexpr size_t WS_WCAT = 1 * MiB;
constexpr size_t WS_WOUT = 9 * MiB;
constexpr size_t WS_W2T = 17 * MiB;
constexpr size_t WS_BONUS = 18 * MiB;
constexpr size_t WS_SSP = 19 * MiB;
constexpr size_t WS_PL = 22 * MiB;
constexpr size_t WS_PG = 30 * MiB;
constexpr size_t WS_PA = 158 * MiB;
constexpr size_t WS_MERGED = WS_PA;
constexpr size_t WS_OBF = WS_PA + 64 * MiB;
constexpr size_t WS_YCAT = 414 * MiB;
constexpr size_t WS_PLS = 478 * MiB;
constexpr size_t WS_END = 510 * MiB;
constexpr size_t DO_HB = 0, DO_WIN = 64 * MiB, DO_STATES = 0;
constexpr size_t DO_MD = 32 * MiB, DO_ND = 64 * MiB, DO_QD = 96 * MiB;
constexpr int CW_BAR = 4096;

constexpr int RING_BYTES = 131072;
constexpr int LDSCTL_OFF = 152576, MISC_OFF = LDSCTL_OFF + 320;
constexpr int LDS_BYTES = 153600;

typedef GAS unsigned gu32;
#define RLX_AGENT __ATOMIC_RELAXED, __HIP_MEMORY_SCOPE_AGENT
#define LDS_WAIT() asm volatile("s_waitcnt lgkmcnt(0)" ::: "memory")
#define VM_WAIT() asm volatile("s_waitcnt vmcnt(0)" ::: "memory")
__device__ __forceinline__ unsigned pk2(float lo, float hi) { f32x2 v = {lo, hi}; bf16x2_t b = __builtin_convertvector(v, bf16x2_t); return __builtin_bit_cast(unsigned, b); }
__device__ __forceinline__ bf16_t f2bf(float f) { return (bf16_t)(pk2(f, 0.f) & 0xffffu); }
__device__ __forceinline__ float bflo(unsigned w) { return __uint_as_float(w << 16); }
__device__ __forceinline__ float bfhi(unsigned w) { return __uint_as_float(w & 0xffff0000u); }
__device__ __forceinline__ float bf2f(bf16_t h) { return __uint_as_float(((unsigned)h) << 16); }
__device__ __forceinline__ void unpack8(const u32x4 w, float (&f)[8]) { f[0] = bflo(w.x); f[1] = bfhi(w.x); f[2] = bflo(w.y); f[3] = bfhi(w.y); f[4] = bflo(w.z); f[5] = bfhi(w.z); f[6] = bflo(w.w); f[7] = bfhi(w.w); }
__device__ __forceinline__ u32x4 pack8(const float (&f)[8]) { u32x4 w; w.x = pk2(f[0], f[1]); w.y = pk2(f[2], f[3]); w.z = pk2(f[4], f[5]); w.w = pk2(f[6], f[7]); return w; }
__device__ __forceinline__ void load8(const float* p, float (&f)[8]) { const f32x4 a = *(const f32x4*)p, b = *(const f32x4*)(p + 4); f[0] = a.x; f[1] = a.y; f[2] = a.z; f[3] = a.w; f[4] = b.x; f[5] = b.y; f[6] = b.z; f[7] = b.w; }
__device__ __forceinline__ float sigmoidf_(float x) { return 1.f / (1.f + __expf(-x)); }
__device__ __forceinline__ float tanhf_(float x) { return 1.f - 2.f / (1.f + __expf(2.f * x)); }

namespace pg8 {
constexpr int BM = 256, BK = 64, HALF = 128, HTB = HALF * BK * 2  , STAGE_BYTES = 8 * HTB, NXCD = 8;
__host__ __device__ __forceinline__ int lds_byte(int r, int c) { const int st = (r >> 4) * 2 + (c >> 5), rr = r & 15, cc = c & 31, ob = rr * 64 + cc * 2; return st * 1024 + (ob ^ (((ob >> 9) & 1) << 5)); }
__host__ __device__ __forceinline__ void stage_rc(int b, int& R, int& C) { const int st = b / 1024, sb = b % 1024, swz = sb ^ (((sb >> 9) & 1) << 5); R = (st >> 1) * 16 + swz / 64; C = (st & 1) * 32 + (swz % 64) / 2; }
__host__ __device__ __forceinline__ int perm32(int rho) { const int n = rho >> 4, i = rho & 15; return 8 * (i >> 2) + 4 * n + (i & 3); }

struct Unit { int pm, pn, kb, nt; };
struct Gemm { const bf16_t* A; const bf16_t* Bt; int M, N, K; };

struct StaticOrder {
    int nM, nN, nwg, G, c, ntk, WGM;
    __host__ __device__ void init(int M_, int N_, int G_, int c_, int K_, int wgm_) { nM = M_ / BM; nN = N_ / BM; nwg = nM * nN; G = G_; c = c_; ntk = K_ / BK; WGM = wgm_; }
    __host__ __device__ void tile(int L, int& pm, int& pn) const {
        int wgid = L; if (XCD_REMAP) { const int q = nwg / NXCD, r = nwg % NXCD, xcd = wgid % NXCD, off = wgid / NXCD; wgid = (xcd < r ? xcd * (q + 1) : r * (q + 1) + (xcd - r) * q) + off; }
        if (WGM > 0) { const int nig = WGM * nN, gid = wgid / nig, fm = gid * WGM, gsz = (nM - fm) < WGM ? (nM - fm) : WGM;
            pm = fm + ((wgid % nig) % gsz); pn = (wgid % nig) / gsz;
            if (ROT_COLS) pn = (pn + ROT_COLS * gid) % nN; }
        else { const int W = -WGM, nig = W * nM, gid = wgid / nig, fn = gid * W, gsz = (nN - fn) < W ? (nN - fn) : W;
            pn = fn + ((wgid % nig) % gsz); pm = (wgid % nig) / gsz; }
    }
    __host__ __device__ bool next(int i, Unit& u) const {
        const long L = (long)i * G + c; if (L >= nwg) return false;
        int pm, pn; tile((int)L, pm, pn);
        u.pm = pm; u.pn = pn; u.kb = 0; u.nt = ntk; return true;
    }
};
struct SplitOrder {
    StaticOrder so; int extra_pn;
    __host__ __device__ bool next(int i, Unit& u) const {
        const long L = (long)i * so.G + so.c; const bool normal = L < so.nwg; const int Lq = (int)(L - so.nwg);
        if (!normal && Lq >= 256) return false;
        int pm, pn; so.tile(normal ? (int)L : 0, pm, pn);
        u.pm = normal ? pm : (Lq >> 2); u.pn = normal ? pn : extra_pn; u.kb = normal ? 0 : (Lq & 3) * 1024; u.nt = normal ? so.ntk : 8; return true;
    }
};
struct PairOrder {
    StaticOrder so; int dpm, dpn;
    __host__ __device__ bool next(int i, Unit& u) const { if (!so.next(i >> 1, u)) return false; if (i & 1) { u.pm += dpm; u.pn += dpn; } return true; }
};

template <class Epi, class Sched, bool ALIGN_EPI = false, bool SP2 = false>
__device__ __forceinline__ void gemm_phase(LAS unsigned char* lds, const Gemm g, const Sched& S, const Epi& E) {
    const int tid = threadIdx.x, wid = __builtin_amdgcn_readfirstlane(tid >> 6), lane = tid & 63, wr = wid >> 2, wc = wid & 3, fr = lane & 15, fq = lane >> 4;
    const int K = g.K;
    unsigned voffA[2], voffB[2];
#pragma unroll
    for (int i = 0; i < 2; ++i) { int R, C; stage_rc(tid * 16 + i * 8192, R, C); const int Rb = Epi::PERM ? ((R & ~31) + perm32(R & 31)) : R;
        voffA[i] = (unsigned)(R * K + C) * 2u; voffB[i] = (unsigned)(Rb * K + C) * 2u; }
    const size_t kstep = (size_t)(BK * 2);
    const size_t hstep = (size_t)HALF * K * 2;
    const size_t tstep = 2 * hstep;
    const unsigned ldsw = (unsigned)wid * 1024u;
    const int aoff = lds_byte(wr * 64 + fr, fq * 8), boff = lds_byte(wc * 32 + fr, fq * 8);
#define PG8_SA(b, h) (((b) * 2 + (h)) * HTB)
#define PG8_SB(b, h) ((4 + (b) * 2 + (h)) * HTB)
#define PG8_STAGE(bufoff, gbase, voff) do { _Pragma("unroll") for (int _i = 0; _i < 2; ++_i) \
        __builtin_amdgcn_global_load_lds((const unsigned*)((const char*)(gbase) + (voff)[_i]), (LAS unsigned*)(lds + (bufoff) + ldsw + _i * 8192), 16, 0, 0); } while (0)
#define PG8_LDA(dst, b, h) do { _Pragma("unroll") for (int m = 0; m < 4; ++m) _Pragma("unroll") for (int k = 0; k < 2; ++k) dst[m][k] = *(const LAS bf16x8*)(lds + PG8_SA(b, h) + aoff + m * 2048 + k * 1024); } while (0)
#define PG8_LDB(dst, b, h) do { _Pragma("unroll") for (int n = 0; n < 2; ++n) _Pragma("unroll") for (int k = 0; k < 2; ++k) dst[n][k] = *(const LAS bf16x8*)(lds + PG8_SB(b, h) + boff + n * 2048 + k * 1024); } while (0)
#define PG8_MMA(ai, bj, At, Bt) do { __builtin_amdgcn_s_setprio(1); _Pragma("unroll") for (int m = 0; m < 4; ++m) _Pragma("unroll") for (int n = 0; n < 2; ++n) _Pragma("unroll") for (int k = 0; k < 2; ++k) \
        acc[ai][bj][m][n] = __builtin_amdgcn_mfma_f32_16x16x32_bf16(Bt[n][k], At[m][k], acc[ai][bj][m][n], 0, 0, 0); __builtin_amdgcn_s_setprio(0); } while (0)
#define PG8_WAIT_V(n) asm volatile("s_waitcnt vmcnt(" #n ")" ::: "memory")
#define PG8_WAIT_L(n) asm volatile("s_waitcnt lgkmcnt(" #n ")" ::: "memory")
#define PG8_BAR __builtin_amdgcn_s_barrier()
#define PG8_SCHED __builtin_amdgcn_sched_barrier(0)
    Unit cur, nxt; int ui = 0;
    if (!S.next(0, cur)) return;
    f32x4 acc[2][2][4][2];
#pragma unroll
    for (int a = 0; a < 2; ++a)
#pragma unroll
        for (int b = 0; b < 2; ++b)
#pragma unroll
            for (int m = 0; m < 4; ++m)
#pragma unroll
                for (int n = 0; n < 2; ++n) acc[a][b][m][n] = (f32x4){0.f, 0.f, 0.f, 0.f};
    bf16x8 At[4][2], B0[2][2], B1[2][2];
    const char* cA = (const char*)g.A + (size_t)cur.pm * tstep + cur.kb; const char* cB = (const char*)g.Bt + (size_t)cur.pn * tstep + cur.kb;
    if constexpr (SP2) {
        PG8_STAGE(PG8_SB(0, 0), cB, voffB); PG8_STAGE(PG8_SB(0, 1), cB + hstep, voffB); PG8_STAGE(PG8_SA(0, 0), cA, voffA); PG8_STAGE(PG8_SA(0, 1), cA + hstep, voffA);
        if (wr == 1) PG8_BAR;
        PG8_WAIT_V(2); PG8_BAR;
        PG8_STAGE(PG8_SB(1, 0), cB + kstep, voffB); PG8_STAGE(PG8_SA(1, 0), cA + kstep, voffA); PG8_STAGE(PG8_SB(1, 1), cB + hstep + kstep, voffB);
        PG8_WAIT_V(6); PG8_BAR;
    } else {
        PG8_STAGE(PG8_SB(0, 0), cB, voffB); PG8_STAGE(PG8_SA(0, 0), cA, voffA); PG8_STAGE(PG8_SB(0, 1), cB + hstep, voffB); PG8_STAGE(PG8_SA(0, 1), cA + hstep, voffA);
        if (wr == 1) PG8_BAR;
        PG8_WAIT_V(4); PG8_BAR;
        PG8_STAGE(PG8_SB(1, 0), cB + kstep, voffB); PG8_STAGE(PG8_SA(1, 0), cA + kstep, voffA); PG8_STAGE(PG8_SB(1, 1), cB + hstep + kstep, voffB);
        PG8_WAIT_V(6); PG8_BAR;
    }
    for (;;) {
        const bool has_next = S.next(ui + 1, nxt);
        const char* nA = has_next ? (const char*)g.A + (size_t)nxt.pm * tstep + nxt.kb : cA; const char* nB = has_next ? (const char*)g.Bt + (size_t)nxt.pn * tstep + nxt.kb : cB;
        const int nt = cur.nt;
        for (int t = 0; t < nt; t += 2) {
            const bool last = (t == nt - 2);
            const char* a1 = cA + (size_t)(t + 1) * kstep;
            const char* a2 = last ? nA : cA + (size_t)(t + 2) * kstep; const char* b2 = last ? nB : cB + (size_t)(t + 2) * kstep;
            const char* a3 = a2 + kstep; const char* b3 = b2 + kstep;
            if constexpr (SP2) {
            PG8_LDB(B0, 0, 0); PG8_LDB(B1, 0, 1); PG8_SCHED; PG8_LDA(At, 0, 0); PG8_STAGE(PG8_SA(1, 1), a1 + hstep, voffA);
            PG8_WAIT_V(8); PG8_WAIT_L(0); PG8_BAR; PG8_MMA(0, 0, At, B0); PG8_MMA(0, 1, At, B1); PG8_BAR; PG8_SCHED;
            PG8_LDA(At, 0, 1); PG8_STAGE(PG8_SB(0, 0), b2, voffB); PG8_STAGE(PG8_SB(0, 1), b2 + hstep, voffB); PG8_STAGE(PG8_SA(0, 0), a2, voffA);
            PG8_WAIT_V(8); PG8_WAIT_L(0); PG8_BAR; PG8_MMA(1, 0, At, B0); PG8_MMA(1, 1, At, B1); PG8_BAR; PG8_SCHED;
            PG8_LDB(B0, 1, 0); PG8_LDB(B1, 1, 1); PG8_SCHED; PG8_LDA(At, 1, 0); PG8_STAGE(PG8_SA(0, 1), a2 + hstep, voffA);
            PG8_WAIT_V(8); PG8_WAIT_L(0); PG8_BAR; PG8_MMA(0, 0, At, B0); PG8_MMA(0, 1, At, B1); PG8_BAR; PG8_SCHED;
            PG8_LDA(At, 1, 1); PG8_STAGE(PG8_SB(1, 0), b3, voffB); PG8_STAGE(PG8_SB(1, 1), b3 + hstep, voffB); PG8_STAGE(PG8_SA(1, 0), a3, voffA);
            PG8_WAIT_V(8); PG8_WAIT_L(0); PG8_BAR; PG8_MMA(1, 0, At, B0); PG8_MMA(1, 1, At, B1); PG8_BAR; PG8_SCHED;
            } else {
            PG8_LDB(B0, 0, 0); PG8_SCHED; PG8_LDA(At, 0, 0); PG8_STAGE(PG8_SA(1, 1), a1 + hstep, voffA);
            PG8_WAIT_L(8); PG8_BAR; PG8_WAIT_L(0); PG8_MMA(0, 0, At, B0); PG8_BAR; PG8_SCHED;
            PG8_LDB(B1, 0, 1); PG8_STAGE(PG8_SB(0, 0), b2, voffB);
            PG8_BAR; PG8_WAIT_L(0); PG8_MMA(0, 1, At, B1); PG8_BAR;
            PG8_LDA(At, 0, 1); PG8_STAGE(PG8_SA(0, 0), a2, voffA);
            PG8_BAR; PG8_WAIT_L(0); PG8_MMA(1, 0, At, B0); PG8_BAR; PG8_SCHED;
            PG8_STAGE(PG8_SB(0, 1), b2 + hstep, voffB);
            PG8_WAIT_V(6); PG8_BAR; PG8_MMA(1, 1, At, B1); PG8_BAR;
            PG8_LDB(B0, 1, 0); PG8_SCHED; PG8_LDA(At, 1, 0); PG8_STAGE(PG8_SA(0, 1), a2 + hstep, voffA);
            PG8_WAIT_L(8); PG8_BAR; PG8_WAIT_L(0); PG8_MMA(0, 0, At, B0); PG8_BAR; PG8_SCHED;
            PG8_LDB(B1, 1, 1); PG8_STAGE(PG8_SB(1, 0), b3, voffB);
            PG8_BAR; PG8_WAIT_L(0); PG8_MMA(0, 1, At, B1); PG8_BAR;
            PG8_LDA(At, 1, 1); PG8_STAGE(PG8_SA(1, 0), a3, voffA);
            PG8_BAR; PG8_WAIT_L(0); PG8_MMA(1, 0, At, B0); PG8_BAR; PG8_SCHED;
            PG8_STAGE(PG8_SB(1, 1), b3 + hstep, voffB);
            PG8_WAIT_V(6); PG8_BAR; PG8_MMA(1, 1, At, B1); PG8_BAR;
            }
        }
        if constexpr (ALIGN_EPI) { if (wr == 0) PG8_BAR; }
        const bool zero_acc = E(acc, cur, wr, wc, fr, fq);
        if (!has_next) break;
        if (zero_acc) {
#pragma unroll
        for (int a = 0; a < 2; ++a)
#pragma unroll
            for (int b = 0; b < 2; ++b)
#pragma unroll
                for (int m = 0; m < 4; ++m)
#pragma unroll
                    for (int n = 0; n < 2; ++n) acc[a][b][m][n] = (f32x4){0.f, 0.f, 0.f, 0.f};
        }
        cur = nxt; cA = nA; cB = nB; ++ui;
        if constexpr (ALIGN_EPI) { if (wr == 1) PG8_BAR; }
    }
    PG8_WAIT_V(0);
    if constexpr (!ALIGN_EPI) { if (wr == 0) PG8_BAR; }
    PG8_BAR;
#undef PG8_SA
#undef PG8_SB
#undef PG8_STAGE
#undef PG8_LDA
#undef PG8_LDB
#undef PG8_MMA
#undef PG8_WAIT_V
#undef PG8_WAIT_L
#undef PG8_BAR
#undef PG8_SCHED
}
}

struct EpiIn {
    static constexpr bool PERM = true;
    bf16_t* PA; bf16_t* PG; bf16_t* PL; const float* bmerge;
    __device__ __forceinline__ bool operator()(f32x4 (&acc)[2][2][4][2], const pg8::Unit& u, int wr, int wc, int fr, int fq) const {
        const int row0 = u.pm * 256 + wr * 64 + fr; const int colb = u.pn * 256 + wc * 32 + 8 * fq;
        if (u.pn < 32) {
            const float sc = (u.pn >= 16 && u.pn < 20) ? 0.125f : 1.0f;
#pragma unroll
            for (int ai = 0; ai < 2; ++ai)
#pragma unroll
                for (int m = 0; m < 4; ++m) { bf16_t* rowp = PA + (size_t)(row0 + ai * 128 + m * 16) * NPA + colb;
#pragma unroll
                    for (int bj = 0; bj < 2; ++bj) { const f32x4 v0 = acc[ai][bj][m][0] * sc, v1 = acc[ai][bj][m][1] * sc;
                        u32x4 w; w.x = pk2(v0[0], v0[1]); w.y = pk2(v0[2], v0[3]); w.z = pk2(v1[0], v1[1]); w.w = pk2(v1[2], v1[3]);
                        *(u32x4*)(rowp + bj * 128) = w; } }
        } else if (u.pn < 48) {
            const int cg = colb - NPA;
            f32x4 bv[2][2];
#pragma unroll
            for (int bj = 0; bj < 2; ++bj)
#pragma unroll
                for (int n = 0; n < 2; ++n) bv[bj][n] = *(const f32x4*)(bmerge + cg + bj * 128 + 4 * n);
#pragma unroll
            for (int ai = 0; ai < 2; ++ai)
#pragma unroll
                for (int m = 0; m < 4; ++m) { bf16_t* rowp = PG + (size_t)(row0 + ai * 128 + m * 16) * NPG + cg;
#pragma unroll
                    for (int bj = 0; bj < 2; ++bj) { const f32x4 v0 = acc[ai][bj][m][0] + bv[bj][0], v1 = acc[ai][bj][m][1] + bv[bj][1];
                        u32x4 w; w.x = pk2(sigmoidf_(v0[0]), sigmoidf_(v0[1])); w.y = pk2(sigmoidf_(v0[2]), sigmoidf_(v0[3])); w.z = pk2(sigmoidf_(v1[0]), sigmoidf_(v1[1])); w.w = pk2(sigmoidf_(v1[2]), sigmoidf_(v1[3]));
                        *(u32x4*)(rowp + bj * 128) = w; } }
        } else {
            const int cl = colb - NPA - NPG;
#pragma unroll
            for (int ai = 0; ai < 2; ++ai)
#pragma unroll
                for (int m = 0; m < 4; ++m) { bf16_t* rowp = PL + (size_t)(u.kb >> 10) * ((size_t)M * NPL) + (size_t)(row0 + ai * 128 + m * 16) * NPL + cl;
#pragma unroll
                    for (int bj = 0; bj < 2; ++bj) { const f32x4 v0 = acc[ai][bj][m][0], v1 = acc[ai][bj][m][1];
                        u32x4 w; w.x = pk2(v0[0], v0[1]); w.y = pk2(v0[2], v0[3]); w.z = pk2(v1[0], v1[1]); w.w = pk2(v1[2], v1[3]);
                        *(u32x4*)(rowp + bj * 128) = w; } }
        }
        return true;
    }
};
struct EpiBranch {
    static constexpr bool PERM = true;
    const bf16_t* PG; bf16_t* MG;
    __device__ __forceinline__ bool operator()(f32x4 (&acc)[2][2][4][2], const pg8::Unit& u, int wr, int wc, int fr, int fq) const {
        const bool first = u.pm < 64;
        const int pm = first ? u.pm : u.pm - 64, pn = first ? u.pn : u.pn - 8;
        const int row0 = pm * 256 + wr * 64 + fr; const int colb = pn * 256 + wc * 32 + 8 * fq;
#pragma unroll
        for (int ai = 0; ai < 2; ++ai) {
            u32x4 ga_[4][2], gr_[4][2];
#pragma unroll
            for (int m = 0; m < 4; ++m)
#pragma unroll
                for (int bj = 0; bj < 2; ++bj) { const bf16_t* p = PG + (size_t)(row0 + ai * 128 + m * 16) * NPG + colb + bj * 128; ga_[m][bj] = *(const u32x4*)(p + 2048); gr_[m][bj] = *(const u32x4*)p; }
#pragma unroll
            for (int m = 0; m < 4; ++m) { const size_t row = (size_t)(row0 + ai * 128 + m * 16);
#pragma unroll
                for (int bj = 0; bj < 2; ++bj) { float ga[8], gr[8]; unpack8(ga_[m][bj], ga); unpack8(gr_[m][bj], gr);
#pragma unroll
                    for (int e = 0; e < 4; ++e) { const float s0 = first ? gr[e] * __builtin_amdgcn_rcpf(ga[e]) : ga[e], s1 = first ? gr[4 + e] * __builtin_amdgcn_rcpf(ga[4 + e]) : ga[4 + e];
                        acc[ai][bj][m][0][e] *= s0; acc[ai][bj][m][1][e] *= s1; }
                    if (!first) { const f32x4 v0 = acc[ai][bj][m][0], v1 = acc[ai][bj][m][1];
                        u32x4 w; w.x = pk2(v0[0], v0[1]); w.y = pk2(v0[2], v0[3]); w.z = pk2(v1[0], v1[1]); w.w = pk2(v1[2], v1[3]);
                        *(u32x4*)(MG + row * DM + colb + bj * 128) = w; } } }
            asm volatile("" ::: "memory");
        }
        return !first;
    }
};
struct EpiOut {
    static constexpr bool PERM = true;
    bf16_t* O; float* SSP;
    __device__ __forceinline__ bool operator()(f32x4 (&acc)[2][2][4][2], const pg8::Unit& u, int wr, int wc, int fr, int fq) const {
        const int row0 = u.pm * 256 + wr * 64 + fr; const int colb = u.pn * 256 + wc * 32 + 8 * fq;
#pragma unroll
        for (int ai = 0; ai < 2; ++ai)
#pragma unroll
            for (int m = 0; m < 4; ++m) { const size_t row = (size_t)(row0 + ai * 128 + m * 16); float ss = 0.f;
#pragma unroll
                for (int bj = 0; bj < 2; ++bj) { const f32x4 v0 = acc[ai][bj][m][0], v1 = acc[ai][bj][m][1];
                    ss += (v0[0] * v0[0] + v0[1] * v0[1]) + (v0[2] * v0[2] + v0[3] * v0[3]) + (v1[0] * v1[0] + v1[1] * v1[1]) + (v1[2] * v1[2] + v1[3] * v1[3]);
                    u32x4 w; w.x = pk2(v0[0], v0[1]); w.y = pk2(v0[2], v0[3]); w.z = pk2(v1[0], v1[1]); w.w = pk2(v1[2], v1[3]);
                    *(u32x4*)(O + row * DM + colb + bj * 128) = w; }
                ss += __shfl_xor(ss, 16); ss += __shfl_xor(ss, 32);
                if (fq == 0) SSP[row * 32 + u.pn * 4 + wc] = ss; }
        return true;
    }
};

#define XB_TMO      128
#define XB_XCNT(j)  (256  + 64 * (j))
#define XB_XSUB(j)  (1280 + 64 * (j))
#define XB_XGEN(j)  (2304 + 64 * (j))
#define XB_TOP      3328
#define XB_TOPGEN   3392
#define XCD_BAR_WORDS 3456
#define XB_SPIN_CAP (1u << 18)
__device__ __forceinline__ unsigned xb_ld(unsigned* p)              { return __hip_atomic_load(p, __ATOMIC_RELAXED, __HIP_MEMORY_SCOPE_AGENT); }
__device__ __forceinline__ unsigned xb_add(unsigned* p, unsigned v) { return __hip_atomic_fetch_add(p, v, __ATOMIC_RELAXED, __HIP_MEMORY_SCOPE_AGENT); }
__device__ __forceinline__ unsigned xb_xcc_id() { return (unsigned)__builtin_amdgcn_s_getreg((3 << 11) | 20) & 0xFu; }
#define XB_SPIN(cond, bar) do { unsigned _sp = 0; while (cond) { __builtin_amdgcn_s_sleep(1); \
    if ((++_sp & 255u) == 0u) { if (xb_ld(&(bar)[XB_TMO])) break; if (_sp > XB_SPIN_CAP) { atomicAdd(&(bar)[XB_TMO], 1u); break; } } } } while (0)
struct XcdBarrier { unsigned* bar; unsigned x; volatile LAS unsigned* st; };
__device__ __forceinline__ XcdBarrier xcd_barrier_post(unsigned* bar, volatile LAS unsigned* st) {
    XcdBarrier b; b.bar = bar; b.x = xb_xcc_id(); b.st = st;
    if (threadIdx.x == 0) (void)xb_add(&bar[XB_XCNT(b.x)], 1u);
    return b;
}
__device__ __forceinline__ void xcd_barrier_complete(unsigned* bar, unsigned x, unsigned& nloc, unsigned& nx) {
    const unsigned G = gridDim.x * gridDim.y * gridDim.z;
    unsigned sum, cnt, mine, sp = 0u;
    for (;;) {
        sum = 0u; cnt = 0u; mine = 0u;
#pragma unroll
        for (unsigned j = 0; j < 16; ++j) { const unsigned c = xb_ld(&bar[XB_XCNT(j)]); sum += c; cnt += (c > 0u) ? 1u : 0u; mine = (j == x) ? c : mine; }
        if (sum == G) break;
        __builtin_amdgcn_s_sleep(1);
        if ((++sp & 255u) == 0u) { if (xb_ld(&bar[XB_TMO])) break; if (sp > XB_SPIN_CAP) { atomicAdd(&bar[XB_TMO], 1u); break; } }
    }
    nloc = mine > 0u ? mine : 1u; nx = cnt > 0u ? cnt : 1u;
}
__device__ __forceinline__ void xcd_barrier(const XcdBarrier& b) {
    asm volatile("s_waitcnt vmcnt(0)" ::: "memory");
    __syncthreads();
    if (threadIdx.x == 0) {
        unsigned* bar = b.bar;
        __builtin_amdgcn_s_waitcnt(0);
        unsigned nloc = b.st[0], nx = b.st[1];
        if (nloc == 0u) { xcd_barrier_complete(bar, b.x, nloc, nx); b.st[0] = nloc; b.st[1] = nx; }
        const unsigned old = xb_add(&bar[XB_XSUB(b.x)], 1u);
        const unsigned gen = old / nloc;
        if (old + 1u == (gen + 1u) * nloc) {
            __builtin_amdgcn_fence(__ATOMIC_RELEASE, "agent");
            asm volatile("s_waitcnt vmcnt(0)" ::: "memory");
            const unsigned og = xb_add(&bar[XB_TOP], 1u);
            const unsigned tg = og / nx;
            if (og + 1u == (tg + 1u) * nx) xb_add(&bar[XB_TOPGEN], 1u);
            else XB_SPIN(xb_ld(&bar[XB_TOPGEN]) == tg, bar);
            __builtin_amdgcn_fence(__ATOMIC_ACQUIRE, "agent");
            xb_add(&bar[XB_XGEN(b.x)], 1u);
            asm volatile("s_waitcnt vmcnt(0)" ::: "memory");
        } else {
            XB_SPIN(xb_ld(&bar[XB_XGEN(b.x)]) == gen, bar);
            __builtin_amdgcn_fence(__ATOMIC_ACQUIRE, "agent");
            asm volatile("s_waitcnt vmcnt(0)" ::: "memory");
        }
    }
    __syncthreads();
}

struct Frame {
    LAS unsigned char* lds;
    int tid, lane, wave, G, bid;
    const float *x, *pre_g, *post_g, *w_in, *mu_rkv, *mu_wa, *w0, *w1, *w2, *a0, *a1, *a2, *k_k, *k_a, *r_k, *lnx_g, *lnx_b, *rel_bias, *w_br, *w_ba, *b_merge, *w_out;
    float* out;
    bf16_t *HB, *WIN_T, *WCAT_T, *WOUT_T, *W2T, *A2T, *PA, *PG, *PL, *YCAT, *MERGED, *STATES;
    float *BONUS, *SSP;
    bf16_t* OBF; bf16_t *MD, *ND, *QD; unsigned* queue;
};

__device__ __forceinline__ float wave_sum(float v) {
#pragma unroll
    for (int o = 1; o < 64; o <<= 1) v += __shfl_xor(v, o);
    return v;
}

__device__ __forceinline__ void p0_transpose_item(const float* W, int K, int N, bf16_t* WT, int row_off, LAS float* scr, int item, int lane, const float* mu, float s0, float s1) {
    const int nblk = N / 32, kb = item / nblk, nb = item % nblk, k0 = 64 * kb, n0 = 32 * nb;
    f32x4 v4[8];
#pragma unroll
    for (int i = 0; i < 8; ++i) { const int kk = 8 * i + (lane >> 3); v4[i] = *(const f32x4*)(W + (size_t)(k0 + kk) * N + n0 + (lane & 7) * 4); }
#pragma unroll
    for (int i = 0; i < 8; ++i) { const int kk = 8 * i + (lane >> 3); f32x4 v = v4[i]; if (mu) v = v * (s0 + s1 * mu[k0 + kk]);
        LAS float* d = scr + kk * 33 + (lane & 7) * 4; d[0] = v[0]; d[1] = v[1]; d[2] = v[2]; d[3] = v[3]; }
    LDS_WAIT(); asm volatile("" ::: "memory");
    const int c = lane & 7;
#pragma unroll
    for (int j = 0; j < 4; ++j) { const int n = (lane >> 3) + 8 * j; const LAS float* s = scr + (8 * c) * 33 + n;
        u32x4 o; o.x = pk2(s[0 * 33], s[1 * 33]); o.y = pk2(s[2 * 33], s[3 * 33]); o.z = pk2(s[4 * 33], s[5 * 33]); o.w = pk2(s[6 * 33], s[7 * 33]);
        *(u32x4*)(WT + (size_t)(row_off + n0 + n) * K + k0 + 8 * c) = o; }
    LDS_WAIT(); asm volatile("" ::: "memory");
}
__device__ __forceinline__ void p0_prologue(Frame& F) {
    LAS float* scr = (LAS float*)(F.lds + F.wave * 16384);
    const int gw = F.bid * NWAVES + F.wave, NGW = F.G * NWAVES;
    constexpr int I_IN = (DM / 64) * (NPA + NPG) / 32, I_L = (DM / 64) * (64 / 32), I_BR = (DBR / 64) * (DM / 32), I_OUT = (DM / 64) * (DM / 32), I_W2 = (64 / 64) * (DBR / 32);
    constexpr int NITEMS = I_IN + 4 * I_L + 2 * I_BR + I_OUT + 2 * I_W2;
    for (int it = gw; it < NITEMS; it += NGW) {
        int r = it;
        if (r < I_IN) { p0_transpose_item(F.w_in, DM, NPA + NPG, F.WIN_T, 0, scr, r, F.lane, nullptr, 1.f, 0.f); continue; } r -= I_IN;
        if (r < I_L) { p0_transpose_item(F.w1, DM, 64, F.WIN_T, NPA + NPG + 0, scr, r, F.lane, F.mu_wa, 1.f, -1.f); continue; } r -= I_L;
        if (r < I_L) { p0_transpose_item(F.w1, DM, 64, F.WIN_T, NPA + NPG + 64, scr, r, F.lane, F.mu_wa, 0.f, 1.f); continue; } r -= I_L;
        if (r < I_L) { p0_transpose_item(F.a1, DM, 64, F.WIN_T, NPA + NPG + 128, scr, r, F.lane, F.mu_wa + DM, 1.f, -1.f); continue; } r -= I_L;
        if (r < I_L) { p0_transpose_item(F.a1, DM, 64, F.WIN_T, NPA + NPG + 192, scr, r, F.lane, F.mu_wa + DM, 0.f, 1.f); continue; } r -= I_L;
        if (r < I_BR) { p0_transpose_item(F.w_br, DBR, DM, F.WCAT_T, 0, scr, r, F.lane, nullptr, 1.f, 0.f); continue; } r -= I_BR;
        if (r < I_BR) { p0_transpose_item(F.w_ba, DBR, DM, F.WCAT_T, DM, scr, r, F.lane, nullptr, 1.f, 0.f); continue; } r -= I_BR;
        if (r < I_OUT) { p0_transpose_item(F.w_out, DM, DM, F.WOUT_T, 0, scr, r, F.lane, nullptr, 1.f, 0.f); continue; } r -= I_OUT;
        if (r < I_W2) { p0_transpose_item(F.w2, 64, DBR, F.W2T, 0, scr, r, F.lane, nullptr, 1.f, 0.f); continue; } r -= I_W2;
        p0_transpose_item(F.a2, 64, DBR, F.A2T, 0, scr, r, F.lane, nullptr, 1.f, 0.f);
    }
    for (int m = gw; m < M; m += 2 * NGW) {
        const int m2 = (m + NGW < M) ? m + NGW : m;
        const f32x4* xr = (const f32x4*)(F.x + (size_t)m * DM) + F.lane; const f32x4* xr2 = (const f32x4*)(F.x + (size_t)m2 * DM) + F.lane; const f32x4* gr = (const f32x4*)F.pre_g + F.lane;
        f32x4 v[8], w[8]; float s = 0.f, s2 = 0.f;
#pragma unroll
        for (int j = 0; j < 8; ++j) { v[j] = xr[64 * j]; w[j] = xr2[64 * j]; }
#pragma unroll
        for (int j = 0; j < 8; ++j) { s += (v[j].x * v[j].x + v[j].y * v[j].y) + (v[j].z * v[j].z + v[j].w * v[j].w); s2 += (w[j].x * w[j].x + w[j].y * w[j].y) + (w[j].z * w[j].z + w[j].w * w[j].w); }
        const float rstd = 1.0f / sqrtf(wave_sum(s) * (1.f / DM) + NORM_EPS), rstd2 = 1.0f / sqrtf(wave_sum(s2) * (1.f / DM) + NORM_EPS);
        u32x2* o8 = (u32x2*)(F.HB + (size_t)m * DM) + F.lane; u32x2* o82 = (u32x2*)(F.HB + (size_t)m2 * DM) + F.lane;
#pragma unroll
        for (int j = 0; j < 8; ++j) { const f32x4 g = gr[64 * j]; u32x2 a; a.x = pk2(v[j].x * rstd * g.x, v[j].y * rstd * g.y); a.y = pk2(v[j].z * rstd * g.z, v[j].w * rstd * g.w); o8[64 * j] = a;
            u32x2 c; c.x = pk2(w[j].x * rstd2 * g.x, w[j].y * rstd2 * g.y); c.y = pk2(w[j].z * rstd2 * g.z, w[j].w * rstd2 * g.w); o82[64 * j] = c; }
    }
}

constexpr int LSTR = 72;
constexpr int SLOT = 64 * LSTR * 2;
__device__ __forceinline__ f32x4 mm16(const LAS bf16_t* A, int m0, const LAS bf16_t* Bt, int n0, f32x4 acc, int fr, int fq) {
#pragma unroll
    for (int ks = 0; ks < 2; ++ks) {
        const bf16x8 a = *(const LAS bf16x8*)(A + (m0 + fr) * LSTR + ks * 32 + fq * 8);
        const bf16x8 b = *(const LAS bf16x8*)(Bt + (n0 + fr) * LSTR + ks * 32 + fq * 8);
        acc = __builtin_amdgcn_mfma_f32_16x16x32_bf16(a, b, acc, 0, 0, 0);
    }
    return acc;
}

typedef short v4i16_t __attribute__((ext_vector_type(4)));
__device__ __forceinline__ s16x4 tr4(const LAS bf16_t* p) { return __builtin_bit_cast(s16x4, __builtin_amdgcn_ds_read_tr16_b64_v4i16((LAS v4i16_t*)p)); }
__device__ __forceinline__ s16x4 frag_tr16(const LAS bf16_t* X, int k0, int n0, int lane) {
    const int g = lane >> 4, q = (lane & 15) >> 2, p = lane & 3;
    return tr4(X + (k0 + 4 * g + q) * LSTR + n0 + 4 * p);
}
__device__ __forceinline__ bf16x8 frag_tr32(const LAS bf16_t* X, int k0, int n0, int lane) {
    const int g = lane >> 4, q = (lane & 15) >> 2, p = lane & 3;
    const s16x4 lo = tr4(X + (k0 + 8 * g + q) * LSTR + n0 + 4 * p), hi = tr4(X + (k0 + 8 * g + 4 + q) * LSTR + n0 + 4 * p);
    return (bf16x8){lo[0], lo[1], lo[2], lo[3], hi[0], hi[1], hi[2], hi[3]};
}

constexpr int P2_GRP_BYTES = 6 * SLOT + 20 * 64 * 16;
struct KVRegs { u32x4 k0, k1, v0, v1; };
__device__ __forceinline__ void kv_load(KVRegs& R, const bf16_t* p, int key0, int d80, int key1, int d81) {
    R.k0 = *(const u32x4*)(p + (size_t)key0 * NPA + PA_KA + d80); R.k1 = *(const u32x4*)(p + (size_t)key1 * NPA + PA_KA + d81);
    R.v0 = *(const u32x4*)(p + (size_t)key0 * NPA + PA_VA + d80); R.v1 = *(const u32x4*)(p + (size_t)key1 * NPA + PA_VA + d81);
}
__device__ __forceinline__ void kv_store(const KVRegs& R, LAS unsigned char* kvb, int key0, int d80, int key1, int d81) {
    LAS bf16_t* Ks = (LAS bf16_t*)kvb; LAS bf16_t* Vs = (LAS bf16_t*)(kvb + SLOT);
    *(LAS u32x4*)(Ks + key0 * LSTR + d80) = R.k0; *(LAS u32x4*)(Ks + key1 * LSTR + d81) = R.k1; *(LAS u32x4*)(Vs + key0 * LSTR + d80) = R.v0; *(LAS u32x4*)(Vs + key1 * LSTR + d81) = R.v1;
}
constexpr int P2_CPI = 2, P2_NITEMS = BATCH * (NH / 2) * (NCHUNK / P2_CPI);
__device__ __forceinline__ void p2_advance(int cr, int& ci, int& j) { if (j == 8) { ++ci; const int nc = cr * P2_CPI + ci; j = (nc >= 8) ? 0 : 8 - nc; } else ++j; }
__device__ __forceinline__ void p2_attention(Frame& F) {
    const int tid = F.tid, lane = F.lane, wave = F.wave, fr = lane & 15, fq = lane >> 4;
    const int grp = wave >> 2, wq = wave & 3, tg = tid & 255;
    LAS unsigned char* gbase = F.lds + grp * P2_GRP_BYTES;
    LAS f32x4* Tb = (LAS f32x4*)(gbase + 6 * SLOT);
    const int key0 = (tg * 2) >> 3, d80 = ((tg * 2) & 7) * 8, key1 = (tg * 2 + 1) >> 3, d81 = ((tg * 2 + 1) & 7) * 8;
    const float L2E = 1.4426950408889634f;
    volatile LAS int* qslot = (volatile LAS int*)(F.lds + MISC_OFF + 64);
    int hp_prev = -1;
    for (;;) {
        __syncthreads();
        if (tid == 0) *qslot = (int)__hip_atomic_fetch_add(F.queue, 1u, __ATOMIC_RELAXED, __HIP_MEMORY_SCOPE_AGENT);
        __syncthreads();
        const int vb = *qslot;
        if (vb >= P2_NITEMS) break;
        constexpr int NR = NCHUNK / P2_CPI; const int b = vb / (NR * 8), hp = (vb / NR) & 7, cr = vb % NR, h = hp * 2 + grp;
        if (hp != hp_prev) for (int e = tg; e < 20 * 64; e += 256) { const int u = e / 64 - 3, ln = e & 63, lfr = ln & 15, lfq = ln >> 4; f32x4 t4;
#pragma unroll
            for (int r = 0; r < 4; ++r) { int rel = 16 * u + (lfr - 4 * lfq - r); rel = rel < -256 ? -256 : (rel > 256 ? 256 : rel); t4[r] = F.rel_bias[h * 513 + rel + 256]; }
            Tb[e] = t4; }
        hp_prev = hp;
        const float bcst = F.rel_bias[h * 513 + 512];
        const bf16_t* kvbase = F.PA + (size_t)b * SEQ * NPA + h * 64;
        int ci = 0, j = (cr * P2_CPI >= 8) ? 0 : 8 - cr * P2_CPI;
        int lci = ci, lj = j;
        KVRegs RA, RB;
        kv_load(RA, kvbase + (size_t)(cr * P2_CPI + lci - 8 + lj) * 64 * NPA, key0, d80, key1, d81); p2_advance(cr, lci, lj);
        kv_store(RA, gbase, key0, d80, key1, d81);
        kv_load(RA, kvbase + (size_t)(cr * P2_CPI + lci - 8 + lj) * 64 * NPA, key0, d80, key1, d81); p2_advance(cr, lci, lj);
        __syncthreads();
        size_t mrow0 = (size_t)b * SEQ + (size_t)(cr * P2_CPI) * 64;
        bf16x8 qa[2];
#pragma unroll
        for (int ks = 0; ks < 2; ++ks) qa[ks] = *(const bf16x8*)(F.PA + (mrow0 + 16 * wq + fr) * NPA + PA_Q + h * 64 + ks * 32 + fq * 8);
        float mrun = -1e30f, lsum = 0.f; f32x4 o[4];
#pragma unroll
        for (int dt = 0; dt < 4; ++dt) o[dt] = (f32x4){0.f, 0.f, 0.f, 0.f};
        int bufc = 0;
#define P2_STEP(RW, RL) { \
            const bool more1 = (ci < P2_CPI - 1) || (j < 8);                           \
            const bool more2 = lci < P2_CPI;                                           \
            if (more2) { kv_load(RL, kvbase + (size_t)(cr * P2_CPI + lci - 8 + lj) * 64 * NPA, key0, d80, key1, d81); p2_advance(cr, lci, lj); } \
            const LAS bf16_t* Ks = (const LAS bf16_t*)(gbase + bufc * 2 * SLOT); const LAS bf16_t* Vs = (const LAS bf16_t*)(gbase + bufc * 2 * SLOT + SLOT); \
            f32x4 s[4]; \
            _Pragma("unroll") for (int nt = 0; nt < 4; ++nt) { const int u = wq - nt + 4 * (8 - j); \
                s[nt] = (u >= 17) ? (f32x4){bcst, bcst, bcst, bcst} : Tb[(u + 3) * 64 + lane]; \
                _Pragma("unroll") for (int ks = 0; ks < 2; ++ks) { const bf16x8 kb = *(const LAS bf16x8*)(Ks + (16 * nt + fr) * LSTR + ks * 32 + fq * 8); \
                    s[nt] = __builtin_amdgcn_mfma_f32_16x16x32_bf16(kb, qa[ks], s[nt], 0, 0, 0); } } \
            float rmax = fmaxf(fmaxf(s[0][0], s[0][1]), fmaxf(s[0][2], s[0][3])); \
            _Pragma("unroll") for (int nt = 1; nt < 4; ++nt) rmax = fmaxf(rmax, fmaxf(fmaxf(s[nt][0], s[nt][1]), fmaxf(s[nt][2], s[nt][3]))); \
            rmax = fmaxf(rmax, __shfl_xor(rmax, 16)); rmax = fmaxf(rmax, __shfl_xor(rmax, 32)); \
            const float mn = fmaxf(mrun, rmax); const float alpha = __builtin_amdgcn_exp2f((mrun - mn) * L2E); mrun = mn; \
            const float mnl = mn * L2E; float ps = 0.f; \
            _Pragma("unroll") for (int nt = 0; nt < 4; ++nt) _Pragma("unroll") for (int r = 0; r < 4; ++r) { s[nt][r] = __builtin_amdgcn_exp2f(fmaf(s[nt][r], L2E, -mnl)); ps += s[nt][r]; } \
            lsum = lsum * alpha + ps; \
            _Pragma("unroll") for (int dt = 0; dt < 4; ++dt) o[dt] = o[dt] * alpha; \
            bf16x8 pb[2]; \
            _Pragma("unroll") for (int ks = 0; ks < 2; ++ks) { u32x4 w; w.x = pk2(s[2 * ks][0], s[2 * ks][1]); w.y = pk2(s[2 * ks][2], s[2 * ks][3]); w.z = pk2(s[2 * ks + 1][0], s[2 * ks + 1][1]); w.w = pk2(s[2 * ks + 1][2], s[2 * ks + 1][3]); pb[ks] = __builtin_bit_cast(bf16x8, w); } \
            _Pragma("unroll") for (int dt = 0; dt < 4; ++dt) _Pragma("unroll") for (int ks = 0; ks < 2; ++ks) { const s16x4 v0 = frag_tr16(Vs, 32 * ks, 16 * dt, lane), v1 = frag_tr16(Vs, 32 * ks + 16, 16 * dt, lane); \
                    const bf16x8 va = (bf16x8){v0[0], v0[1], v0[2], v0[3], v1[0], v1[1], v1[2], v1[3]}; \
                    o[dt] = __builtin_amdgcn_mfma_f32_16x16x32_bf16(va, pb[ks], o[dt], 0, 0, 0); } \
            if (j == 8) { \
                float l = lsum; l += __shfl_xor(l, 16); l += __shfl_xor(l, 32); \
                const float inv = 1.0f / l; const size_t m = mrow0 + 16 * wq + fr; \
                _Pragma("unroll") for (int dt = 0; dt < 4; ++dt) { const int col = h * 64 + 16 * dt + 4 * fq; \
                    const u32x2 zw = *(const u32x2*)(F.PA + m * NPA + PA_ZA + col); \
                    const float z0 = bflo(zw.x), z1 = bfhi(zw.x), z2 = bflo(zw.y), z3 = bfhi(zw.y); \
                    u32x2 yw; yw.x = pk2(o[dt][0] * inv * z0 * sigmoidf_(z0), o[dt][1] * inv * z1 * sigmoidf_(z1)); yw.y = pk2(o[dt][2] * inv * z2 * sigmoidf_(z2), o[dt][3] * inv * z3 * sigmoidf_(z3)); \
                    *(u32x2*)(F.YCAT + ((size_t)M + m) * DBR + col) = yw; } \
                if (more1) { \
                    mrow0 = (size_t)b * SEQ + (size_t)(cr * P2_CPI + ci + 1) * 64; \
                    _Pragma("unroll") for (int ks = 0; ks < 2; ++ks) qa[ks] = *(const bf16x8*)(F.PA + (mrow0 + 16 * wq + fr) * NPA + PA_Q + h * 64 + ks * 32 + fq * 8); \
                    mrun = -1e30f; lsum = 0.f; \
                    _Pragma("unroll") for (int dt = 0; dt < 4; ++dt) o[dt] = (f32x4){0.f, 0.f, 0.f, 0.f}; \
                } \
            } \
            const int bufn = (bufc == 2) ? 0 : bufc + 1; \
            if (more1) kv_store(RW, gbase + bufn * 2 * SLOT, key0, d80, key1, d81); \
            __syncthreads(); \
            if (!more1) break; \
            p2_advance(cr, ci, j); bufc = bufn; }
        for (;;) {
            P2_STEP(RA, RB)
            P2_STEP(RB, RA)
        }
#undef P2_STEP
    }
}

constexpr int FSTR = 68;
constexpr int DSTR = 24;
__device__ __forceinline__ f32x4 mfma16(s16x4 a, s16x4 b, f32x4 c) {
    const bf16x8 a8 = (bf16x8){a[0], a[1], a[2], a[3], 0, 0, 0, 0}, b8 = (bf16x8){b[0], b[1], b[2], b[3], 0, 0, 0, 0};
    return __builtin_amdgcn_mfma_f32_16x16x32_bf16(a8, b8, c, 0, 0, 0); }
__device__ __forceinline__ s16x4 cvt_hi(const f32x4 v) { u32x2 w; w.x = pk2(v[0], v[1]); w.y = pk2(v[2], v[3]); return __builtin_bit_cast(s16x4, w); }
__device__ __forceinline__ s16x4 cvt_lo(const f32x4 v, const s16x4 hi) { const u32x2 h = __builtin_bit_cast(u32x2, hi);
    u32x2 w; w.x = pk2(v[0] - bflo(h.x), v[1] - bfhi(h.x)); w.y = pk2(v[2] - bflo(h.y), v[3] - bfhi(h.y)); return __builtin_bit_cast(s16x4, w); }
struct P3Loads { u32x4 w2, a2, pr, pk, pv, qr, qk, qv; f32x4 mur[2], muk[2], muv[2], kkp[2], kap[2], rkp[2]; };
__device__ __forceinline__ void p3_load(Frame& F, P3Loads& G, int h, size_t m, int t_e, int c8, bool hasprev) {
    const u32x4 zero4 = (u32x4){0u, 0u, 0u, 0u};
    G.w2 = *(const u32x4*)(F.W2T + (size_t)(h * 64 + t_e) * 64 + c8); G.a2 = *(const u32x4*)(F.A2T + (size_t)(h * 64 + t_e) * 64 + c8);
    const bf16_t* rowp = F.PA + m * NPA + h * 64 + c8;
    G.pr = *(const u32x4*)(rowp + PA_R); G.pk = *(const u32x4*)(rowp + PA_K); G.pv = *(const u32x4*)(rowp + PA_V);
    G.qr = hasprev ? *(const u32x4*)(rowp - NPA + PA_R) : zero4; G.qk = hasprev ? *(const u32x4*)(rowp - NPA + PA_K) : zero4; G.qv = hasprev ? *(const u32x4*)(rowp - NPA + PA_V) : zero4;
    const int ch0 = h * 64 + c8;
#pragma unroll
    for (int q = 0; q < 2; ++q) { G.mur[q] = *(const f32x4*)(F.mu_rkv + ch0 + 4 * q); G.muk[q] = *(const f32x4*)(F.mu_rkv + DBR + ch0 + 4 * q); G.muv[q] = *(const f32x4*)(F.mu_rkv + 2 * DBR + ch0 + 4 * q);
        G.kkp[q] = *(const f32x4*)(F.k_k + ch0 + 4 * q); G.kap[q] = *(const f32x4*)(F.k_a + ch0 + 4 * q); G.rkp[q] = *(const f32x4*)(F.r_k + ch0 + 4 * q); }
}
__device__ __forceinline__ void p3_prep(Frame& F) {
    const int wave = F.wave;
    LAS unsigned char* L = F.lds;
    LAS bf16_t* X_A = (LAS bf16_t*)(L + 0 * SLOT);
    LAS bf16_t* X_B = (LAS bf16_t*)(L + 1 * SLOT);
    LAS bf16_t* X_K = (LAS bf16_t*)(L + 2 * SLOT);
    LAS bf16_t* X_R = (LAS bf16_t*)(L + 3 * SLOT);
    LAS bf16_t* X_V = (LAS bf16_t*)(L + 4 * SLOT);
    LAS bf16_t* S_TW = (LAS bf16_t*)(L + 5 * SLOT);
    LAS bf16_t* S_TA = (LAS bf16_t*)(L + 6 * SLOT);
    LAS bf16_t* A_AB = (LAS bf16_t*)(L + 7 * SLOT);
    LAS bf16_t* A_AK = (LAS bf16_t*)(L + 8 * SLOT);
    LAS bf16_t* A_RB = (LAS bf16_t*)(L + 9 * SLOT);
    LAS bf16_t* A_RK = (LAS bf16_t*)(L + 10 * SLOT);
    LAS bf16_t* DB = (LAS bf16_t*)(L + 11 * SLOT);
    LAS float* CLf = (LAS float*)(L + 12 * SLOT);
    LAS float* Af = CLf + 64 * FSTR;
    LAS float* GL = Af + 64 * FSTR;
    LAS bf16_t* ST_Q = A_AK; LAS bf16_t* ST_Y = X_A; LAS bf16_t* ST_M = X_V; LAS bf16_t* ST_N = (LAS bf16_t*)CLf;
    const int mt = wave >> 1, ntb = (wave & 1) * 2;
    for (int vb = F.bid; vb < 256; vb += F.G) {
        const int b = vb >> 7, c = vb & 127; const size_t mrow0 = (size_t)b * SEQ + (size_t)c * 64;
        {
            const int t_e = F.tid >> 3, c8 = (F.tid & 7) * 8; const size_t m = mrow0 + t_e; const bool hasprev = (c > 0) || (t_e > 0);
            const u32x4 zero4 = (u32x4){0u, 0u, 0u, 0u};
            float sw[8], sa[8];
#pragma unroll
            for (int e = 0; e < 8; ++e) { sw[e] = 0.f; sa[e] = 0.f; }
#pragma unroll
            for (int q = 0; q < 4; ++q) { const bf16_t* slab = F.PL + (size_t)q * ((size_t)M * NPL);
                const u32x4 g_law = *(const u32x4*)(slab + m * NPL + 0 + c8), g_laa = *(const u32x4*)(slab + m * NPL + 128 + c8);
                const u32x4 g_lbw = hasprev ? *(const u32x4*)(slab + (m - 1) * NPL + 64 + c8) : zero4, g_lba = hasprev ? *(const u32x4*)(slab + (m - 1) * NPL + 192 + c8) : zero4;
                float law[8], laa[8], lbw[8], lba[8];
                unpack8(g_law, law); unpack8(g_laa, laa); unpack8(g_lbw, lbw); unpack8(g_lba, lba);
#pragma unroll
                for (int e = 0; e < 8; ++e) { sw[e] += law[e] + lbw[e]; sa[e] += laa[e] + lba[e]; } }
            float tw[8], ta[8];
#pragma unroll
            for (int e = 0; e < 8; ++e) { tw[e] = tanhf_(sw[e]); ta[e] = sa[e]; }
            __syncthreads();
            *(LAS u32x4*)(S_TW + t_e * LSTR + c8) = pack8(tw); *(LAS u32x4*)(S_TA + t_e * LSTR + c8) = pack8(ta);
        }
        P3Loads G; p3_load(F, G, 0, mrow0 + (F.tid >> 3), F.tid >> 3, (F.tid & 7) * 8, (c > 0) || ((F.tid >> 3) > 0));
        for (int h = 0; h < NH; ++h) {
            int tid = F.tid; asm volatile("" : "+v"(tid));
            const int lane = tid & 63, fr = lane & 15, fq = lane >> 4;
            const int t_e = tid >> 3, c8 = (tid & 7) * 8;
            const size_t m = mrow0 + t_e; const bool hasprev = (c > 0) || (t_e > 0);
            const u32x4 g_w2 = G.w2, g_a2 = G.a2, g_pr = G.pr, g_pk = G.pk, g_pv = G.pv, g_qr = G.qr, g_qk = G.qk, g_qv = G.qv;
            float mur[8], muk[8], muv[8], kkp[8], kap[8], rkp[8];
#pragma unroll
            for (int e = 0; e < 8; ++e) { mur[e] = G.mur[e >> 2][e & 3]; muk[e] = G.muk[e >> 2][e & 3]; muv[e] = G.muv[e >> 2][e & 3]; kkp[e] = G.kkp[e >> 2][e & 3]; kap[e] = G.kap[e >> 2][e & 3]; rkp[e] = G.rkp[e >> 2][e & 3]; }
            __syncthreads();
            *(LAS u32x4*)(A_AB + t_e * LSTR + c8) = g_w2; *(LAS u32x4*)(A_AK + t_e * LSTR + c8) = g_a2;
            __syncthreads();
#pragma unroll
            for (int q = 0; q < 2; ++q) { const int nt = ntb + q; const int ch = 16 * nt + fr;
                f32x4 dw = (f32x4){0.f, 0.f, 0.f, 0.f}, da = (f32x4){0.f, 0.f, 0.f, 0.f};
#pragma unroll
                for (int ks = 0; ks < 2; ++ks) {
                    const bf16x8 aw = *(const LAS bf16x8*)(S_TW + (16 * mt + fr) * LSTR + ks * 32 + fq * 8), aa = *(const LAS bf16x8*)(S_TA + (16 * mt + fr) * LSTR + ks * 32 + fq * 8);
                    const bf16x8 bw = *(const LAS bf16x8*)(A_AB + ch * LSTR + ks * 32 + fq * 8), ba = *(const LAS bf16x8*)(A_AK + ch * LSTR + ks * 32 + fq * 8);
                    dw = __builtin_amdgcn_mfma_f32_16x16x32_bf16(aw, bw, dw, 0, 0, 0); da = __builtin_amdgcn_mfma_f32_16x16x32_bf16(aa, ba, da, 0, 0, 0); }
                const float w0v = F.w0[h * 64 + ch], a0v = F.a0[h * 64 + ch];
#pragma unroll
                for (int r = 0; r < 4; ++r) { const int t = 16 * mt + 4 * fq + r;
                    CLf[t * FSTR + ch] = -DECAY_SCALE * sigmoidf_(w0v + dw[r]); Af[t * FSTR + ch] = sigmoidf_(a0v + da[r]); } }
            __syncthreads();
#pragma unroll
            for (int q = 0; q < 8; ++q) { const int ch = wave * 8 + q; float xv = CLf[lane * FSTR + ch];
#pragma unroll
                for (int off = 1; off < 64; off <<= 1) { const float y = __shfl_up(xv, off); if (lane >= off) xv += y; }
                CLf[lane * FSTR + ch] = xv; }
            __syncthreads();
            {
                float pr[8], pk[8], pv[8], qr[8], qk[8], qv[8];
                unpack8(g_pr, pr); unpack8(g_pk, pk); unpack8(g_pv, pv); unpack8(g_qr, qr); unpack8(g_qk, qk); unpack8(g_qv, qv);
                float rr[8], kk[8], vv[8], kn[8], av[8], cl[8], clp[8]; float nrm = 0.f;
#pragma unroll
                for (int e = 0; e < 8; ++e) {
                    rr[e] = pr[e] + (qr[e] - pr[e]) * mur[e]; kk[e] = pk[e] + (qk[e] - pk[e]) * muk[e]; vv[e] = pv[e] + (qv[e] - pv[e]) * muv[e];
                    kn[e] = kk[e] * kkp[e]; nrm += kn[e] * kn[e];
                    av[e] = Af[t_e * FSTR + c8 + e]; cl[e] = CLf[t_e * FSTR + c8 + e]; clp[e] = (t_e > 0) ? CLf[(t_e - 1) * FSTR + c8 + e] : 0.f; }
                nrm += __shfl_xor(nrm, 1); nrm += __shfl_xor(nrm, 2); nrm += __shfl_xor(nrm, 4);
                const float inrm = 1.0f / fmaxf(sqrtf(nrm), 1e-12f);
                float at_[8], bt_[8], kt_[8], rt_[8]; float bon = 0.f;
#pragma unroll
                for (int e = 0; e < 8; ++e) {
                    const float kkn = kn[e] * inrm; const float kmod = kk[e] * (1.0f + (av[e] - 1.0f) * kap[e]);
                    const float gin = __expf(cl[e]), gex = __expf(clp[e]), ginv = __expf(-cl[e]);
                    at_[e] = -kkn * gex; bt_[e] = kkn * av[e] * ginv; kt_[e] = kmod * ginv; rt_[e] = rr[e] * gin;
                    bon += rr[e] * kmod * rkp[e]; }
                bon += __shfl_xor(bon, 1); bon += __shfl_xor(bon, 2); bon += __shfl_xor(bon, 4);
                if ((tid & 7) == 0) F.BONUS[m * NH + h] = bon;
                if (t_e == 63) {
#pragma unroll
                    for (int e = 0; e < 8; ++e) GL[c8 + e] = __expf(cl[e]); }
                *(LAS u32x4*)(X_A + t_e * LSTR + c8) = pack8(at_); *(LAS u32x4*)(X_B + t_e * LSTR + c8) = pack8(bt_);
                *(LAS u32x4*)(X_K + t_e * LSTR + c8) = pack8(kt_); *(LAS u32x4*)(X_R + t_e * LSTR + c8) = pack8(rt_);
                *(LAS u32x4*)(X_V + t_e * LSTR + c8) = pack8(vv);
            }
            __syncthreads();
            if (h + 1 < NH) p3_load(F, G, h + 1, m, t_e, c8, hasprev);
#pragma unroll
            for (int q = 0; q < 2; ++q) { const int it = mt, tt = ntb + q; const int t = 16 * tt + fr, i0 = 16 * it + 4 * fq;
                const f32x4 z4 = (f32x4){0.f, 0.f, 0.f, 0.f};
                const f32x4 d_ab = mm16(X_B, 16 * it, X_A, 16 * tt, z4, fr, fq), d_ak = mm16(X_K, 16 * it, X_A, 16 * tt, z4, fr, fq);
                const f32x4 d_rb = mm16(X_B, 16 * it, X_R, 16 * tt, z4, fr, fq), d_rk = mm16(X_K, 16 * it, X_R, 16 * tt, z4, fr, fq);
                f32x4 e_ab, e_ak, e_rb, e_rk;
#pragma unroll
                for (int r = 0; r < 4; ++r) { const int i = i0 + r; e_ab[r] = (i < t) ? d_ab[r] : 0.f; e_ak[r] = (i < t) ? d_ak[r] : 0.f; e_rb[r] = (i <= t) ? d_rb[r] : 0.f; e_rk[r] = (i <= t) ? d_rk[r] : 0.f; }
                *(LAS s16x4*)(A_AB + t * LSTR + i0) = cvt_hi(e_ab); *(LAS s16x4*)(A_AK + t * LSTR + i0) = cvt_hi(e_ak);
                *(LAS s16x4*)(A_RB + t * LSTR + i0) = cvt_hi(e_rb); *(LAS s16x4*)(A_RK + t * LSTR + i0) = cvt_hi(e_rk); }
            __syncthreads();
            f32x4 rhs[4]; bf16x8 vf[2];
            const int ct = wave & 3;
            if (wave < 4) {
                const s16x4 af = *(const LAS s16x4*)(A_AB + (16 * wave + fr) * LSTR + 16 * wave + 4 * fq);
                f32x4 iden;
#pragma unroll
                for (int r = 0; r < 4; ++r) iden[r] = (4 * fq + r == fr) ? 1.0f : 0.0f;
                f32x4 T = iden;
#pragma unroll
                for (int it = 0; it < 15; ++it) { const s16x4 hi = cvt_hi(T), lo = cvt_lo(T, hi); f32x4 acc = mfma16(af, hi, iden); T = mfma16(af, lo, acc); }
#pragma unroll
                for (int r = 0; r < 4; ++r) DB[(16 * wave + 4 * fq + r) * DSTR + fr] = f2bf(T[r]);
#pragma unroll
                for (int bi = 0; bi < 4; ++bi)
#pragma unroll
                    for (int r = 0; r < 4; ++r) rhs[bi][r] = bf2f(X_A[(16 * bi + 4 * fq + r) * LSTR + 16 * ct + fr]);
                vf[0] = (bf16x8){0, 0, 0, 0, 0, 0, 0, 0}; vf[1] = vf[0];
            } else {
#pragma unroll
                for (int ks = 0; ks < 2; ++ks) vf[ks] = frag_tr32(X_V, ks * 32, 16 * ct, lane);
#pragma unroll
                for (int bi = 0; bi < 4; ++bi) { rhs[bi] = (f32x4){0.f, 0.f, 0.f, 0.f};
#pragma unroll
                    for (int ks = 0; ks < 2; ++ks) rhs[bi] = __builtin_amdgcn_mfma_f32_16x16x32_bf16(*(const LAS bf16x8*)(A_AK + (16 * bi + fr) * LSTR + ks * 32 + fq * 8), vf[ks], rhs[bi], 0, 0, 0); }
            }
            __syncthreads();
            s16x4 xb[4];
#pragma unroll
            for (int bi = 0; bi < 4; ++bi) {
                f32x4 acc = rhs[bi];
#pragma unroll
                for (int bj = 0; bj < 4; ++bj) if (bj < bi) acc = mfma16(*(const LAS s16x4*)(A_AB + (16 * bi + fr) * LSTR + 16 * bj + 4 * fq), xb[bj], acc);
                const s16x4 hi = cvt_hi(acc), lo = cvt_lo(acc, hi); const s16x4 df = *(const LAS s16x4*)(DB + (16 * bi + fr) * DSTR + 4 * fq);
                f32x4 x = mfma16(df, hi, (f32x4){0.f, 0.f, 0.f, 0.f}); x = mfma16(df, lo, x);
                xb[bi] = cvt_hi(x);
            }
            const int col = 16 * ct + fr; const int c4 = 16 * ct + 4 * fq;
#pragma unroll
            for (int bi = 0; bi < 4; ++bi) {
                f32x4 acc; const int t = 16 * bi + fr;
                if (wave < 4) { const u32x2 rw = *(const LAS u32x2*)(X_R + t * LSTR + c4); acc[0] = bflo(rw.x); acc[1] = bfhi(rw.x); acc[2] = bflo(rw.y); acc[3] = bfhi(rw.y); }
                else {
                    acc = (f32x4){0.f, 0.f, 0.f, 0.f};
#pragma unroll
                    for (int ks = 0; ks < 2; ++ks) acc = __builtin_amdgcn_mfma_f32_16x16x32_bf16(vf[ks], *(const LAS bf16x8*)(A_RK + t * LSTR + ks * 32 + fq * 8), acc, 0, 0, 0);
                }
#pragma unroll
                for (int bj = 0; bj < 4; ++bj) if (bj <= bi) acc = mfma16(xb[bj], *(const LAS s16x4*)(A_RB + t * LSTR + 16 * bj + 4 * fq), acc);
                const s16x4 o4 = cvt_hi(acc);
                if (wave < 4) *(LAS s16x4*)(ST_Q + t * LSTR + c4) = o4; else *(LAS s16x4*)(ST_Y + t * LSTR + c4) = o4;
            }
#pragma unroll
            for (int mk = 0; mk < 4; ++mk) {
                f32x4 acc = (f32x4){0.f, 0.f, 0.f, 0.f};
                if (wave < 4) {
#pragma unroll
                    for (int bj = 0; bj < 4; ++bj) acc = mfma16(xb[bj], frag_tr16(X_B, 16 * bj, 16 * mk, lane), acc);
                    const int k = 16 * mk + fr; const float gl = GL[k];
#pragma unroll
                    for (int r = 0; r < 4; ++r) acc[r] = gl * (acc[r] + ((k == c4 + r) ? 1.0f : 0.0f));
                    *(LAS s16x4*)(ST_M + k * LSTR + 32 * (ct >> 1) + 8 * fq + 4 * (ct & 1)) = cvt_hi(acc);
                } else {
#pragma unroll
                    for (int ks = 0; ks < 2; ++ks) acc = __builtin_amdgcn_mfma_f32_16x16x32_bf16(frag_tr32(X_K, ks * 32, 16 * mk, lane), vf[ks], acc, 0, 0, 0);
#pragma unroll
                    for (int bj = 0; bj < 4; ++bj) acc = mfma16(frag_tr16(X_B, 16 * bj, 16 * mk, lane), xb[bj], acc);
                    const f32x4 gl4 = *(const LAS f32x4*)(GL + 16 * mk + 4 * fq);
                    acc = acc * gl4;
                    *(LAS s16x4*)(ST_N + col * LSTR + 16 * mk + 4 * fq) = cvt_hi(acc);
                }
            }
            __syncthreads();
            { const size_t mr = mrow0 + t_e;
              const size_t ub = (size_t)((b * NH + h) * NCHUNK + c) * 4096 + t_e * 64 + c8;
              *(u32x4*)(F.QD + ub) = *(const LAS u32x4*)(ST_Q + t_e * LSTR + c8);
              *(u32x4*)(F.YCAT + mr * DBR + h * 64 + c8) = *(const LAS u32x4*)(ST_Y + t_e * LSTR + c8);
              *(u32x4*)(F.MD + ub) = *(const LAS u32x4*)(ST_M + t_e * LSTR + c8);
              *(u32x4*)(F.ND + ub) = *(const LAS u32x4*)(ST_N + t_e * LSTR + c8); }
        }
    }
}

struct ScanBuf { u32x4 m[4][2]; u32x2 nn[4]; };
__device__ __forceinline__ void scan_load(ScanBuf& B, const bf16_t* PA, size_t mrow0, int h, int v, int fr, int fq) {
#pragma unroll
    for (int i = 0; i < 4; ++i) { const bf16_t* mrowp = PA + (mrow0 + 16 * i + fr) * NPA + PA_KA + h * 64;
#pragma unroll
        for (int ks = 0; ks < 2; ++ks) B.m[i][ks] = *(const u32x4*)(mrowp + 32 * ks + 8 * fq);
        B.nn[i] = *(const u32x2*)(PA + (mrow0 + v) * NPA + PA_VA + h * 64 + 16 * i + 4 * fq); }
}
__device__ __forceinline__ void scan_step(f32x4 (&st)[4], const ScanBuf& B, bf16_t* sp, int fq) {
    u32x2 pk[4];
#pragma unroll
    for (int i = 0; i < 4; ++i) { pk[i].x = pk2(st[i][0], st[i][1]); pk[i].y = pk2(st[i][2], st[i][3]); *(u32x2*)(sp + 16 * i + 4 * fq) = pk[i]; }
    bf16x8 bfr[2];
#pragma unroll
    for (int ks = 0; ks < 2; ++ks) { u32x4 w; w.x = pk[2 * ks].x; w.y = pk[2 * ks].y; w.z = pk[2 * ks + 1].x; w.w = pk[2 * ks + 1].y; bfr[ks] = __builtin_bit_cast(bf16x8, w); }
#pragma unroll
    for (int i = 0; i < 4; ++i) { f32x4 n; n[0] = bflo(B.nn[i].x); n[1] = bfhi(B.nn[i].x); n[2] = bflo(B.nn[i].y); n[3] = bfhi(B.nn[i].y);
#pragma unroll
        for (int ks = 0; ks < 2; ++ks) n = __builtin_amdgcn_mfma_f32_16x16x32_bf16(__builtin_bit_cast(bf16x8, B.m[i][ks]), bfr[ks], n, 0, 0, 0);
        st[i] = n; }
}
constexpr int SC_NST = 2;
constexpr int SC_STEP_BYTES = 8192 + 2048, SC_SLOT_BYTES = SC_NST * SC_STEP_BYTES, SC_NSLOT = 6;
constexpr int SC_SO_OFF = SC_NSLOT * SC_SLOT_BYTES, SC_SO_STEP = 16 * LSTR * 2, SC_SO_SLOT = SC_NST * SC_SO_STEP;
__device__ __forceinline__ void scan_dma(Frame& F, int wave, int lane, int it, LAS unsigned char* slot, size_t row0, int h, int vt) {
    const int r8 = lane >> 3, cg = ((lane & 7) ^ r8) * 8;
#pragma unroll
    for (int q = 0; q < 4; ++q) { const int j = (wave - 1) + 5 * q;
        { const int st = j / 10, w10 = j % 10; const size_t ubase = row0;
            const bf16_t* g = (w10 < 8) ? F.MD + ubase + (size_t)(SC_NST * it + st) * 4096 + (8 * w10 + r8) * 64 + cg : F.ND + ubase + (size_t)(SC_NST * it + st) * 4096 + (16 * vt + 8 * (w10 - 8) + r8) * 64 + cg;
            __builtin_amdgcn_global_load_lds((const unsigned*)g, (LAS unsigned*)(slot + st * SC_STEP_BYTES + w10 * 1024), 16, 0, 0); } }
}
__device__ __forceinline__ void scan_flush(int L2, int it, const LAS unsigned char* so, bf16_t* sp0v0) {
#pragma unroll
    for (int st = 0; st < SC_NST; ++st) { const int rr = (L2 >> 3) & 15, ch = L2 & 7;
        *(u32x4*)(sp0v0 + (size_t)(SC_NST * it + st) * 4096 + rr * 64 + ch * 8) = *(const LAS u32x4*)(so + st * SC_SO_STEP + rr * (LSTR * 2) + ch * 16); }
}
__device__ __forceinline__ void p4_scan(Frame& F) {
    const int lane = F.lane, wave = F.wave, fr = lane & 15, fq = lane >> 4;
    constexpr int NIT = NCHUNK / SC_NST;
    for (int vb = F.bid; vb < 128; vb += F.G) {
        const int b = vb >> 6, h = (vb >> 2) & 15, vt = vb & 3;
        const size_t row0 = (size_t)((b * NH + h) * NCHUNK) * 4096;
        const int L = (wave - 1) * 64 + lane;
        bf16_t* sp0v0 = F.STATES + ((size_t)((b * NH + h) * NCHUNK)) * 4096 + (16 * vt) * 64;
        __syncthreads();
        if (wave >= 1 && wave <= 5) {
#pragma unroll
            for (int p = 0; p < 5; ++p) scan_dma(F, wave, lane, p, F.lds + p * SC_SLOT_BYTES, row0, h, vt);
        }
        asm volatile("s_waitcnt vmcnt(0)\n\ts_barrier" ::: "memory");
        f32x4 st[4];
#pragma unroll
        for (int i = 0; i < 4; ++i) st[i] = (f32x4){0.f, 0.f, 0.f, 0.f};
        int cur = 0, cur3 = 0;
        for (int it = 0; it < NIT; ++it) {
            if (wave >= 6) {
                if (it >= 1) scan_flush(L - 320, it - 1, F.lds + SC_SO_OFF + ((cur3 == 0) ? 2 : cur3 - 1) * SC_SO_SLOT, sp0v0);
            } else if (wave >= 1) {
                const int s5 = (cur == 0) ? 5 : cur - 1;
                if (it + 5 < NIT) scan_dma(F, wave, lane, it + 5, F.lds + s5 * SC_SLOT_BYTES, row0, h, vt);
                asm volatile("s_waitcnt vmcnt(16)" ::: "memory");
            } else {
                const LAS unsigned char* slot = F.lds + cur * SC_SLOT_BYTES; LAS unsigned char* so = F.lds + SC_SO_OFF + cur3 * SC_SO_SLOT;
#pragma unroll
                for (int s4 = 0; s4 < SC_NST; ++s4) {
                    u32x2 pk[4];
#pragma unroll
                    for (int i = 0; i < 4; ++i) { pk[i].x = pk2(st[i][0], st[i][1]); pk[i].y = pk2(st[i][2], st[i][3]); *(LAS u32x2*)(so + s4 * SC_SO_STEP + fr * (LSTR * 2) + (16 * i + 4 * fq) * 2) = pk[i]; }
                    bf16x8 bfr[2];
#pragma unroll
                    for (int ks = 0; ks < 2; ++ks) { u32x4 w; w.x = pk[2 * ks].x; w.y = pk[2 * ks].y; w.z = pk[2 * ks + 1].x; w.w = pk[2 * ks + 1].y; bfr[ks] = __builtin_bit_cast(bf16x8, w); }
#pragma unroll
                    for (int i = 0; i < 4; ++i) {
                        const u32x2 nn = *(const LAS u32x2*)(slot + s4 * SC_STEP_BYTES + 8192 + fr * 128 + (((2 * i + (fq >> 1)) ^ (fr & 7)) * 16) + (fq & 1) * 8);
                        f32x4 n; n[0] = bflo(nn.x); n[1] = bfhi(nn.x); n[2] = bflo(nn.y); n[3] = bfhi(nn.y);
#pragma unroll
                        for (int ks = 0; ks < 2; ++ks) { const u32x4 mf = *(const LAS u32x4*)(slot + s4 * SC_STEP_BYTES + (16 * i + fr) * 128 + (((4 * ks + fq) ^ (fr & 7)) * 16));
                            n = __builtin_amdgcn_mfma_f32_16x16x32_bf16(__builtin_bit_cast(bf16x8, mf), bfr[ks], n, 0, 0, 0); }
                        st[i] = n; }
                }
            }
            asm volatile("s_waitcnt lgkmcnt(0)\n\ts_barrier" ::: "memory");
            cur = (cur == 5) ? 0 : cur + 1; cur3 = (cur3 == 2) ? 0 : cur3 + 1;
        }
        if (wave >= 6) scan_flush(L - 320, NIT - 1, F.lds + SC_SO_OFF + ((cur3 == 0) ? 2 : cur3 - 1) * SC_SO_SLOT, sp0v0);
    }
}

__device__ __forceinline__ void p5_out(Frame& F) {
    const int lane = F.lane, wave = F.wave, fr = lane & 15, fq = lane >> 4, grp = wave >> 2, wq = wave & 3;
    for (int u = F.bid * 2 + grp; u < BATCH * NH * NCHUNK; u += F.G * 2) {
        const int c = u & 127, h = (u >> 7) & 15, b = u >> 11; const size_t mrow0 = (size_t)b * SEQ + (size_t)c * 64;
        const bf16_t* sp = F.STATES + (size_t)u * 4096;
        const int t = 16 * wq + fr; const size_t m = mrow0 + t; const bool hasprev = (c > 0) || (t > 0);
        bf16x8 qa[2];
#pragma unroll
        for (int ks = 0; ks < 2; ++ks) qa[ks] = *(const bf16x8*)(F.QD + (size_t)u * 4096 + t * 64 + ks * 32 + fq * 8);
        f32x4 y[4];
#pragma unroll
        for (int nt = 0; nt < 4; ++nt) {
            const u32x2 yl = *(const u32x2*)(F.YCAT + m * DBR + h * 64 + 16 * nt + 4 * fq);
            y[nt] = (f32x4){bflo(yl.x), bfhi(yl.x), bflo(yl.y), bfhi(yl.y)};
#pragma unroll
            for (int ks = 0; ks < 2; ++ks) { const bf16x8 sb = *(const bf16x8*)(sp + (16 * nt + fr) * 64 + ks * 32 + fq * 8);
                y[nt] = __builtin_amdgcn_mfma_f32_16x16x32_bf16(sb, qa[ks], y[nt], 0, 0, 0); } }
        float s = 0.f;
#pragma unroll
        for (int nt = 0; nt < 4; ++nt) s += (y[nt][0] + y[nt][1]) + (y[nt][2] + y[nt][3]);
        s += __shfl_xor(s, 16); s += __shfl_xor(s, 32);
        const float mean = s * (1.0f / 64.0f);
        float q = 0.f;
#pragma unroll
        for (int nt = 0; nt < 4; ++nt)
#pragma unroll
            for (int r = 0; r < 4; ++r) { const float d = y[nt][r] - mean; q += d * d; }
        q += __shfl_xor(q, 16); q += __shfl_xor(q, 32);
        const float rstd = 1.0f / sqrtf(q * (1.0f / 64.0f) + GN_EPS);
        const float bon = F.BONUS[m * NH + h];
#pragma unroll
        for (int nt = 0; nt < 4; ++nt) { const int ch = h * 64 + 16 * nt + 4 * fq;
            const u32x2 pvw = *(const u32x2*)(F.PA + m * NPA + PA_V + ch); const u32x2 qvw = hasprev ? *(const u32x2*)(F.PA + (m - 1) * NPA + PA_V + ch) : (u32x2){0u, 0u};
            const u32x2 zw = *(const u32x2*)(F.PA + m * NPA + PA_ZR + ch);
            const f32x4 mu4 = *(const f32x4*)(F.mu_rkv + 2 * DBR + ch), g4 = *(const f32x4*)(F.lnx_g + ch), b4 = *(const f32x4*)(F.lnx_b + ch);
            const f32x4 pv = (f32x4){bflo(pvw.x), bfhi(pvw.x), bflo(pvw.y), bfhi(pvw.y)}, qv = (f32x4){bflo(qvw.x), bfhi(qvw.x), bflo(qvw.y), bfhi(qvw.y)};
            const f32x4 z = (f32x4){bflo(zw.x), bfhi(zw.x), bflo(zw.y), bfhi(zw.y)};
            const f32x4 vv = pv + (qv - pv) * mu4;
            f32x4 o4;
#pragma unroll
            for (int r = 0; r < 4; ++r) o4[r] = ((y[nt][r] - mean) * rstd * g4[r] + b4[r] + bon * vv[r]) * (z[r] * sigmoidf_(z[r]));
            u32x2 ow; ow.x = pk2(o4[0], o4[1]); ow.y = pk2(o4[2], o4[3]);
            *(u32x2*)(F.YCAT + m * DBR + ch) = ow; }
    }
}

__device__ __forceinline__ void p8_final(Frame& F) {
    const int gw = F.bid * NWAVES + F.wave, NGW = F.G * NWAVES;
    for (int m0 = gw; m0 < M; m0 += 2 * NGW) {
#pragma unroll
        for (int q = 0; q < 2; ++q) { const int m = (m0 + q * NGW < M) ? m0 + q * NGW : m0;
            const f32x4* xr = (const f32x4*)(F.x + (size_t)m * DM) + 2 * F.lane; const f32x4* gr = (const f32x4*)F.post_g + 2 * F.lane;
            const u32x4* orow = (const u32x4*)(F.OBF + (size_t)m * DM) + F.lane;
            f32x4* outr = (f32x4*)(F.out + (size_t)m * DM) + 2 * F.lane;
            u32x4 ow[4]; f32x4 x0[4], x1[4];
#pragma unroll
            for (int jj = 0; jj < 4; ++jj) { ow[jj] = orow[64 * jj]; x0[jj] = xr[128 * jj]; x1[jj] = xr[128 * jj + 1]; }
            float ss = (F.lane < 32) ? F.SSP[(size_t)m * 32 + F.lane] : 0.f;
            ss = wave_sum(ss);
            const float rstd = 1.0f / sqrtf(ss * (1.f / DM) + NORM_EPS);
#pragma unroll
            for (int jj = 0; jj < 4; ++jj) { float ov[8]; unpack8(ow[jj], ov);
                const f32x4 g0 = gr[128 * jj], g1 = gr[128 * jj + 1];
                outr[128 * jj] = x0[jj] + (f32x4){ov[0], ov[1], ov[2], ov[3]} * rstd * g0; outr[128 * jj + 1] = x1[jj] + (f32x4){ov[4], ov[5], ov[6], ov[7]} * rstd * g1; }
        }
    }
}

struct Args { const float* in[22]; float* out; unsigned char* ws; int ph_lo, ph_hi, li, pad; };
constexpr int N_PHASES = 9;
__global__ void __launch_bounds__(NTHREADS, 2) mk_fwd(Args args) {
    extern __shared__ __attribute__((aligned(16))) unsigned char lds[];
    Frame F;
    F.lds = (LAS unsigned char*)lds;
    F.tid = threadIdx.x; F.lane = F.tid & 63; F.wave = __builtin_amdgcn_readfirstlane(F.tid >> 6);
    F.G = gridDim.x; F.bid = blockIdx.x;
    unsigned char* ws = args.ws;
    F.x = args.in[0]; F.pre_g = args.in[1]; F.post_g = args.in[2]; F.w_in = args.in[3]; F.mu_rkv = args.in[4]; F.mu_wa = args.in[5]; F.w0 = args.in[6]; F.w1 = args.in[7]; F.w2 = args.in[8];
    F.a0 = args.in[9]; F.a1 = args.in[10]; F.a2 = args.in[11]; F.k_k = args.in[12]; F.k_a = args.in[13]; F.r_k = args.in[14]; F.lnx_g = args.in[15]; F.lnx_b = args.in[16]; F.rel_bias = args.in[17];
    F.w_br = args.in[18]; F.w_ba = args.in[19]; F.b_merge = args.in[20]; F.w_out = args.in[21]; F.out = args.out;
    F.HB = (bf16_t*)((unsigned char*)args.out + DO_HB); F.WIN_T = (bf16_t*)((unsigned char*)args.out + DO_WIN); F.STATES = (bf16_t*)((unsigned char*)args.out + DO_STATES);
    F.MD = (bf16_t*)((unsigned char*)args.out + DO_MD); F.ND = (bf16_t*)((unsigned char*)args.out + DO_ND); F.QD = (bf16_t*)((unsigned char*)args.out + DO_QD);
    F.WCAT_T = (bf16_t*)(ws + WS_WCAT); F.WOUT_T = (bf16_t*)(ws + WS_WOUT); F.W2T = (bf16_t*)(ws + WS_W2T); F.A2T = F.W2T + DBR * 64;
    F.BONUS = (float*)(ws + WS_BONUS); F.SSP = (float*)(ws + WS_SSP); F.PL = (bf16_t*)(ws + WS_PLS); F.PG = (bf16_t*)(ws + WS_PG); F.PA = (bf16_t*)(ws + WS_PA);
    F.MERGED = (bf16_t*)(ws + WS_MERGED); F.YCAT = (bf16_t*)(ws + WS_YCAT); F.OBF = (bf16_t*)(ws + WS_OBF); F.queue = (unsigned*)(ws + WS_CTL) + 65536;
    for (int u = F.tid; u < (LDS_BYTES - LDSCTL_OFF) / 4; u += NTHREADS) ((LAS unsigned*)(F.lds + LDSCTL_OFF))[u] = 0u;
    __syncthreads();
    const int lo = args.ph_lo, hi = args.ph_hi;
    XcdBarrier bar; bar.bar = (unsigned*)(ws + WS_CTL) + CW_BAR; bar.x = 0; bar.st = nullptr;
    if (hi - lo > 1) bar = xcd_barrier_post((unsigned*)(ws + WS_CTL) + CW_BAR, (volatile LAS unsigned*)(F.lds + MISC_OFF) + 8);
#define IN(k) (lo <= (k) && (k) < hi)
#define SEAM(k) do { if (IN(k) && IN((k) + 1)) xcd_barrier(bar); } while (0)
#define PHASE(k, ...) do { if (IN(k)) { __VA_ARGS__; SEAM(k); if (PROBE_REP == (k)) { __VA_ARGS__; xcd_barrier(bar); } } } while (0)
    PHASE(0, p0_prologue(F));
    PHASE(1, {
        pg8::Gemm g{F.HB, F.WIN_T, M, NIN, DM}; pg8::SplitOrder S; S.so.init(M, NPA + NPG, F.G, F.bid, DM, WGM_P1); S.extra_pn = (NPA + NPG) / 256;
        EpiIn E{F.PA, F.PG, F.PL, F.b_merge};
        pg8::gemm_phase<EpiIn, pg8::SplitOrder, P1_ALIGN, P1_SP2>(F.lds, g, S, E);
    });
    PHASE(3, p3_prep(F));
    PHASE(4, { p4_scan(F); p2_attention(F); });
    PHASE(5, p5_out(F));
    PHASE(6, {
        pg8::Gemm g{F.YCAT, F.WCAT_T, 2 * M, 2 * DM, DBR}; pg8::PairOrder S; S.so.init(M, DM, F.G, F.bid, DBR, WGM_P6); S.dpm = M / 256; S.dpn = DM / 256;
        EpiBranch E{F.PG, F.MERGED};
        pg8::gemm_phase<EpiBranch, pg8::PairOrder, true, true>(F.lds, g, S, E);
    });
    PHASE(7, {
        pg8::Gemm g{F.MERGED, F.WOUT_T, M, DM, DM}; pg8::StaticOrder S; S.init(M, DM, F.G, F.bid, DM, WGM_P7);
        EpiOut E{F.OBF, F.SSP};
        pg8::gemm_phase<EpiOut, pg8::StaticOrder, true, true>(F.lds, g, S, E);
    });
    if (IN(8)) { p8_final(F); }
#undef PHASE
#undef IN
#undef SEAM
}

extern "C" void kernel_launch(void* const* d_in, const int* in_sizes, int n_in, void* d_out, int out_size, void* d_ws, size_t ws_size, hipStream_t stream) {
    static int grid = 0;
    if (grid == 0) {
        if (n_in != 22 || in_sizes[0] != M * DM || out_size != M * DM || ws_size < WS_END) { fprintf(stderr, "kernel_launch: unexpected shapes (n_in %d in0 %d out %d ws %zu); nothing launched\n", n_in, n_in > 0 ? in_sizes[0] : -1, out_size, ws_size); grid = -1; return; }
        int dev = 0, cus = 0;
        if (hipGetDevice(&dev) != hipSuccess || hipDeviceGetAttribute(&cus, hipDeviceAttributeMultiprocessorCount, dev) != hipSuccess) { fprintf(stderr, "kernel_launch: device query failed\n"); grid = -1; return; }
        if (hipFuncSetAttribute((const void*)mk_fwd, hipFuncAttributeMaxDynamicSharedMemorySize, LDS_BYTES) != hipSuccess) { fprintf(stderr, "kernel_launch: hipFuncSetAttribute failed\n"); grid = -1; return; }
        int per_cu = 0;
        if (hipOccupancyMaxActiveBlocksPerMultiprocessor(&per_cu, (const void*)mk_fwd, NTHREADS, LDS_BYTES) != hipSuccess || per_cu < 1) fprintf(stderr, "kernel_launch: note: occupancy query reports %d blocks per CU\n", per_cu);
        (void)hipGetLastError();
        grid = cus > 256 ? 256 : cus;
        if (grid != 256) { fprintf(stderr, "kernel_launch: this build needs a 256-CU device (got %d); nothing launched\n", cus); grid = -1; return; }
    }
    if (grid < 0) return;
    (void)hipMemsetAsync((char*)d_ws + WS_CTL, 0, CTL_ZERO_BYTES, stream);
    Args a{};
    for (int i = 0; i < 22; ++i) a.in[i] = (const float*)d_in[i];
    a.out = (float*)d_out; a.ws = (unsigned char*)d_ws;
#if MK_N_LAUNCHES == 1
    a.ph_lo = 0; a.ph_hi = N_PHASES; a.li = 0;
    hipLaunchKernelGGL(mk_fwd, dim3(grid), dim3(NTHREADS), LDS_BYTES, stream, a);
#else
    for (int li = 0; li < N_PHASES; ++li) { a.ph_lo = li; a.ph_hi = li + 1; a.li = li; hipLaunchKernelGGL(mk_fwd, dim3(grid), dim3(NTHREADS), LDS_BYTES, stream, a); }
#endif
}
```

```cpp
#include <hip/hip_runtime.h>
#include <cstdio>
#include <cstdint>

#ifndef MK_N_LAUNCHES
#define MK_N_LAUNCHES 1
#endif
#ifndef WGM_P1
#define WGM_P1 6
#endif
#ifndef WGM_P6
#define WGM_P6 2
#endif
#ifndef WGM_P7
#define WGM_P7 2
#endif
#ifndef P1_ALIGN
#define P1_ALIGN true
#endif
#ifndef P1_SP2
#define P1_SP2 true
#endif
#ifndef XCD_REMAP
#define XCD_REMAP 1
#endif
#ifndef ROT_COLS
#define ROT_COLS 0
#endif
#ifndef PROBE_REP
#define PROBE_REP -1
#endif

#define LAS __attribute__((address_space(3)))
#define GAS __attribute__((address_space(1)))
typedef unsigned short bf16_t;
typedef short bf16x8 __attribute__((ext_vector_type(8)));
typedef short s16x4 __attribute__((ext_vector_type(4)));
typedef float f32x4 __attribute__((ext_vector_type(4)));
typedef float f32x2 __attribute__((ext_vector_type(2)));
typedef unsigned u32x4 __attribute__((ext_vector_type(4)));
typedef unsigned u32x2 __attribute__((ext_vector_type(2)));
typedef __bf16 bf16x2_t __attribute__((ext_vector_type(2)));

constexpr int BATCH = 2, SEQ = 8192, DM = 2048, DBR = 1024, NH = 16, HD = 64, CHUNK = 64, NCHUNK = SEQ / CHUNK, M = BATCH * SEQ;
constexpr int NPA = 8192, NPG = 4096, NPL = 256, NIN = NPA + NPG + NPL;
constexpr int PA_R = 0, PA_K = 1024, PA_V = 2048, PA_ZR = 3072, PA_Q = 4096, PA_KA = 5120, PA_VA = 6144, PA_ZA = 7168;
constexpr float NORM_EPS = 1e-6f, GN_EPS = 64e-5f, DECAY_SCALE = 0.606531f;
constexpr int NWAVES = 8, NTHREADS = 512;

constexpr size_t MiB = 1u << 20;
constexpr size_t WS_CTL = 0, CTL_ZERO_BYTES = 1 * MiB;
constexpr size_t WS_WCAT = 1 * MiB;
constexpr size_t WS_WOUT = 9 * MiB;
constexpr size_t WS_W2T = 17 * MiB;
constexpr size_t WS_BONUS = 18 * MiB;
constexpr size_t WS_SSP = 19 * MiB;
constexpr size_t WS_PL = 22 * MiB;
constexpr size_t WS_PG = 30 * MiB;
constexpr size_t WS_PA = 158 * MiB;
constexpr size_t WS_MERGED = WS_PA;
constexpr size_t WS_OBF = WS_PA + 64 * MiB;
constexpr size_t WS_YCAT = 414 * MiB;
constexpr size_t WS_PLS = 478 * MiB;
constexpr size_t WS_END = 510 * MiB;
constexpr size_t DO_HB = 0, DO_WIN = 64 * MiB, DO_STATES = 0;
constexpr size_t DO_MD = 32 * MiB, DO_ND = 64 * MiB, DO_QD = 96 * MiB;
constexpr int CW_BAR = 4096;

constexpr int RING_BYTES = 131072;
constexpr int LDSCTL_OFF = 152576, MISC_OFF = LDSCTL_OFF + 320;
constexpr int LDS_BYTES = 153600;

typedef GAS unsigned gu32;
#define RLX_AGENT __ATOMIC_RELAXED, __HIP_MEMORY_SCOPE_AGENT
#define LDS_WAIT() asm volatile("s_waitcnt lgkmcnt(0)" ::: "memory")
#define VM_WAIT() asm volatile("s_waitcnt vmcnt(0)" ::: "memory")
__device__ __forceinline__ unsigned pk2(float lo, float hi) { f32x2 v = {lo, hi}; bf16x2_t b = __builtin_convertvector(v, bf16x2_t); return __builtin_bit_cast(unsigned, b); }
__device__ __forceinline__ bf16_t f2bf(float f) { return (bf16_t)(pk2(f, 0.f) & 0xffffu); }
__device__ __forceinline__ float bflo(unsigned w) { return __uint_as_float(w << 16); }
__device__ __forceinline__ float bfhi(unsigned w) { return __uint_as_float(w & 0xffff0000u); }
__device__ __forceinline__ float bf2f(bf16_t h) { return __uint_as_float(((unsigned)h) << 16); }
__device__ __forceinline__ void unpack8(const u32x4 w, float (&f)[8]) { f[0] = bflo(w.x); f[1] = bfhi(w.x); f[2] = bflo(w.y); f[3] = bfhi(w.y); f[4] = bflo(w.z); f[5] = bfhi(w.z); f[6] = bflo(w.w); f[7] = bfhi(w.w); }
__device__ __forceinline__ u32x4 pack8(const float (&f)[8]) { u32x4 w; w.x = pk2(f[0], f[1]); w.y = pk2(f[2], f[3]); w.z = pk2(f[4], f[5]); w.w = pk2(f[6], f[7]); return w; }
__device__ __forceinline__ void load8(const float* p, float (&f)[8]) { const f32x4 a = *(const f32x4*)p, b = *(const f32x4*)(p + 4); f[0] = a.x; f[1] = a.y; f[2] = a.z; f[3] = a.w; f[4] = b.x; f[5] = b.y; f[6] = b.z; f[7] = b.w; }
__device__ __forceinline__ float sigmoidf_(float x) { return 1.f / (1.f + __expf(-x)); }
__device__ __forceinline__ float tanhf_(float x) { return 1.f - 2.f / (1.f + __expf(2.f * x)); }

namespace pg8 {
constexpr int BM = 256, BK = 64, HALF = 128, HTB = HALF * BK * 2  , STAGE_BYTES = 8 * HTB, NXCD = 8;
__host__ __device__ __forceinline__ int lds_byte(int r, int c) { const int st = (r >> 4) * 2 + (c >> 5), rr = r & 15, cc = c & 31, ob = rr * 64 + cc * 2; return st * 1024 + (ob ^ (((ob >> 9) & 1) << 5)); }
__host__ __device__ __forceinline__ void stage_rc(int b, int& R, int& C) { const int st = b / 1024, sb = b % 1024, swz = sb ^ (((sb >> 9) & 1) << 5); R = (st >> 1) * 16 + swz / 64; C = (st & 1) * 32 + (swz % 64) / 2; }
__host__ __device__ __forceinline__ int perm32(int rho) { const int n = rho >> 4, i = rho & 15; return 8 * (i >> 2) + 4 * n + (i & 3); }

struct Unit { int pm, pn, kb, nt; };
struct Gemm { const bf16_t* A; const bf16_t* Bt; int M, N, K; };

struct StaticOrder {
    int nM, nN, nwg, G, c, ntk, WGM;
    __host__ __device__ void init(int M_, int N_, int G_, int c_, int K_, int wgm_) { nM = M_ / BM; nN = N_ / BM; nwg = nM * nN; G = G_; c = c_; ntk = K_ / BK; WGM = wgm_; }
    __host__ __device__ void tile(int L, int& pm, int& pn) const {
        int wgid = L; if (XCD_REMAP) { const int q = nwg / NXCD, r = nwg % NXCD, xcd = wgid % NXCD, off = wgid / NXCD; wgid = (xcd < r ? xcd * (q + 1) : r * (q + 1) + (xcd - r) * q) + off; }
        if (WGM > 0) { const int nig = WGM * nN, gid = wgid / nig, fm = gid * WGM, gsz = (nM - fm) < WGM ? (nM - fm) : WGM;
            pm = fm + ((wgid % nig) % gsz); pn = (wgid % nig) / gsz;
            if (ROT_COLS) pn = (pn + ROT_COLS * gid) % nN; }
        else { const int W = -WGM, nig = W * nM, gid = wgid / nig, fn = gid * W, gsz = (nN - fn) < W ? (nN - fn) : W;
            pn = fn + ((wgid % nig) % gsz); pm = (wgid % nig) / gsz; }
    }
    __host__ __device__ bool next(int i, Unit& u) const {
        const long L = (long)i * G + c; if (L >= nwg) return false;
        int pm, pn; tile((int)L, pm, pn);
        u.pm = pm; u.pn = pn; u.kb = 0; u.nt = ntk; return true;
    }
};
struct SplitOrder {
    StaticOrder so; int extra_pn;
    __host__ __device__ bool next(int i, Unit& u) const {
        const long L = (long)i * so.G + so.c; const bool normal = L < so.nwg; const int Lq = (int)(L - so.nwg);
        if (!normal && Lq >= 256) return false;
        int pm, pn; so.tile(normal ? (int)L : 0, pm, pn);
        u.pm = normal ? pm : (Lq >> 2); u.pn = normal ? pn : extra_pn; u.kb = normal ? 0 : (Lq & 3) * 1024; u.nt = normal ? so.ntk : 8; return true;
    }
};
struct PairOrder {
    StaticOrder so; int dpm, dpn;
    __host__ __device__ bool next(int i, Unit& u) const { if (!so.next(i >> 1, u)) return false; if (i & 1) { u.pm += dpm; u.pn += dpn; } return true; }
};

template <class Epi, class Sched, bool ALIGN_EPI = false, bool SP2 = false>
__device__ __forceinline__ void gemm_phase(LAS unsigned char* lds, const Gemm g, const Sched& S, const Epi& E) {
    const int tid = threadIdx.x, wid = __builtin_amdgcn_readfirstlane(tid >> 6), lane = tid & 63, wr = wid >> 2, wc = wid & 3, fr = lane & 15, fq = lane >> 4;
    const int K = g.K;
    unsigned voffA[2], voffB[2];
#pragma unroll
    for (int i = 0; i < 2; ++i) { int R, C; stage_rc(tid * 16 + i * 8192, R, C); const int Rb = Epi::PERM ? ((R & ~31) + perm32(R & 31)) : R;
        voffA[i] = (unsigned)(R * K + C) * 2u; voffB[i] = (unsigned)(Rb * K + C) * 2u; }
    const size_t kstep = (size_t)(BK * 2);
    const size_t hstep = (size_t)HALF * K * 2;
    const size_t tstep = 2 * hstep;
    const unsigned ldsw = (unsigned)wid * 1024u;
    const int aoff = lds_byte(wr * 64 + fr, fq * 8), boff = lds_byte(wc * 32 + fr, fq * 8);
#define PG8_SA(b, h) (((b) * 2 + (h)) * HTB)
#define PG8_SB(b, h) ((4 + (b) * 2 + (h)) * HTB)
#define PG8_STAGE(bufoff, gbase, voff) do { _Pragma("unroll") for (int _i = 0; _i < 2; ++_i) \
        __builtin_amdgcn_global_load_lds((const unsigned*)((const char*)(gbase) + (voff)[_i]), (LAS unsigned*)(lds + (bufoff) + ldsw + _i * 8192), 16, 0, 0); } while (0)
#define PG8_LDA(dst, b, h) do { _Pragma("unroll") for (int m = 0; m < 4; ++m) _Pragma("unroll") for (int k = 0; k < 2; ++k) dst[m][k] = *(const LAS bf16x8*)(lds + PG8_SA(b, h) + aoff + m * 2048 + k * 1024); } while (0)
#define PG8_LDB(dst, b, h) do { _Pragma("unroll") for (int n = 0; n < 2; ++n) _Pragma("unroll") for (int k = 0; k < 2; ++k) dst[n][k] = *(const LAS bf16x8*)(lds + PG8_SB(b, h) + boff + n * 2048 + k * 1024); } while (0)
#define PG8_MMA(ai, bj, At, Bt) do { __builtin_amdgcn_s_setprio(1); _Pragma("unroll") for (int m = 0; m < 4; ++m) _Pragma("unroll") for (int n = 0; n < 2; ++n) _Pragma("unroll") for (int k = 0; k < 2; ++k) \
        acc[ai][bj][m][n] = __builtin_amdgcn_mfma_f32_16x16x32_bf16(Bt[n][k], At[m][k], acc[ai][bj][m][n], 0, 0, 0); __builtin_amdgcn_s_setprio(0); } while (0)
#define PG8_WAIT_V(n) asm volatile("s_waitcnt vmcnt(" #n ")" ::: "memory")
#define PG8_WAIT_L(n) asm volatile("s_waitcnt lgkmcnt(" #n ")" ::: "memory")
#define PG8_BAR __builtin_amdgcn_s_barrier()
#define PG8_SCHED __builtin_amdgcn_sched_barrier(0)
    Unit cur, nxt; int ui = 0;
    if (!S.next(0, cur)) return;
    f32x4 acc[2][2][4][2];
#pragma unroll
    for (int a = 0; a < 2; ++a)
#pragma unroll
        for (int b = 0; b < 2; ++b)
#pragma unroll
            for (int m = 0; m < 4; ++m)
#pragma unroll
                for (int n = 0; n < 2; ++n) acc[a][b][m][n] = (f32x4){0.f, 0.f, 0.f, 0.f};
    bf16x8 At[4][2], B0[2][2], B1[2][2];
    const char* cA = (const char*)g.A + (size_t)cur.pm * tstep + cur.kb; const char* cB = (const char*)g.Bt + (size_t)cur.pn * tstep + cur.kb;
    if constexpr (SP2) {
        PG8_STAGE(PG8_SB(0, 0), cB, voffB); PG8_STAGE(PG8_SB(0, 1), cB + hstep, voffB); PG8_STAGE(PG8_SA(0, 0), cA, voffA); PG8_STAGE(PG8_SA(0, 1), cA + hstep, voffA);
        if (wr == 1) PG8_BAR;
        PG8_WAIT_V(2); PG8_BAR;
        PG8_STAGE(PG8_SB(1, 0), cB + kstep, voffB); PG8_STAGE(PG8_SA(1, 0), cA + kstep, voffA); PG8_STAGE(PG8_SB(1, 1), cB + hstep + kstep, voffB);
        PG8_WAIT_V(6); PG8_BAR;
    } else {
        PG8_STAGE(PG8_SB(0, 0), cB, voffB); PG8_STAGE(PG8_SA(0, 0), cA, voffA); PG8_STAGE(PG8_SB(0, 1), cB + hstep, voffB); PG8_STAGE(PG8_SA(0, 1), cA + hstep, voffA);
        if (wr == 1) PG8_BAR;
        PG8_WAIT_V(4); PG8_BAR;
        PG8_STAGE(PG8_SB(1, 0), cB + kstep, voffB); PG8_STAGE(PG8_SA(1, 0), cA + kstep, voffA); PG8_STAGE(PG8_SB(1, 1), cB + hstep + kstep, voffB);
        PG8_WAIT_V(6); PG8_BAR;
    }
    for (;;) {
        const bool has_next = S.next(ui + 1, nxt);
        const char* nA = has_next ? (const char*)g.A + (size_t)nxt.pm * tstep + nxt.kb : cA; const char* nB = has_next ? (const char*)g.Bt + (size_t)nxt.pn * tstep + nxt.kb : cB;
        const int nt = cur.nt;
        for (int t = 0; t < nt; t += 2) {
            const bool last = (t == nt - 2);
            const char* a1 = cA + (size_t)(t + 1) * kstep;
            const char* a2 = last ? nA : cA + (size_t)(t + 2) * kstep; const char* b2 = last ? nB : cB + (size_t)(t + 2) * kstep;
            const char* a3 = a2 + kstep; const char* b3 = b2 + kstep;
            if constexpr (SP2) {
            PG8_LDB(B0, 0, 0); PG8_LDB(B1, 0, 1); PG8_SCHED; PG8_LDA(At, 0, 0); PG8_STAGE(PG8_SA(1, 1), a1 + hstep, voffA);
            PG8_WAIT_V(8); PG8_WAIT_L(0); PG8_BAR; PG8_MMA(0, 0, At, B0); PG8_MMA(0, 1, At, B1); PG8_BAR; PG8_SCHED;
            PG8_LDA(At, 0, 1); PG8_STAGE(PG8_SB(0, 0), b2, voffB); PG8_STAGE(PG8_SB(0, 1), b2 + hstep, voffB); PG8_STAGE(PG8_SA(0, 0), a2, voffA);
            PG8_WAIT_V(8); PG8_WAIT_L(0); PG8_BAR; PG8_MMA(1, 0, At, B0); PG8_MMA(1, 1, At, B1); PG8_BAR; PG8_SCHED;
            PG8_LDB(B0, 1, 0); PG8_LDB(B1, 1, 1); PG8_SCHED; PG8_LDA(At, 1, 0); PG8_STAGE(PG8_SA(0, 1), a2 + hstep, voffA);
            PG8_WAIT_V(8); PG8_WAIT_L(0); PG8_BAR; PG8_MMA(0, 0, At, B0); PG8_MMA(0, 1, At, B1); PG8_BAR; PG8_SCHED;
            PG8_LDA(At, 1, 1); PG8_STAGE(PG8_SB(1, 0), b3, voffB); PG8_STAGE(PG8_SB(1, 1), b3 + hstep, voffB); PG8_STAGE(PG8_SA(1, 0), a3, voffA);
            PG8_WAIT_V(8); PG8_WAIT_L(0); PG8_BAR; PG8_MMA(1, 0, At, B0); PG8_MMA(1, 1, At, B1); PG8_BAR; PG8_SCHED;
            } else {
            PG8_LDB(B0, 0, 0); PG8_SCHED; PG8_LDA(At, 0, 0); PG8_STAGE(PG8_SA(1, 1), a1 + hstep, voffA);
            PG8_WAIT_L(8); PG8_BAR; PG8_WAIT_L(0); PG8_MMA(0, 0, At, B0); PG8_BAR; PG8_SCHED;
            PG8_LDB(B1, 0, 1); PG8_STAGE(PG8_SB(0, 0), b2, voffB);
            PG8_BAR; PG8_WAIT_L(0); PG8_MMA(0, 1, At, B1); PG8_BAR;
            PG8_LDA(At, 0, 1); PG8_STAGE(PG8_SA(0, 0), a2, voffA);
            PG8_BAR; PG8_WAIT_L(0); PG8_MMA(1, 0, At, B0); PG8_BAR; PG8_SCHED;
            PG8_STAGE(PG8_SB(0, 1), b2 + hstep, voffB);
            PG8_WAIT_V(6); PG8_BAR; PG8_MMA(1, 1, At, B1); PG8_BAR;
            PG8_LDB(B0, 1, 0); PG8_SCHED; PG8_LDA(At, 1, 0); PG8_STAGE(PG8_SA(0, 1), a2 + hstep, voffA);
            PG8_WAIT_L(8); PG8_BAR; PG8_WAIT_L(0); PG8_MMA(0, 0, At, B0); PG8_BAR; PG8_SCHED;
            PG8_LDB(B1, 1, 1); PG8_STAGE(PG8_SB(1, 0), b3, voffB);
            PG8_BAR; PG8_WAIT_L(0); PG8_MMA(0, 1, At, B1); PG8_BAR;
            PG8_LDA(At, 1, 1); PG8_STAGE(PG8_SA(1, 0), a3, voffA);
            PG8_BAR; PG8_WAIT_L(0); PG8_MMA(1, 0, At, B0); PG8_BAR; PG8_SCHED;
            PG8_STAGE(PG8_SB(1, 1), b3 + hstep, voffB);
            PG8_WAIT_V(6); PG8_BAR; PG8_MMA(1, 1, At, B1); PG8_BAR;
            }
        }
        if constexpr (ALIGN_EPI) { if (wr == 0) PG8_BAR; }
        const bool zero_acc = E(acc, cur, wr, wc, fr, fq);
        if (!has_next) break;
        if (zero_acc) {
#pragma unroll
        for (int a = 0; a < 2; ++a)
#pragma unroll
            for (int b = 0; b < 2; ++b)
#pragma unroll
                for (int m = 0; m < 4; ++m)
#pragma unroll
                    for (int n = 0; n < 2; ++n) acc[a][b][m][n] = (f32x4){0.f, 0.f, 0.f, 0.f};
        }
        cur = nxt; cA = nA; cB = nB; ++ui;
        if constexpr (ALIGN_EPI) { if (wr == 1) PG8_BAR; }
    }
    PG8_WAIT_V(0);
    if constexpr (!ALIGN_EPI) { if (wr == 0) PG8_BAR; }
    PG8_BAR;
#undef PG8_SA
#undef PG8_SB
#undef PG8_STAGE
#undef PG8_LDA
#undef PG8_LDB
#undef PG8_MMA
#undef PG8_WAIT_V
#undef PG8_WAIT_L
#undef PG8_BAR
#undef PG8_SCHED
}
}

struct EpiIn {
    static constexpr bool PERM = true;
    bf16_t* PA; bf16_t* PG; bf16_t* PL; const float* bmerge;
    __device__ __forceinline__ bool operator()(f32x4 (&acc)[2][2][4][2], const pg8::Unit& u, int wr, int wc, int fr, int fq) const {
        const int row0 = u.pm * 256 + wr * 64 + fr; const int colb = u.pn * 256 + wc * 32 + 8 * fq;
        if (u.pn < 32) {
            const float sc = (u.pn >= 16 && u.pn < 20) ? 0.125f : 1.0f;
#pragma unroll
            for (int ai = 0; ai < 2; ++ai)
#pragma unroll
                for (int m = 0; m < 4; ++m) { bf16_t* rowp = PA + (size_t)(row0 + ai * 128 + m * 16) * NPA + colb;
#pragma unroll
                    for (int bj = 0; bj < 2; ++bj) { const f32x4 v0 = acc[ai][bj][m][0] * sc, v1 = acc[ai][bj][m][1] * sc;
                        u32x4 w; w.x = pk2(v0[0], v0[1]); w.y = pk2(v0[2], v0[3]); w.z = pk2(v1[0], v1[1]); w.w = pk2(v1[2], v1[3]);
                        *(u32x4*)(rowp + bj * 128) = w; } }
        } else if (u.pn < 48) {
            const int cg = colb - NPA;
            f32x4 bv[2][2];
#pragma unroll
            for (int bj = 0; bj < 2; ++bj)
#pragma unroll
                for (int n = 0; n < 2; ++n) bv[bj][n] = *(const f32x4*)(bmerge + cg + bj * 128 + 4 * n);
#pragma unroll
            for (int ai = 0; ai < 2; ++ai)
#pragma unroll
                for (int m = 0; m < 4; ++m) { bf16_t* rowp = PG + (size_t)(row0 + ai * 128 + m * 16) * NPG + cg;
#pragma unroll
                    for (int bj = 0; bj < 2; ++bj) { const f32x4 v0 = acc[ai][bj][m][0] + bv[bj][0], v1 = acc[ai][bj][m][1] + bv[bj][1];
                        u32x4 w; w.x = pk2(sigmoidf_(v0[0]), sigmoidf_(v0[1])); w.y = pk2(sigmoidf_(v0[2]), sigmoidf_(v0[3])); w.z = pk2(sigmoidf_(v1[0]), sigmoidf_(v1[1])); w.w = pk2(sigmoidf_(v1[2]), sigmoidf_(v1[3]));
                        *(u32x4*)(rowp + bj * 128) = w; } }
        } else {
            const int cl = colb - NPA - NPG;
#pragma unroll
            for (int ai = 0; ai < 2; ++ai)
#pragma unroll
                for (int m = 0; m < 4; ++m) { bf16_t* rowp = PL + (size_t)(u.kb >> 10) * ((size_t)M * NPL) + (size_t)(row0 + ai * 128 + m * 16) * NPL + cl;
#pragma unroll
                    for (int bj = 0; bj < 2; ++bj) { const f32x4 v0 = acc[ai][bj][m][0], v1 = acc[ai][bj][m][1];
                        u32x4 w; w.x = pk2(v0[0], v0[1]); w.y = pk2(v0[2], v0[3]); w.z = pk2(v1[0], v1[1]); w.w = pk2(v1[2], v1[3]);
                        *(u32x4*)(rowp + bj * 128) = w; } }
        }
        return true;
    }
};
struct EpiBranch {
    static constexpr bool PERM = true;
    const bf16_t* PG; bf16_t* MG;
    __device__ __forceinline__ bool operator()(f32x4 (&acc)[2][2][4][2], const pg8::Unit& u, int wr, int wc, int fr, int fq) const {
        const bool first = u.pm < 64;
        const int pm = first ? u.pm : u.pm - 64, pn = first ? u.pn : u.pn - 8;
        const int row0 = pm * 256 + wr * 64 + fr; const int colb = pn * 256 + wc * 32 + 8 * fq;
#pragma unroll
        for (int ai = 0; ai < 2; ++ai) {
            u32x4 ga_[4][2], gr_[4][2];
#pragma unroll
            for (int m = 0; m < 4; ++m)
#pragma unroll
                for (int bj = 0; bj < 2; ++bj) { const bf16_t* p = PG + (size_t)(row0 + ai * 128 + m * 16) * NPG + colb + bj * 128; ga_[m][bj] = *(const u32x4*)(p + 2048); gr_[m][bj] = *(const u32x4*)p; }
#pragma unroll
            for (int m = 0; m < 4; ++m) { const size_t row = (size_t)(row0 + ai * 128 + m * 16);
#pragma unroll
                for (int bj = 0; bj < 2; ++bj) { float ga[8], gr[8]; unpack8(ga_[m][bj], ga); unpack8(gr_[m][bj], gr);
#pragma unroll
                    for (int e = 0; e < 4; ++e) { const float s0 = first ? gr[e] * __builtin_amdgcn_rcpf(ga[e]) : ga[e], s1 = first ? gr[4 + e] * __builtin_amdgcn_rcpf(ga[4 + e]) : ga[4 + e];
                        acc[ai][bj][m][0][e] *= s0; acc[ai][bj][m][1][e] *= s1; }
                    if (!first) { const f32x4 v0 = acc[ai][bj][m][0], v1 = acc[ai][bj][m][1];
                        u32x4 w; w.x = pk2(v0[0], v0[1]); w.y = pk2(v0[2], v0[3]); w.z = pk2(v1[0], v1[1]); w.w = pk2(v1[2], v1[3]);
                        *(u32x4*)(MG + row * DM + colb + bj * 128) = w; } } }
            asm volatile("" ::: "memory");
        }
        return !first;
    }
};
struct EpiOut {
    static constexpr bool PERM = true;
    bf16_t* O; float* SSP;
    __device__ __forceinline__ bool operator()(f32x4 (&acc)[2][2][4][2], const pg8::Unit& u, int wr, int wc, int fr, int fq) const {
        const int row0 = u.pm * 256 + wr * 64 + fr; const int colb = u.pn * 256 + wc * 32 + 8 * fq;
#pragma unroll
        for (int ai = 0; ai < 2; ++ai)
#pragma unroll
            for (int m = 0; m < 4; ++m) { const size_t row = (size_t)(row0 + ai * 128 + m * 16); float ss = 0.f;
#pragma unroll
                for (int bj = 0; bj < 2; ++bj) { const f32x4 v0 = acc[ai][bj][m][0], v1 = acc[ai][bj][m][1];
                    ss += (v0[0] * v0[0] + v0[1] * v0[1]) + (v0[2] * v0[2] + v0[3] * v0[3]) + (v1[0] * v1[0] + v1[1] * v1[1]) + (v1[2] * v1[2] + v1[3] * v1[3]);
                    u32x4 w; w.x = pk2(v0[0], v0[1]); w.y = pk2(v0[2], v0[3]); w.z = pk2(v1[0], v1[1]); w.w = pk2(v1[2], v1[3]);
                    *(u32x4*)(O + row * DM + colb + bj * 128) = w; }
                ss += __shfl_xor(ss, 16); ss += __shfl_xor(ss, 32);
                if (fq == 0) SSP[row * 32 + u.pn * 4 + wc] = ss; }
        return true;
    }
};

#define XB_TMO      128
#define XB_XCNT(j)  (256  + 64 * (j))
#define XB_XSUB(j)  (1280 + 64 * (j))
#define XB_XGEN(j)  (2304 + 64 * (j))
#define XB_TOP      3328
#define XB_TOPGEN   3392
#define XCD_BAR_WORDS 3456
#define XB_SPIN_CAP (1u << 18)
__device__ __forceinline__ unsigned xb_ld(unsigned* p)              { return __hip_atomic_load(p, __ATOMIC_RELAXED, __HIP_MEMORY_SCOPE_AGENT); }
__device__ __forceinline__ unsigned xb_add(unsigned* p, unsigned v) { return __hip_atomic_fetch_add(p, v, __ATOMIC_RELAXED, __HIP_MEMORY_SCOPE_AGENT); }
__device__ __forceinline__ unsigned xb_xcc_id() { return (unsigned)__builtin_amdgcn_s_getreg((3 << 11) | 20) & 0xFu; }
#define XB_SPIN(cond, bar) do { unsigned _sp = 0; while (cond) { __builtin_amdgcn_s_sleep(1); \
    if ((++_sp & 255u) == 0u) { if (xb_ld(&(bar)[XB_TMO])) break; if (_sp > XB_SPIN_CAP) { atomicAdd(&(bar)[XB_TMO], 1u); break; } } } } while (0)
struct XcdBarrier { unsigned* bar; unsigned x; volatile LAS unsigned* st; };
__device__ __forceinline__ XcdBarrier xcd_barrier_post(unsigned* bar, volatile LAS unsigned* st) {
    XcdBarrier b; b.bar = bar; b.x = xb_xcc_id(); b.st = st;
    if (threadIdx.x == 0) (void)xb_add(&bar[XB_XCNT(b.x)], 1u);
    return b;
}
__device__ __forceinline__ void xcd_barrier_complete(unsigned* bar, unsigned x, unsigned& nloc, unsigned& nx) {
    const unsigned G = gridDim.x * gridDim.y * gridDim.z;
    unsigned sum, cnt, mine, sp = 0u;
    for (;;) {
        sum = 0u; cnt = 0u; mine = 0u;
#pragma unroll
        for (unsigned j = 0; j < 16; ++j) { const unsigned c = xb_ld(&bar[XB_XCNT(j)]); sum += c; cnt += (c > 0u) ? 1u : 0u; mine = (j == x) ? c : mine; }
        if (sum == G) break;
        __builtin_amdgcn_s_sleep(1);
        if ((++sp & 255u) == 0u) { if (xb_ld(&bar[XB_TMO])) break; if (sp > XB_SPIN_CAP) { atomicAdd(&bar[XB_TMO], 1u); break; } }
    }
    nloc = mine > 0u ? mine : 1u; nx = cnt > 0u ? cnt : 1u;
}
__device__ __forceinline__ void xcd_barrier(const XcdBarrier& b) {
    asm volatile("s_waitcnt vmcnt(0)" ::: "memory");
    __syncthreads();
    if (threadIdx.x == 0) {
        unsigned* bar = b.bar;
        __builtin_amdgcn_s_waitcnt(0);
        unsigned nloc = b.st[0], nx = b.st[1];
        if (nloc == 0u) { xcd_barrier_complete(bar, b.x, nloc, nx); b.st[0] = nloc; b.st[1] = nx; }
        const unsigned old = xb_add(&bar[XB_XSUB(b.x)], 1u);
        const unsigned gen = old / nloc;
        if (old + 1u == (gen + 1u) * nloc) {
            __builtin_amdgcn_fence(__ATOMIC_RELEASE, "agent");
            asm volatile("s_waitcnt vmcnt(0)" ::: "memory");
            const unsigned og = xb_add(&bar[XB_TOP], 1u);
            const unsigned tg = og / nx;
            if (og + 1u == (tg + 1u) * nx) xb_add(&bar[XB_TOPGEN], 1u);
            else XB_SPIN(xb_ld(&bar[XB_TOPGEN]) == tg, bar);
            __builtin_amdgcn_fence(__ATOMIC_ACQUIRE, "agent");
            xb_add(&bar[XB_XGEN(b.x)], 1u);
            asm volatile("s_waitcnt vmcnt(0)" ::: "memory");
        } else {
            XB_SPIN(xb_ld(&bar[XB_XGEN(b.x)]) == gen, bar);
            __builtin_amdgcn_fence(__ATOMIC_ACQUIRE, "agent");
            asm volatile("s_waitcnt vmcnt(0)" ::: "memory");
        }
    }
    __syncthreads();
}

struct Frame {
    LAS unsigned char* lds;
    int tid, lane, wave, G, bid;
    const float *x, *pre_g, *post_g, *w_in, *mu_rkv, *mu_wa, *w0, *w1, *w2, *a0, *a1, *a2, *k_k, *k_a, *r_k, *lnx_g, *lnx_b, *rel_bias, *w_br, *w_ba, *b_merge, *w_out;
    float* out;
    bf16_t *HB, *WIN_T, *WCAT_T, *WOUT_T, *W2T, *A2T, *PA, *PG, *PL, *YCAT, *MERGED, *STATES;
    float *BONUS, *SSP;
    bf16_t* OBF; bf16_t *MD, *ND, *QD; unsigned* queue;
};

__device__ __forceinline__ float wave_sum(float v) {
#pragma unroll
    for (int o = 1; o < 64; o <<= 1) v += __shfl_xor(v, o);
    return v;
}

__device__ __forceinline__ void p0_transpose_item(const float* W, int K, int N, bf16_t* WT, int row_off, LAS float* scr, int item, int lane, const float* mu, float s0, float s1) {
    const int nblk = N / 32, kb = item / nblk, nb = item % nblk, k0 = 64 * kb, n0 = 32 * nb;
    f32x4 v4[8];
#pragma unroll
    for (int i = 0; i < 8; ++i) { const int kk = 8 * i + (lane >> 3); v4[i] = *(const f32x4*)(W + (size_t)(k0 + kk) * N + n0 + (lane & 7) * 4); }
#pragma unroll
    for (int i = 0; i < 8; ++i) { const int kk = 8 * i + (lane >> 3); f32x4 v = v4[i]; if (mu) v = v * (s0 + s1 * mu[k0 + kk]);
        LAS float* d = scr + kk * 33 + (lane & 7) * 4; d[0] = v[0]; d[1] = v[1]; d[2] = v[2]; d[3] = v[3]; }
    LDS_WAIT(); asm volatile("" ::: "memory");
    const int c = lane & 7;
#pragma unroll
    for (int j = 0; j < 4; ++j) { const int n = (lane >> 3) + 8 * j; const LAS float* s = scr + (8 * c) * 33 + n;
        u32x4 o; o.x = pk2(s[0 * 33], s[1 * 33]); o.y = pk2(s[2 * 33], s[3 * 33]); o.z = pk2(s[4 * 33], s[5 * 33]); o.w = pk2(s[6 * 33], s[7 * 33]);
        *(u32x4*)(WT + (size_t)(row_off + n0 + n) * K + k0 + 8 * c) = o; }
    LDS_WAIT(); asm volatile("" ::: "memory");
}
__device__ __forceinline__ void p0_prologue(Frame& F) {
    LAS float* scr = (LAS float*)(F.lds + F.wave * 16384);
    const int gw = F.bid * NWAVES + F.wave, NGW = F.G * NWAVES;
    constexpr int I_IN = (DM / 64) * (NPA + NPG) / 32, I_L = (DM / 64) * (64 / 32), I_BR = (DBR / 64) * (DM / 32), I_OUT = (DM / 64) * (DM / 32), I_W2 = (64 / 64) * (DBR / 32);
    constexpr int NITEMS = I_IN + 4 * I_L + 2 * I_BR + I_OUT + 2 * I_W2;
    for (int it = gw; it < NITEMS; it += NGW) {
        int r = it;
        if (r < I_IN) { p0_transpose_item(F.w_in, DM, NPA + NPG, F.WIN_T, 0, scr, r, F.lane, nullptr, 1.f, 0.f); continue; } r -= I_IN;
        if (r < I_L) { p0_transpose_item(F.w1, DM, 64, F.WIN_T, NPA + NPG + 0, scr, r, F.lane, F.mu_wa, 1.f, -1.f); continue; } r -= I_L;
        if (r < I_L) { p0_transpose_item(F.w1, DM, 64, F.WIN_T, NPA + NPG + 64, scr, r, F.lane, F.mu_wa, 0.f, 1.f); continue; } r -= I_L;
        if (r < I_L) { p0_transpose_item(F.a1, DM, 64, F.WIN_T, NPA + NPG + 128, scr, r, F.lane, F.mu_wa + DM, 1.f, -1.f); continue; } r -= I_L;
        if (r < I_L) { p0_transpose_item(F.a1, DM, 64, F.WIN_T, NPA + NPG + 192, scr, r, F.lane, F.mu_wa + DM, 0.f, 1.f); continue; } r -= I_L;
        if (r < I_BR) { p0_transpose_item(F.w_br, DBR, DM, F.WCAT_T, 0, scr, r, F.lane, nullptr, 1.f, 0.f); continue; } r -= I_BR;
        if (r < I_BR) { p0_transpose_item(F.w_ba, DBR, DM, F.WCAT_T, DM, scr, r, F.lane, nullptr, 1.f, 0.f); continue; } r -= I_BR;
        if (r < I_OUT) { p0_transpose_item(F.w_out, DM, DM, F.WOUT_T, 0, scr, r, F.lane, nullptr, 1.f, 0.f); continue; } r -= I_OUT;
        if (r < I_W2) { p0_transpose_item(F.w2, 64, DBR, F.W2T, 0, scr, r, F.lane, nullptr, 1.f, 0.f); continue; } r -= I_W2;
        p0_transpose_item(F.a2, 64, DBR, F.A2T, 0, scr, r, F.lane, nullptr, 1.f, 0.f);
    }
    for (int m = gw; m < M; m += 2 * NGW) {
        const int m2 = (m + NGW < M) ? m + NGW : m;
        const f32x4* xr = (const f32x4*)(F.x + (size_t)m * DM) + F.lane; const f32x4* xr2 = (const f32x4*)(F.x + (size_t)m2 * DM) + F.lane; const f32x4* gr = (const f32x4*)F.pre_g + F.lane;
        f32x4 v[8], w[8]; float s = 0.f, s2 = 0.f;
#pragma unroll
        for (int j = 0; j < 8; ++j) { v[j] = xr[64 * j]; w[j] = xr2[64 * j]; }
#pragma unroll
        for (int j = 0; j < 8; ++j) { s += (v[j].x * v[j].x + v[j].y * v[j].y) + (v[j].z * v[j].z + v[j].w * v[j].w); s2 += (w[j].x * w[j].x + w[j].y * w[j].y) + (w[j].z * w[j].z + w[j].w * w[j].w); }
        const float rstd = 1.0f / sqrtf(wave_sum(s) * (1.f / DM) + NORM_EPS), rstd2 = 1.0f / sqrtf(wave_sum(s2) * (1.f / DM) + NORM_EPS);
        u32x2* o8 = (u32x2*)(F.HB + (size_t)m * DM) + F.lane; u32x2* o82 = (u32x2*)(F.HB + (size_t)m2 * DM) + F.lane;
#pragma unroll
        for (int j = 0; j < 8; ++j) { const f32x4 g = gr[64 * j]; u32x2 a; a.x = pk2(v[j].x * rstd * g.x, v[j].y * rstd * g.y); a.y = pk2(v[j].z * rstd * g.z, v[j].w * rstd * g.w); o8[64 * j] = a;
            u32x2 c; c.x = pk2(w[j].x * rstd2 * g.x, w[j].y * rstd2 * g.y); c.y = pk2(w[j].z * rstd2 * g.z, w[j].w * rstd2 * g.w); o82[64 * j] = c; }
    }
}

constexpr int LSTR = 72;
constexpr int SLOT = 64 * LSTR * 2;
__device__ __forceinline__ f32x4 mm16(const LAS bf16_t* A, int m0, const LAS bf16_t* Bt, int n0, f32x4 acc, int fr, int fq) {
#pragma unroll
    for (int ks = 0; ks < 2; ++ks) {
        const bf16x8 a = *(const LAS bf16x8*)(A + (m0 + fr) * LSTR + ks * 32 + fq * 8);
        const bf16x8 b = *(const LAS bf16x8*)(Bt + (n0 + fr) * LSTR + ks * 32 + fq * 8);
        acc = __builtin_amdgcn_mfma_f32_16x16x32_bf16(a, b, acc, 0, 0, 0);
    }
    return acc;
}

typedef short v4i16_t __attribute__((ext_vector_type(4)));
__device__ __forceinline__ s16x4 tr4(const LAS bf16_t* p) { return __builtin_bit_cast(s16x4, __builtin_amdgcn_ds_read_tr16_b64_v4i16((LAS v4i16_t*)p)); }
__device__ __forceinline__ s16x4 frag_tr16(const LAS bf16_t* X, int k0, int n0, int lane) {
    const int g = lane >> 4, q = (lane & 15) >> 2, p = lane & 3;
    return tr4(X + (k0 + 4 * g + q) * LSTR + n0 + 4 * p);
}
__device__ __forceinline__ bf16x8 frag_tr32(const LAS bf16_t* X, int k0, int n0, int lane) {
    const int g = lane >> 4, q = (lane & 15) >> 2, p = lane & 3;
    const s16x4 lo = tr4(X + (k0 + 8 * g + q) * LSTR + n0 + 4 * p), hi = tr4(X + (k0 + 8 * g + 4 + q) * LSTR + n0 + 4 * p);
    return (bf16x8){lo[0], lo[1], lo[2], lo[3], hi[0], hi[1], hi[2], hi[3]};
}

constexpr int P2_GRP_BYTES = 6 * SLOT + 20 * 64 * 16;
struct KVRegs { u32x4 k0, k1, v0, v1; };
__device__ __forceinline__ void kv_load(KVRegs& R, const bf16_t* p, int key0, int d80, int key1, int d81) {
    R.k0 = *(const u32x4*)(p + (size_t)key0 * NPA + PA_KA + d80); R.k1 = *(const u32x4*)(p + (size_t)key1 * NPA + PA_KA + d81);
    R.v0 = *(const u32x4*)(p + (size_t)key0 * NPA + PA_VA + d80); R.v1 = *(const u32x4*)(p + (size_t)key1 * NPA + PA_VA + d81);
}
__device__ __forceinline__ void kv_store(const KVRegs& R, LAS unsigned char* kvb, int key0, int d80, int key1, int d81) {
    LAS bf16_t* Ks = (LAS bf16_t*)kvb; LAS bf16_t* Vs = (LAS bf16_t*)(kvb + SLOT);
    *(LAS u32x4*)(Ks + key0 * LSTR + d80) = R.k0; *(LAS u32x4*)(Ks + key1 * LSTR + d81) = R.k1; *(LAS u32x4*)(Vs + key0 * LSTR + d80) = R.v0; *(LAS u32x4*)(Vs + key1 * LSTR + d81) = R.v1;
}
constexpr int P2_CPI = 2, P2_NITEMS = BATCH * (NH / 2) * (NCHUNK / P2_CPI);
__device__ __forceinline__ void p2_advance(int cr, int& ci, int& j) { if (j == 8) { ++ci; const int nc = cr * P2_CPI + ci; j = (nc >= 8) ? 0 : 8 - nc; } else ++j; }
__device__ __forceinline__ void p2_attention(Frame& F) {
    const int tid = F.tid, lane = F.lane, wave = F.wave, fr = lane & 15, fq = lane >> 4;
    const int grp = wave >> 2, wq = wave & 3, tg = tid & 255;
    LAS unsigned char* gbase = F.lds + grp * P2_GRP_BYTES;
    LAS f32x4* Tb = (LAS f32x4*)(gbase + 6 * SLOT);
    const int key0 = (tg * 2) >> 3, d80 = ((tg * 2) & 7) * 8, key1 = (tg * 2 + 1) >> 3, d81 = ((tg * 2 + 1) & 7) * 8;
    const float L2E = 1.4426950408889634f;
    volatile LAS int* qslot = (volatile LAS int*)(F.lds + MISC_OFF + 64);
    int hp_prev = -1;
    for (;;) {
        __syncthreads();
        if (tid == 0) *qslot = (int)__hip_atomic_fetch_add(F.queue, 1u, __ATOMIC_RELAXED, __HIP_MEMORY_SCOPE_AGENT);
        __syncthreads();
        const int vb = *qslot;
        if (vb >= P2_NITEMS) break;
        constexpr int NR = NCHUNK / P2_CPI; const int b = vb / (NR * 8), hp = (vb / NR) & 7, cr = vb % NR, h = hp * 2 + grp;
        if (hp != hp_prev) for (int e = tg; e < 20 * 64; e += 256) { const int u = e / 64 - 3, ln = e & 63, lfr = ln & 15, lfq = ln >> 4; f32x4 t4;
#pragma unroll
            for (int r = 0; r < 4; ++r) { int rel = 16 * u + (lfr - 4 * lfq - r); rel = rel < -256 ? -256 : (rel > 256 ? 256 : rel); t4[r] = F.rel_bias[h * 513 + rel + 256]; }
            Tb[e] = t4; }
        hp_prev = hp;
        const float bcst = F.rel_bias[h * 513 + 512];
        const bf16_t* kvbase = F.PA + (size_t)b * SEQ * NPA + h * 64;
        int ci = 0, j = (cr * P2_CPI >= 8) ? 0 : 8 - cr * P2_CPI;
        int lci = ci, lj = j;
        KVRegs RA, RB;
        kv_load(RA, kvbase + (size_t)(cr * P2_CPI + lci - 8 + lj) * 64 * NPA, key0, d80, key1, d81); p2_advance(cr, lci, lj);
        kv_store(RA, gbase, key0, d80, key1, d81);
        kv_load(RA, kvbase + (size_t)(cr * P2_CPI + lci - 8 + lj) * 64 * NPA, key0, d80, key1, d81); p2_advance(cr, lci, lj);
        __syncthreads();
        size_t mrow0 = (size_t)b * SEQ + (size_t)(cr * P2_CPI) * 64;
        bf16x8 qa[2];
#pragma unroll
        for (int ks = 0; ks < 2; ++ks) qa[ks] = *(const bf16x8*)(F.PA + (mrow0 + 16 * wq + fr) * NPA + PA_Q + h * 64 + ks * 32 + fq * 8);
        float mrun = -1e30f, lsum = 0.f; f32x4 o[4];
#pragma unroll
        for (int dt = 0; dt < 4; ++dt) o[dt] = (f32x4){0.f, 0.f, 0.f, 0.f};
        int bufc = 0;
#define P2_STEP(RW, RL) { \
            const bool more1 = (ci < P2_CPI - 1) || (j < 8);                           \
            const bool more2 = lci < P2_CPI;                                           \
            if (more2) { kv_load(RL, kvbase + (size_t)(cr * P2_CPI + lci - 8 + lj) * 64 * NPA, key0, d80, key1, d81); p2_advance(cr, lci, lj); } \
            const LAS bf16_t* Ks = (const LAS bf16_t*)(gbase + bufc * 2 * SLOT); const LAS bf16_t* Vs = (const LAS bf16_t*)(gbase + bufc * 2 * SLOT + SLOT); \
            f32x4 s[4]; \
            _Pragma("unroll") for (int nt = 0; nt < 4; ++nt) { const int u = wq - nt + 4 * (8 - j); \
                s[nt] = (u >= 17) ? (f32x4){bcst, bcst, bcst, bcst} : Tb[(u + 3) * 64 + lane]; \
                _Pragma("unroll") for (int ks = 0; ks < 2; ++ks) { const bf16x8 kb = *(const LAS bf16x8*)(Ks + (16 * nt + fr) * LSTR + ks * 32 + fq * 8); \
                    s[nt] = __builtin_amdgcn_mfma_f32_16x16x32_bf16(kb, qa[ks], s[nt], 0, 0, 0); } } \
            float rmax = fmaxf(fmaxf(s[0][0], s[0][1]), fmaxf(s[0][2], s[0][3])); \
            _Pragma("unroll") for (int nt = 1; nt < 4; ++nt) rmax = fmaxf(rmax, fmaxf(fmaxf(s[nt][0], s[nt][1]), fmaxf(s[nt][2], s[nt][3]))); \
            rmax = fmaxf(rmax, __shfl_xor(rmax, 16)); rmax = fmaxf(rmax, __shfl_xor(rmax, 32)); \
            const float mn = fmaxf(mrun, rmax); const float alpha = __builtin_amdgcn_exp2f((mrun - mn) * L2E); mrun = mn; \
            const float mnl = mn * L2E; float ps = 0.f; \
            _Pragma("unroll") for (int nt = 0; nt < 4; ++nt) _Pragma("unroll") for (int r = 0; r < 4; ++r) { s[nt][r] = __builtin_amdgcn_exp2f(fmaf(s[nt][r], L2E, -mnl)); ps += s[nt][r]; } \
            lsum = lsum * alpha + ps; \
            _Pragma("unroll") for (int dt = 0; dt < 4; ++dt) o[dt] = o[dt] * alpha; \
            bf16x8 pb[2]; \
            _Pragma("unroll") for (int ks = 0; ks < 2; ++ks) { u32x4 w; w.x = pk2(s[2 * ks][0], s[2 * ks][1]); w.y = pk2(s[2 * ks][2], s[2 * ks][3]); w.z = pk2(s[2 * ks + 1][0], s[2 * ks + 1][1]); w.w = pk2(s[2 * ks + 1][2], s[2 * ks + 1][3]); pb[ks] = __builtin_bit_cast(bf16x8, w); } \
            _Pragma("unroll") for (int dt = 0; dt < 4; ++dt) _Pragma("unroll") for (int ks = 0; ks < 2; ++ks) { const s16x4 v0 = frag_tr16(Vs, 32 * ks, 16 * dt, lane), v1 = frag_tr16(Vs, 32 * ks + 16, 16 * dt, lane); \
                    const bf16x8 va = (bf16x8){v0[0], v0[1], v0[2], v0[3], v1[0], v1[1], v1[2], v1[3]}; \
                    o[dt] = __builtin_amdgcn_mfma_f32_16x16x32_bf16(va, pb[ks], o[dt], 0, 0, 0); } \
            if (j == 8) { \
                float l = lsum; l += __shfl_xor(l, 16); l += __shfl_xor(l, 32); \
                const float inv = 1.0f / l; const size_t m = mrow0 + 16 * wq + fr; \
                _Pragma("unroll") for (int dt = 0; dt < 4; ++dt) { const int col = h * 64 + 16 * dt + 4 * fq; \
                    const u32x2 zw = *(const u32x2*)(F.PA + m * NPA + PA_ZA + col); \
                    const float z0 = bflo(zw.x), z1 = bfhi(zw.x), z2 = bflo(zw.y), z3 = bfhi(zw.y); \
                    u32x2 yw; yw.x = pk2(o[dt][0] * inv * z0 * sigmoidf_(z0), o[dt][1] * inv * z1 * sigmoidf_(z1)); yw.y = pk2(o[dt][2] * inv * z2 * sigmoidf_(z2), o[dt][3] * inv * z3 * sigmoidf_(z3)); \
                    *(u32x2*)(F.YCAT + ((size_t)M + m) * DBR + col) = yw; } \
                if (more1) { \
                    mrow0 = (size_t)b * SEQ + (size_t)(cr * P2_CPI + ci + 1) * 64; \
                    _Pragma("unroll") for (int ks = 0; ks < 2; ++ks) qa[ks] = *(const bf16x8*)(F.PA + (mrow0 + 16 * wq + fr) * NPA + PA_Q + h * 64 + ks * 32 + fq * 8); \
                    mrun = -1e30f; lsum = 0.f; \
                    _Pragma("unroll") for (int dt = 0; dt < 4; ++dt) o[dt] = (f32x4){0.f, 0.f, 0.f, 0.f}; \
                } \
            } \
            const int bufn = (bufc == 2) ? 0 : bufc + 1; \
            if (more1) kv_store(RW, gbase + bufn * 2 * SLOT, key0, d80, key1, d81); \
            __syncthreads(); \
            if (!more1) break; \
            p2_advance(cr, ci, j); bufc = bufn; }
        for (;;) {
            P2_STEP(RA, RB)
            P2_STEP(RB, RA)
        }
#undef P2_STEP
    }
}

constexpr int FSTR = 68;
constexpr int DSTR = 24;
__device__ __forceinline__ f32x4 mfma16(s16x4 a, s16x4 b, f32x4 c) {
    const bf16x8 a8 = (bf16x8){a[0], a[1], a[2], a[3], 0, 0, 0, 0}, b8 = (bf16x8){b[0], b[1], b[2], b[3], 0, 0, 0, 0};
    return __builtin_amdgcn_mfma_f32_16x16x32_bf16(a8, b8, c, 0, 0, 0); }
__device__ __forceinline__ s16x4 cvt_hi(const f32x4 v) { u32x2 w; w.x = pk2(v[0], v[1]); w.y = pk2(v[2], v[3]); return __builtin_bit_cast(s16x4, w); }
__device__ __forceinline__ s16x4 cvt_lo(const f32x4 v, const s16x4 hi) { const u32x2 h = __builtin_bit_cast(u32x2, hi);
    u32x2 w; w.x = pk2(v[0] - bflo(h.x), v[1] - bfhi(h.x)); w.y = pk2(v[2] - bflo(h.y), v[3] - bfhi(h.y)); return __builtin_bit_cast(s16x4, w); }
struct P3Loads { u32x4 w2, a2, pr, pk, pv, qr, qk, qv; f32x4 mur[2], muk[2], muv[2], kkp[2], kap[2], rkp[2]; };
__device__ __forceinline__ void p3_load(Frame& F, P3Loads& G, int h, size_t m, int t_e, int c8, bool hasprev) {
    const u32x4 zero4 = (u32x4){0u, 0u, 0u, 0u};
    G.w2 = *(const u32x4*)(F.W2T + (size_t)(h * 64 + t_e) * 64 + c8); G.a2 = *(const u32x4*)(F.A2T + (size_t)(h * 64 + t_e) * 64 + c8);
    const bf16_t* rowp = F.PA + m * NPA + h * 64 + c8;
    G.pr = *(const u32x4*)(rowp + PA_R); G.pk = *(const u32x4*)(rowp + PA_K); G.pv = *(const u32x4*)(rowp + PA_V);
    G.qr = hasprev ? *(const u32x4*)(rowp - NPA + PA_R) : zero4; G.qk = hasprev ? *(const u32x4*)(rowp - NPA + PA_K) : zero4; G.qv = hasprev ? *(const u32x4*)(rowp - NPA + PA_V) : zero4;
    const int ch0 = h * 64 + c8;
#pragma unroll
    for (int q = 0; q < 2; ++q) { G.mur[q] = *(const f32x4*)(F.mu_rkv + ch0 + 4 * q); G.muk[q] = *(const f32x4*)(F.mu_rkv + DBR + ch0 + 4 * q); G.muv[q] = *(const f32x4*)(F.mu_rkv + 2 * DBR + ch0 + 4 * q);
        G.kkp[q] = *(const f32x4*)(F.k_k + ch0 + 4 * q); G.kap[q] = *(const f32x4*)(F.k_a + ch0 + 4 * q); G.rkp[q] = *(const f32x4*)(F.r_k + ch0 + 4 * q); }
}
__device__ __forceinline__ void p3_prep(Frame& F) {
    const int wave = F.wave;
    LAS unsigned char* L = F.lds;
    LAS bf16_t* X_A = (LAS bf16_t*)(L + 0 * SLOT);
    LAS bf16_t* X_B = (LAS bf16_t*)(L + 1 * SLOT);
    LAS bf16_t* X_K = (LAS bf16_t*)(L + 2 * SLOT);
    LAS bf16_t* X_R = (LAS bf16_t*)(L + 3 * SLOT);
    LAS bf16_t* X_V = (LAS bf16_t*)(L + 4 * SLOT);
    LAS bf16_t* S_TW = (LAS bf16_t*)(L + 5 * SLOT);
    LAS bf16_t* S_TA = (LAS bf16_t*)(L + 6 * SLOT);
    LAS bf16_t* A_AB = (LAS bf16_t*)(L + 7 * SLOT);
    LAS bf16_t* A_AK = (LAS bf16_t*)(L + 8 * SLOT);
    LAS bf16_t* A_RB = (LAS bf16_t*)(L + 9 * SLOT);
    LAS bf16_t* A_RK = (LAS bf16_t*)(L + 10 * SLOT);
    LAS bf16_t* DB = (LAS bf16_t*)(L + 11 * SLOT);
    LAS float* CLf = (LAS float*)(L + 12 * SLOT);
    LAS float* Af = CLf + 64 * FSTR;
    LAS float* GL = Af + 64 * FSTR;
    LAS bf16_t* ST_Q = A_AK; LAS bf16_t* ST_Y = X_A; LAS bf16_t* ST_M = X_V; LAS bf16_t* ST_N = (LAS bf16_t*)CLf;
    const int mt = wave >> 1, ntb = (wave & 1) * 2;
    for (int vb = F.bid; vb < 256; vb += F.G) {
        const int b = vb >> 7, c = vb & 127; const size_t mrow0 = (size_t)b * SEQ + (size_t)c * 64;
        {
            const int t_e = F.tid >> 3, c8 = (F.tid & 7) * 8; const size_t m = mrow0 + t_e; const bool hasprev = (c > 0) || (t_e > 0);
            const u32x4 zero4 = (u32x4){0u, 0u, 0u, 0u};
            float sw[8], sa[8];
#pragma unroll
            for (int e = 0; e < 8; ++e) { sw[e] = 0.f; sa[e] = 0.f; }
#pragma unroll
            for (int q = 0; q < 4; ++q) { const bf16_t* slab = F.PL + (size_t)q * ((size_t)M * NPL);
                const u32x4 g_law = *(const u32x4*)(slab + m * NPL + 0 + c8), g_laa = *(const u32x4*)(slab + m * NPL + 128 + c8);
                const u32x4 g_lbw = hasprev ? *(const u32x4*)(slab + (m - 1) * NPL + 64 + c8) : zero4, g_lba = hasprev ? *(const u32x4*)(slab + (m - 1) * NPL + 192 + c8) : zero4;
                float law[8], laa[8], lbw[8], lba[8];
                unpack8(g_law, law); unpack8(g_laa, laa); unpack8(g_lbw, lbw); unpack8(g_lba, lba);
#pragma unroll
                for (int e = 0; e < 8; ++e) { sw[e] += law[e] + lbw[e]; sa[e] += laa[e] + lba[e]; } }
            float tw[8], ta[8];
#pragma unroll
            for (int e = 0; e < 8; ++e) { tw[e] = tanhf_(sw[e]); ta[e] = sa[e]; }
            __syncthreads();
            *(LAS u32x4*)(S_TW + t_e * LSTR + c8) = pack8(tw); *(LAS u32x4*)(S_TA + t_e * LSTR + c8) = pack8(ta);
        }
        P3Loads G; p3_load(F, G, 0, mrow0 + (F.tid >> 3), F.tid >> 3, (F.tid & 7) * 8, (c > 0) || ((F.tid >> 3) > 0));
        for (int h = 0; h < NH; ++h) {
            int tid = F.tid; asm volatile("" : "+v"(tid));
            const int lane = tid & 63, fr = lane & 15, fq = lane >> 4;
            const int t_e = tid >> 3, c8 = (tid & 7) * 8;
            const size_t m = mrow0 + t_e; const bool hasprev = (c > 0) || (t_e > 0);
            const u32x4 g_w2 = G.w2, g_a2 = G.a2, g_pr = G.pr, g_pk = G.pk, g_pv = G.pv, g_qr = G.qr, g_qk = G.qk, g_qv = G.qv;
            float mur[8], muk[8], muv[8], kkp[8], kap[8], rkp[8];
#pragma unroll
            for (int e = 0; e < 8; ++e) { mur[e] = G.mur[e >> 2][e & 3]; muk[e] = G.muk[e >> 2][e & 3]; muv[e] = G.muv[e >> 2][e & 3]; kkp[e] = G.kkp[e >> 2][e & 3]; kap[e] = G.kap[e >> 2][e & 3]; rkp[e] = G.rkp[e >> 2][e & 3]; }
            __syncthreads();
            *(LAS u32x4*)(A_AB + t_e * LSTR + c8) = g_w2; *(LAS u32x4*)(A_AK + t_e * LSTR + c8) = g_a2;
            __syncthreads();
#pragma unroll
            for (int q = 0; q < 2; ++q) { const int nt = ntb + q; const int ch = 16 * nt + fr;
                f32x4 dw = (f32x4){0.f, 0.f, 0.f, 0.f}, da = (f32x4){0.f, 0.f, 0.f, 0.f};
#pragma unroll
                for (int ks = 0; ks < 2; ++ks) {
                    const bf16x8 aw = *(const LAS bf16x8*)(S_TW + (16 * mt + fr) * LSTR + ks * 32 + fq * 8), aa = *(const LAS bf16x8*)(S_TA + (16 * mt + fr) * LSTR + ks * 32 + fq * 8);
                    const bf16x8 bw = *(const LAS bf16x8*)(A_AB + ch * LSTR + ks * 32 + fq * 8), ba = *(const LAS bf16x8*)(A_AK + ch * LSTR + ks * 32 + fq * 8);
                    dw = __builtin_amdgcn_mfma_f32_16x16x32_bf16(aw, bw, dw, 0, 0, 0); da = __builtin_amdgcn_mfma_f32_16x16x32_bf16(aa, ba, da, 0, 0, 0); }
                const float w0v = F.w0[h * 64 + ch], a0v = F.a0[h * 64 + ch];
#pragma unroll
                for (int r = 0; r < 4; ++r) { const int t = 16 * mt + 4 * fq + r;
                    CLf[t * FSTR + ch] = -DECAY_SCALE * sigmoidf_(w0v + dw[r]); Af[t * FSTR + ch] = sigmoidf_(a0v + da[r]); } }
            __syncthreads();
#pragma unroll
            for (int q = 0; q < 8; ++q) { const int ch = wave * 8 + q; float xv = CLf[lane * FSTR + ch];
#pragma unroll
                for (int off = 1; off < 64; off <<= 1) { const float y = __shfl_up(xv, off); if (lane >= off) xv += y; }
                CLf[lane * FSTR + ch] = xv; }
            __syncthreads();
            {
                float pr[8], pk[8], pv[8], qr[8], qk[8], qv[8];
                unpack8(g_pr, pr); unpack8(g_pk, pk); unpack8(g_pv, pv); unpack8(g_qr, qr); unpack8(g_qk, qk); unpack8(g_qv, qv);
                float rr[8], kk[8], vv[8], kn[8], av[8], cl[8], clp[8]; float nrm = 0.f;
#pragma unroll
                for (int e = 0; e < 8; ++e) {
                    rr[e] = pr[e] + (qr[e] - pr[e]) * mur[e]; kk[e] = pk[e] + (qk[e] - pk[e]) * muk[e]; vv[e] = pv[e] + (qv[e] - pv[e]) * muv[e];
                    kn[e] = kk[e] * kkp[e]; nrm += kn[e] * kn[e];
                    av[e] = Af[t_e * FSTR + c8 + e]; cl[e] = CLf[t_e * FSTR + c8 + e]; clp[e] = (t_e > 0) ? CLf[(t_e - 1) * FSTR + c8 + e] : 0.f; }
                nrm += __shfl_xor(nrm, 1); nrm += __shfl_xor(nrm, 2); nrm += __shfl_xor(nrm, 4);
                const float inrm = 1.0f / fmaxf(sqrtf(nrm), 1e-12f);
                float at_[8], bt_[8], kt_[8], rt_[8]; float bon = 0.f;
#pragma unroll
                for (int e = 0; e < 8; ++e) {
                    const float kkn = kn[e] * inrm; const float kmod = kk[e] * (1.0f + (av[e] - 1.0f) * kap[e]);
                    const float gin = __expf(cl[e]), gex = __expf(clp[e]), ginv = __expf(-cl[e]);
                    at_[e] = -kkn * gex; bt_[e] = kkn * av[e] * ginv; kt_[e] = kmod * ginv; rt_[e] = rr[e] * gin;
                    bon += rr[e] * kmod * rkp[e]; }
                bon += __shfl_xor(bon, 1); bon += __shfl_xor(bon, 2); bon += __shfl_xor(bon, 4);
                if ((tid & 7) == 0) F.BONUS[m * NH + h] = bon;
                if (t_e == 63) {
#pragma unroll
                    for (int e = 0; e < 8; ++e) GL[c8 + e] = __expf(cl[e]); }
                *(LAS u32x4*)(X_A + t_e * LSTR + c8) = pack8(at_); *(LAS u32x4*)(X_B + t_e * LSTR + c8) = pack8(bt_);
                *(LAS u32x4*)(X_K + t_e * LSTR + c8) = pack8(kt_); *(LAS u32x4*)(X_R + t_e * LSTR + c8) = pack8(rt_);
                *(LAS u32x4*)(X_V + t_e * LSTR + c8) = pack8(vv);
            }
            __syncthreads();
            if (h + 1 < NH) p3_load(F, G, h + 1, m, t_e, c8, hasprev);
#pragma unroll
            for (int q = 0; q < 2; ++q) { const int it = mt, tt = ntb + q; const int t = 16 * tt + fr, i0 = 16 * it + 4 * fq;
                const f32x4 z4 = (f32x4){0.f, 0.f, 0.f, 0.f};
                const f32x4 d_ab = mm16(X_B, 16 * it, X_A, 16 * tt, z4, fr, fq), d_ak = mm16(X_K, 16 * it, X_A, 16 * tt, z4, fr, fq);
                const f32x4 d_rb = mm16(X_B, 16 * it, X_R, 16 * tt, z4, fr, fq), d_rk = mm16(X_K, 16 * it, X_R, 16 * tt, z4, fr, fq);
                f32x4 e_ab, e_ak, e_rb, e_rk;
#pragma unroll
                for (int r = 0; r < 4; ++r) { const int i = i0 + r; e_ab[r] = (i < t) ? d_ab[r] : 0.f; e_ak[r] = (i < t) ? d_ak[r] : 0.f; e_rb[r] = (i <= t) ? d_rb[r] : 0.f; e_rk[r] = (i <= t) ? d_rk[r] : 0.f; }
                *(LAS s16x4*)(A_AB + t * LSTR + i0) = cvt_hi(e_ab); *(LAS s16x4*)(A_AK + t * LSTR + i0) = cvt_hi(e_ak);
                *(LAS s16x4*)(A_RB + t * LSTR + i0) = cvt_hi(e_rb); *(LAS s16x4*)(A_RK + t * LSTR + i0) = cvt_hi(e_rk); }
            __syncthreads();
            f32x4 rhs[4]; bf16x8 vf[2];
            const int ct = wave & 3;
            if (wave < 4) {
                const s16x4 a_t = *(const LAS s16x4*)(A_AB + (16 * wave + fr) * LSTR + 16 * wave + 4 * fq);
                const s16x4 a_c = frag_tr16(A_AB, 16 * wave, 16 * wave, lane);
                const f32x4 z4 = (f32x4){0.f, 0.f, 0.f, 0.f};
                f32x4 iden;
#pragma unroll
                for (int r = 0; r < 4; ++r) iden[r] = (4 * fq + r == fr) ? 1.0f : 0.0f;
                const u32x2 atw = __builtin_bit_cast(u32x2, a_t), acw = __builtin_bit_cast(u32x2, a_c);
                f32x4 Sc = iden + (f32x4){bflo(acw.x), bfhi(acw.x), bflo(acw.y), bfhi(acw.y)}, St = iden + (f32x4){bflo(atw.x), bfhi(atw.x), bflo(atw.y), bfhi(atw.y)};
                f32x4 Pc = mfma16(a_t, a_c, z4), Pt = mfma16(a_c, a_t, z4);
#pragma unroll
                for (int lvl = 0; lvl < 3; ++lvl) {
                    const s16x4 pt = cvt_hi(Pt), pc = cvt_hi(Pc);
                    const s16x4 sh = cvt_hi(Sc), sl = cvt_lo(Sc, sh);
                    const f32x4 Sc2 = mfma16(pt, sl, mfma16(pt, sh, Sc)), St2 = mfma16(sl, pt, mfma16(sh, pt, St));
                    Sc = Sc2; St = St2;
                    if (lvl < 2) { const f32x4 Pc2 = mfma16(pt, pc, z4), Pt2 = mfma16(pc, pt, z4); Pc = Pc2; Pt = Pt2; }
                }
                *(LAS s16x4*)(DB + (16 * wave + fr) * DSTR + 4 * fq) = cvt_hi(St);
#pragma unroll
                for (int bi = 0; bi < 4; ++bi)
#pragma unroll
                    for (int r = 0; r < 4; ++r) rhs[bi][r] = bf2f(X_A[(16 * bi + 4 * fq + r) * LSTR + 16 * ct + fr]);
                vf[0] = (bf16x8){0, 0, 0, 0, 0, 0, 0, 0}; vf[1] = vf[0];
            } else {
#pragma unroll
                for (int ks = 0; ks < 2; ++ks) vf[ks] = frag_tr32(X_V, ks * 32, 16 * ct, lane);
#pragma unroll
                for (int bi = 0; bi < 4; ++bi) { rhs[bi] = (f32x4){0.f, 0.f, 0.f, 0.f};
#pragma unroll
                    for (int ks = 0; ks < 2; ++ks) rhs[bi] = __builtin_amdgcn_mfma_f32_16x16x32_bf16(*(const LAS bf16x8*)(A_AK + (16 * bi + fr) * LSTR + ks * 32 + fq * 8), vf[ks], rhs[bi], 0, 0, 0); }
            }
            __syncthreads();
            s16x4 xb[4];
#pragma unroll
            for (int bi = 0; bi < 4; ++bi) {
                f32x4 acc = rhs[bi];
#pragma unroll
                for (int bj = 0; bj < 4; ++bj) if (bj < bi) acc = mfma16(*(const LAS s16x4*)(A_AB + (16 * bi + fr) * LSTR + 16 * bj + 4 * fq), xb[bj], acc);
                const s16x4 hi = cvt_hi(acc), lo = cvt_lo(acc, hi); const s16x4 df = *(const LAS s16x4*)(DB + (16 * bi + fr) * DSTR + 4 * fq);
                f32x4 x = mfma16(df, hi, (f32x4){0.f, 0.f, 0.f, 0.f}); x = mfma16(df, lo, x);
                xb[bi] = cvt_hi(x);
            }
            const int col = 16 * ct + fr; const int c4 = 16 * ct + 4 * fq;
#pragma unroll
            for (int bi = 0; bi < 4; ++bi) {
                f32x4 acc; const int t = 16 * bi + fr;
                if (wave < 4) { const u32x2 rw = *(const LAS u32x2*)(X_R + t * LSTR + c4); acc[0] = bflo(rw.x); acc[1] = bfhi(rw.x); acc[2] = bflo(rw.y); acc[3] = bfhi(rw.y); }
                else {
                    acc = (f32x4){0.f, 0.f, 0.f, 0.f};
#pragma unroll
                    for (int ks = 0; ks < 2; ++ks) acc = __builtin_amdgcn_mfma_f32_16x16x32_bf16(vf[ks], *(const LAS bf16x8*)(A_RK + t * LSTR + ks * 32 + fq * 8), acc, 0, 0, 0);
                }
#pragma unroll
                for (int bj = 0; bj < 4; ++bj) if (bj <= bi) acc = mfma16(xb[bj], *(const LAS s16x4*)(A_RB + t * LSTR + 16 * bj + 4 * fq), acc);
                const s16x4 o4 = cvt_hi(acc);
                if (wave < 4) *(LAS s16x4*)(ST_Q + t * LSTR + c4) = o4; else *(LAS s16x4*)(ST_Y + t * LSTR + c4) = o4;
            }
#pragma unroll
            for (int mk = 0; mk < 4; ++mk) {
                f32x4 acc = (f32x4){0.f, 0.f, 0.f, 0.f};
                if (wave < 4) {
#pragma unroll
                    for (int bj = 0; bj < 4; ++bj) acc = mfma16(xb[bj], frag_tr16(X_B, 16 * bj, 16 * mk, lane), acc);
                    const int k = 16 * mk + fr; const float gl = GL[k];
#pragma unroll
                    for (int r = 0; r < 4; ++r) acc[r] = gl * (acc[r] + ((k == c4 + r) ? 1.0f : 0.0f));
                    *(LAS s16x4*)(ST_M + k * LSTR + 32 * (ct >> 1) + 8 * fq + 4 * (ct & 1)) = cvt_hi(acc);
                } else {
#pragma unroll
                    for (int ks = 0; ks < 2; ++ks) acc = __builtin_amdgcn_mfma_f32_16x16x32_bf16(frag_tr32(X_K, ks * 32, 16 * mk, lane), vf[ks], acc, 0, 0, 0);
#pragma unroll
                    for (int bj = 0; bj < 4; ++bj) acc = mfma16(frag_tr16(X_B, 16 * bj, 16 * mk, lane), xb[bj], acc);
                    const f32x4 gl4 = *(const LAS f32x4*)(GL + 16 * mk + 4 * fq);
                    acc = acc * gl4;
                    *(LAS s16x4*)(ST_N + col * LSTR + 16 * mk + 4 * fq) = cvt_hi(acc);
                }
            }
            __syncthreads();
            { const size_t mr = mrow0 + t_e;
              const size_t ub = (size_t)((b * NH + h) * NCHUNK + c) * 4096 + t_e * 64 + c8;
              *(u32x4*)(F.QD + ub) = *(const LAS u32x4*)(ST_Q + t_e * LSTR + c8);
              *(u32x4*)(F.YCAT + mr * DBR + h * 64 + c8) = *(const LAS u32x4*)(ST_Y + t_e * LSTR + c8);
              *(u32x4*)(F.MD + ub) = *(const LAS u32x4*)(ST_M + t_e * LSTR + c8);
              *(u32x4*)(F.ND + ub) = *(const LAS u32x4*)(ST_N + t_e * LSTR + c8); }
        }
    }
}

struct ScanBuf { u32x4 m[4][2]; u32x2 nn[4]; };
__device__ __forceinline__ void scan_load(ScanBuf& B, const bf16_t* PA, size_t mrow0, int h, int v, int fr, int fq) {
#pragma unroll
    for (int i = 0; i < 4; ++i) { const bf16_t* mrowp = PA + (mrow0 + 16 * i + fr) * NPA + PA_KA + h * 64;
#pragma unroll
        for (int ks = 0; ks < 2; ++ks) B.m[i][ks] = *(const u32x4*)(mrowp + 32 * ks + 8 * fq);
        B.nn[i] = *(const u32x2*)(PA + (mrow0 + v) * NPA + PA_VA + h * 64 + 16 * i + 4 * fq); }
}
__device__ __forceinline__ void scan_step(f32x4 (&st)[4], const ScanBuf& B, bf16_t* sp, int fq) {
    u32x2 pk[4];
#pragma unroll
    for (int i = 0; i < 4; ++i) { pk[i].x = pk2(st[i][0], st[i][1]); pk[i].y = pk2(st[i][2], st[i][3]); *(u32x2*)(sp + 16 * i + 4 * fq) = pk[i]; }
    bf16x8 bfr[2];
#pragma unroll
    for (int ks = 0; ks < 2; ++ks) { u32x4 w; w.x = pk[2 * ks].x; w.y = pk[2 * ks].y; w.z = pk[2 * ks + 1].x; w.w = pk[2 * ks + 1].y; bfr[ks] = __builtin_bit_cast(bf16x8, w); }
#pragma unroll
    for (int i = 0; i < 4; ++i) { f32x4 n; n[0] = bflo(B.nn[i].x); n[1] = bfhi(B.nn[i].x); n[2] = bflo(B.nn[i].y); n[3] = bfhi(B.nn[i].y);
#pragma unroll
        for (int ks = 0; ks < 2; ++ks) n = __builtin_amdgcn_mfma_f32_16x16x32_bf16(__builtin_bit_cast(bf16x8, B.m[i][ks]), bfr[ks], n, 0, 0, 0);
        st[i] = n; }
}
constexpr int SC_NST = 2;
constexpr int SC_STEP_BYTES = 8192 + 2048, SC_SLOT_BYTES = SC_NST * SC_STEP_BYTES, SC_NSLOT = 6;
constexpr int SC_SO_OFF = SC_NSLOT * SC_SLOT_BYTES, SC_SO_STEP = 16 * LSTR * 2, SC_SO_SLOT = SC_NST * SC_SO_STEP;
__device__ __forceinline__ void scan_dma(Frame& F, int wave, int lane, int it, LAS unsigned char* slot, size_t row0, int h, int vt) {
    const int r8 = lane >> 3, cg = ((lane & 7) ^ r8) * 8;
#pragma unroll
    for (int q = 0; q < 4; ++q) { const int j = (wave - 1) + 5 * q;
        { const int st = j / 10, w10 = j % 10; const size_t ubase = row0;
            const bf16_t* g = (w10 < 8) ? F.MD + ubase + (size_t)(SC_NST * it + st) * 4096 + (8 * w10 + r8) * 64 + cg : F.ND + ubase + (size_t)(SC_NST * it + st) * 4096 + (16 * vt + 8 * (w10 - 8) + r8) * 64 + cg;
            __builtin_amdgcn_global_load_lds((const unsigned*)g, (LAS unsigned*)(slot + st * SC_STEP_BYTES + w10 * 1024), 16, 0, 0); } }
}
__device__ __forceinline__ void scan_flush(int L2, int it, const LAS unsigned char* so, bf16_t* sp0v0) {
#pragma unroll
    for (int st = 0; st < SC_NST; ++st) { const int rr = (L2 >> 3) & 15, ch = L2 & 7;
        *(u32x4*)(sp0v0 + (size_t)(SC_NST * it + st) * 4096 + rr * 64 + ch * 8) = *(const LAS u32x4*)(so + st * SC_SO_STEP + rr * (LSTR * 2) + ch * 16); }
}
__device__ __forceinline__ void p4_scan(Frame& F) {
    const int lane = F.lane, wave = F.wave, fr = lane & 15, fq = lane >> 4;
    constexpr int NIT = NCHUNK / SC_NST;
    for (int vb = F.bid; vb < 128; vb += F.G) {
        const int b = vb >> 6, h = (vb >> 2) & 15, vt = vb & 3;
        const size_t row0 = (size_t)((b * NH + h) * NCHUNK) * 4096;
        const int L = (wave - 1) * 64 + lane;
        bf16_t* sp0v0 = F.STATES + ((size_t)((b * NH + h) * NCHUNK)) * 4096 + (16 * vt) * 64;
        __syncthreads();
        if (wave >= 1 && wave <= 5) {
#pragma unroll
            for (int p = 0; p < 5; ++p) scan_dma(F, wave, lane, p, F.lds + p * SC_SLOT_BYTES, row0, h, vt);
        }
        asm volatile("s_waitcnt vmcnt(0)\n\ts_barrier" ::: "memory");
        f32x4 st[4];
#pragma unroll
        for (int i = 0; i < 4; ++i) st[i] = (f32x4){0.f, 0.f, 0.f, 0.f};
        int cur = 0, cur3 = 0;
        for (int it = 0; it < NIT; ++it) {
            if (wave >= 6) {
                if (it >= 1) scan_flush(L - 320, it - 1, F.lds + SC_SO_OFF + ((cur3 == 0) ? 2 : cur3 - 1) * SC_SO_SLOT, sp0v0);
            } else if (wave >= 1) {
                const int s5 = (cur == 0) ? 5 : cur - 1;
                if (it + 5 < NIT) scan_dma(F, wave, lane, it + 5, F.lds + s5 * SC_SLOT_BYTES, row0, h, vt);
                asm volatile("s_waitcnt vmcnt(16)" ::: "memory");
            } else {
                const LAS unsigned char* slot = F.lds + cur * SC_SLOT_BYTES; LAS unsigned char* so = F.lds + SC_SO_OFF + cur3 * SC_SO_SLOT;
#pragma unroll
                for (int s4 = 0; s4 < SC_NST; ++s4) {
                    u32x2 pk[4];
#pragma unroll
                    for (int i = 0; i < 4; ++i) { pk[i].x = pk2(st[i][0], st[i][1]); pk[i].y = pk2(st[i][2], st[i][3]); *(LAS u32x2*)(so + s4 * SC_SO_STEP + fr * (LSTR * 2) + (16 * i + 4 * fq) * 2) = pk[i]; }
                    bf16x8 bfr[2];
#pragma unroll
                    for (int ks = 0; ks < 2; ++ks) { u32x4 w; w.x = pk[2 * ks].x; w.y = pk[2 * ks].y; w.z = pk[2 * ks + 1].x; w.w = pk[2 * ks + 1].y; bfr[ks] = __builtin_bit_cast(bf16x8, w); }
#pragma unroll
                    for (int i = 0; i < 4; ++i) {
                        const u32x2 nn = *(const LAS u32x2*)(slot + s4 * SC_STEP_BYTES + 8192 + fr * 128 + (((2 * i + (fq >> 1)) ^ (fr & 7)) * 16) + (fq & 1) * 8);
                        f32x4 n; n[0] = bflo(nn.x); n[1] = bfhi(nn.x); n[2] = bflo(nn.y); n[3] = bfhi(nn.y);
#pragma unroll
                        for (int ks = 0; ks < 2; ++ks) { const u32x4 mf = *(const LAS u32x4*)(slot + s4 * SC_STEP_BYTES + (16 * i + fr) * 128 + (((4 * ks + fq) ^ (fr & 7)) * 16));
                            n = __builtin_amdgcn_mfma_f32_16x16x32_bf16(__builtin_bit_cast(bf16x8, mf), bfr[ks], n, 0, 0, 0); }
                        st[i] = n; }
                }
            }
            asm volatile("s_waitcnt lgkmcnt(0)\n\ts_barrier" ::: "memory");
            cur = (cur == 5) ? 0 : cur + 1; cur3 = (cur3 == 2) ? 0 : cur3 + 1;
        }
        if (wave >= 6) scan_flush(L - 320, NIT - 1, F.lds + SC_SO_OFF + ((cur3 == 0) ? 2 : cur3 - 1) * SC_SO_SLOT, sp0v0);
    }
}

__device__ __forceinline__ void p5_out(Frame& F) {
    const int lane = F.lane, wave = F.wave, fr = lane & 15, fq = lane >> 4, grp = wave >> 2, wq = wave & 3;
    for (int u = F.bid * 2 + grp; u < BATCH * NH * NCHUNK; u += F.G * 2) {
        const int c = u & 127, h = (u >> 7) & 15, b = u >> 11; const size_t mrow0 = (size_t)b * SEQ + (size_t)c * 64;
        const bf16_t* sp = F.STATES + (size_t)u * 4096;
        const int t = 16 * wq + fr; const size_t m = mrow0 + t; const bool hasprev = (c > 0) || (t > 0);
        bf16x8 qa[2];
#pragma unroll
        for (int ks = 0; ks < 2; ++ks) qa[ks] = *(const bf16x8*)(F.QD + (size_t)u * 4096 + t * 64 + ks * 32 + fq * 8);
        f32x4 y[4];
#pragma unroll
        for (int nt = 0; nt < 4; ++nt) {
            const u32x2 yl = *(const u32x2*)(F.YCAT + m * DBR + h * 64 + 16 * nt + 4 * fq);
            y[nt] = (f32x4){bflo(yl.x), bfhi(yl.x), bflo(yl.y), bfhi(yl.y)};
#pragma unroll
            for (int ks = 0; ks < 2; ++ks) { const bf16x8 sb = *(const bf16x8*)(sp + (16 * nt + fr) * 64 + ks * 32 + fq * 8);
                y[nt] = __builtin_amdgcn_mfma_f32_16x16x32_bf16(sb, qa[ks], y[nt], 0, 0, 0); } }
        float s = 0.f;
#pragma unroll
        for (int nt = 0; nt < 4; ++nt) s += (y[nt][0] + y[nt][1]) + (y[nt][2] + y[nt][3]);
        s += __shfl_xor(s, 16); s += __shfl_xor(s, 32);
        const float mean = s * (1.0f / 64.0f);
        float q = 0.f;
#pragma unroll
        for (int nt = 0; nt < 4; ++nt)
#pragma unroll
            for (int r = 0; r < 4; ++r) { const float d = y[nt][r] - mean; q += d * d; }
        q += __shfl_xor(q, 16); q += __shfl_xor(q, 32);
        const float rstd = 1.0f / sqrtf(q * (1.0f / 64.0f) + GN_EPS);
        const float bon = F.BONUS[m * NH + h];
#pragma unroll
        for (int nt = 0; nt < 4; ++nt) { const int ch = h * 64 + 16 * nt + 4 * fq;
            const u32x2 pvw = *(const u32x2*)(F.PA + m * NPA + PA_V + ch); const u32x2 qvw = hasprev ? *(const u32x2*)(F.PA + (m - 1) * NPA + PA_V + ch) : (u32x2){0u, 0u};
            const u32x2 zw = *(const u32x2*)(F.PA + m * NPA + PA_ZR + ch);
            const f32x4 mu4 = *(const f32x4*)(F.mu_rkv + 2 * DBR + ch), g4 = *(const f32x4*)(F.lnx_g + ch), b4 = *(const f32x4*)(F.lnx_b + ch);
            const f32x4 pv = (f32x4){bflo(pvw.x), bfhi(pvw.x), bflo(pvw.y), bfhi(pvw.y)}, qv = (f32x4){bflo(qvw.x), bfhi(qvw.x), bflo(qvw.y), bfhi(qvw.y)};
            const f32x4 z = (f32x4){bflo(zw.x), bfhi(zw.x), bflo(zw.y), bfhi(zw.y)};
            const f32x4 vv = pv + (qv - pv) * mu4;
            f32x4 o4;
#pragma unroll
            for (int r = 0; r < 4; ++r) o4[r] = ((y[nt][r] - mean) * rstd * g4[r] + b4[r] + bon * vv[r]) * (z[r] * sigmoidf_(z[r]));
            u32x2 ow; ow.x = pk2(o4[0], o4[1]); ow.y = pk2(o4[2], o4[3]);
            *(u32x2*)(F.YCAT + m * DBR + ch) = ow; }
    }
}

__device__ __forceinline__ void p8_final(Frame& F) {
    const int gw = F.bid * NWAVES + F.wave, NGW = F.G * NWAVES;
    for (int m0 = gw; m0 < M; m0 += 2 * NGW) {
#pragma unroll
        for (int q = 0; q < 2; ++q) { const int m = (m0 + q * NGW < M) ? m0 + q * NGW : m0;
            const f32x4* xr = (const f32x4*)(F.x + (size_t)m * DM) + 2 * F.lane; const f32x4* gr = (const f32x4*)F.post_g + 2 * F.lane;
            const u32x4* orow = (const u32x4*)(F.OBF + (size_t)m * DM) + F.lane;
            f32x4* outr = (f32x4*)(F.out + (size_t)m * DM) + 2 * F.lane;
            u32x4 ow[4]; f32x4 x0[4], x1[4];
#pragma unroll
            for (int jj = 0; jj < 4; ++jj) { ow[jj] = orow[64 * jj]; x0[jj] = xr[128 * jj]; x1[jj] = xr[128 * jj + 1]; }
            float ss = (F.lane < 32) ? F.SSP[(size_t)m * 32 + F.lane] : 0.f;
            ss = wave_sum(ss);
            const float rstd = 1.0f / sqrtf(ss * (1.f / DM) + NORM_EPS);
#pragma unroll
            for (int jj = 0; jj < 4; ++jj) { float ov[8]; unpack8(ow[jj], ov);
                const f32x4 g0 = gr[128 * jj], g1 = gr[128 * jj + 1];
                outr[128 * jj] = x0[jj] + (f32x4){ov[0], ov[1], ov[2], ov[3]} * rstd * g0; outr[128 * jj + 1] = x1[jj] + (f32x4){ov[4], ov[5], ov[6], ov[7]} * rstd * g1; }
        }
    }
}

struct Args { const float* in[22]; float* out; unsigned char* ws; int ph_lo, ph_hi, li, pad; };
constexpr int N_PHASES = 9;
__global__ void __launch_bounds__(NTHREADS, 2) mk_fwd(Args args) {
    extern __shared__ __attribute__((aligned(16))) unsigned char lds[];
    Frame F;
    F.lds = (LAS unsigned char*)lds;
    F.tid = threadIdx.x; F.lane = F.tid & 63; F.wave = __builtin_amdgcn_readfirstlane(F.tid >> 6);
    F.G = gridDim.x; F.bid = blockIdx.x;
    unsigned char* ws = args.ws;
    F.x = args.in[0]; F.pre_g = args.in[1]; F.post_g = args.in[2]; F.w_in = args.in[3]; F.mu_rkv = args.in[4]; F.mu_wa = args.in[5]; F.w0 = args.in[6]; F.w1 = args.in[7]; F.w2 = args.in[8];
    F.a0 = args.in[9]; F.a1 = args.in[10]; F.a2 = args.in[11]; F.k_k = args.in[12]; F.k_a = args.in[13]; F.r_k = args.in[14]; F.lnx_g = args.in[15]; F.lnx_b = args.in[16]; F.rel_bias = args.in[17];
    F.w_br = args.in[18]; F.w_ba = args.in[19]; F.b_merge = args.in[20]; F.w_out = args.in[21]; F.out = args.out;
    F.HB = (bf16_t*)((unsigned char*)args.out + DO_HB); F.WIN_T = (bf16_t*)((unsigned char*)args.out + DO_WIN); F.STATES = (bf16_t*)((unsigned char*)args.out + DO_STATES);
    F.MD = (bf16_t*)((unsigned char*)args.out + DO_MD); F.ND = (bf16_t*)((unsigned char*)args.out + DO_ND); F.QD = (bf16_t*)((unsigned char*)args.out + DO_QD);
    F.WCAT_T = (bf16_t*)(ws + WS_WCAT); F.WOUT_T = (bf16_t*)(ws + WS_WOUT); F.W2T = (bf16_t*)(ws + WS_W2T); F.A2T = F.W2T + DBR * 64;
    F.BONUS = (float*)(ws + WS_BONUS); F.SSP = (float*)(ws + WS_SSP); F.PL = (bf16_t*)(ws + WS_PLS); F.PG = (bf16_t*)(ws + WS_PG); F.PA = (bf16_t*)(ws + WS_PA);
    F.MERGED = (bf16_t*)(ws + WS_MERGED); F.YCAT = (bf16_t*)(ws + WS_YCAT); F.OBF = (bf16_t*)(ws + WS_OBF); F.queue = (unsigned*)(ws + WS_CTL) + 65536;
    for (int u = F.tid; u < (LDS_BYTES - LDSCTL_OFF) / 4; u += NTHREADS) ((LAS unsigned*)(F.lds + LDSCTL_OFF))[u] = 0u;
    __syncthreads();
    const int lo = args.ph_lo, hi = args.ph_hi;
    XcdBarrier bar; bar.bar = (unsigned*)(ws + WS_CTL) + CW_BAR; bar.x = 0; bar.st = nullptr;
    if (hi - lo > 1) bar = xcd_barrier_post((unsigned*)(ws + WS_CTL) + CW_BAR, (volatile LAS unsigned*)(F.lds + MISC_OFF) + 8);
#define IN(k) (lo <= (k) && (k) < hi)
#define SEAM(k) do { if (IN(k) && IN((k) + 1)) xcd_barrier(bar); } while (0)
#define PHASE(k, ...) do { if (IN(k)) { __VA_ARGS__; SEAM(k); if (PROBE_REP == (k)) { __VA_ARGS__; xcd_barrier(bar); } } } while (0)
    PHASE(0, p0_prologue(F));
    PHASE(1, {
        pg8::Gemm g{F.HB, F.WIN_T, M, NIN, DM}; pg8::SplitOrder S; S.so.init(M, NPA + NPG, F.G, F.bid, DM, WGM_P1); S.extra_pn = (NPA + NPG) / 256;
        EpiIn E{F.PA, F.PG, F.PL, F.b_merge};
        pg8::gemm_phase<EpiIn, pg8::SplitOrder, P1_ALIGN, P1_SP2>(F.lds, g, S, E);
    });
    PHASE(3, p3_prep(F));
    PHASE(4, { p4_scan(F); p2_attention(F); });
    PHASE(5, p5_out(F));
    PHASE(6, {
        pg8::Gemm g{F.YCAT, F.WCAT_T, 2 * M, 2 * DM, DBR}; pg8::PairOrder S; S.so.init(M, DM, F.G, F.bid, DBR, WGM_P6); S.dpm = M / 256; S.dpn = DM / 256;
        EpiBranch E{F.PG, F.MERGED};
        pg8::gemm_phase<EpiBranch, pg8::PairOrder, true, true>(F.lds, g, S, E);
    });
    PHASE(7, {
        pg8::Gemm g{F.MERGED, F.WOUT_T, M, DM, DM}; pg8::StaticOrder S; S.init(M, DM, F.G, F.bid, DM, WGM_P7);
        EpiOut E{F.OBF, F.SSP};
        pg8::gemm_phase<EpiOut, pg8::StaticOrder, true, true>(F.lds, g, S, E);
    });
    if (IN(8)) { p8_final(F); }
#undef PHASE
#undef IN
#undef SEAM
}

extern "C" void kernel_launch(void* const* d_in, const int* in_sizes, int n_in, void* d_out, int out_size, void* d_ws, size_t ws_size, hipStream_t stream) {
    static int grid = 0;
    if (grid == 0) {
        if (n_in != 22 || in_sizes[0] != M * DM || out_size != M * DM || ws_size < WS_END) { fprintf(stderr, "kernel_launch: unexpected shapes (n_in %d in0 %d out %d ws %zu); nothing launched\n", n_in, n_in > 0 ? in_sizes[0] : -1, out_size, ws_size); grid = -1; return; }
        int dev = 0, cus = 0;
        if (hipGetDevice(&dev) != hipSuccess || hipDeviceGetAttribute(&cus, hipDeviceAttributeMultiprocessorCount, dev) != hipSuccess) { fprintf(stderr, "kernel_launch: device query failed\n"); grid = -1; return; }
        if (hipFuncSetAttribute((const void*)mk_fwd, hipFuncAttributeMaxDynamicSharedMemorySize, LDS_BYTES) != hipSuccess) { fprintf(stderr, "kernel_launch: hipFuncSetAttribute failed\n"); grid = -1; return; }
        int per_cu = 0;
        if (hipOccupancyMaxActiveBlocksPerMultiprocessor(&per_cu, (const void*)mk_fwd, NTHREADS, LDS_BYTES) != hipSuccess || per_cu < 1) fprintf(stderr, "kernel_launch: note: occupancy query reports %d blocks per CU\n", per_cu);
        (void)hipGetLastError();
        grid = cus > 256 ? 256 : cus;
        if (grid != 256) { fprintf(stderr, "kernel_launch: this build needs a 256-CU device (got %d); nothing launched\n", cus); grid = -1; return; }
    }
    if (grid < 0) return;
    (void)hipMemsetAsync((char*)d_ws + WS_CTL, 0, CTL_ZERO_BYTES, stream);
    Args a{};
    for (int i = 0; i < 22; ++i) a.in[i] = (const float*)d_in[i];
    a.out = (float*)d_out; a.ws = (unsigned char*)d_ws;
#if MK_N_LAUNCHES == 1
    a.ph_lo = 0; a.ph_hi = N_PHASES; a.li = 0;
    hipLaunchKernelGGL(mk_fwd, dim3(grid), dim3(NTHREADS), LDS_BYTES, stream, a);
#else
    for (int li = 0; li < N_PHASES; ++li) { a.ph_lo = li; a.ph_hi = li + 1; a.li = li; hipLaunchKernelGGL(mk_fwd, dim3(grid), dim3(NTHREADS), LDS_BYTES, stream, a); }
#endif
}
```

```cpp
#include <hip/hip_runtime.h>
#include <cstdio>
#include <cstdint>

#ifndef MK_N_LAUNCHES
#define MK_N_LAUNCHES 1
#endif
#ifndef WGM_P1
#define WGM_P1 6
#endif
#ifndef WGM_P6
#define WGM_P6 2
#endif
#ifndef WGM_P7
#define WGM_P7 2
#endif
#ifndef P1_ALIGN
#define P1_ALIGN true
#endif
#ifndef P1_SP2
#define P1_SP2 true
#endif
#ifndef XCD_REMAP
#define XCD_REMAP 1
#endif
#ifndef ROT_COLS
#define ROT_COLS 0
#endif
#ifndef PROBE_REP
#define PROBE_REP -1
#endif

#define LAS __attribute__((address_space(3)))
#define GAS __attribute__((address_space(1)))
typedef unsigned short bf16_t;
typedef short bf16x8 __attribute__((ext_vector_type(8)));
typedef short s16x4 __attribute__((ext_vector_type(4)));
typedef float f32x4 __attribute__((ext_vector_type(4)));
typedef float f32x2 __attribute__((ext_vector_type(2)));
typedef unsigned u32x4 __attribute__((ext_vector_type(4)));
typedef unsigned u32x2 __attribute__((ext_vector_type(2)));
typedef __bf16 bf16x2_t __attribute__((ext_vector_type(2)));

constexpr int BATCH = 2, SEQ = 8192, DM = 2048, DBR = 1024, NH = 16, HD = 64, CHUNK = 64, NCHUNK = SEQ / CHUNK, M = BATCH * SEQ;
constexpr int NPA = 8192, NPG = 4096, NPL = 256, NIN = NPA + NPG + NPL;
constexpr int PA_R = 0, PA_K = 1024, PA_V = 2048, PA_ZR = 3072, PA_Q = 4096, PA_KA = 5120, PA_VA = 6144, PA_ZA = 7168;
constexpr float NORM_EPS = 1e-6f, GN_EPS = 64e-5f, DECAY_SCALE = 0.606531f;
constexpr int NWAVES = 8, NTHREADS = 512;

constexpr size_t MiB = 1u << 20;
constexpr size_t WS_CTL = 0, CTL_ZERO_BYTES = 1 * MiB;
constexpr size_t WS_WCAT = 1 * MiB;
constexpr size_t WS_WOUT = 9 * MiB;
constexpr size_t WS_W2T = 17 * MiB;
constexpr size_t WS_BONUS = 18 * MiB;
constexpr size_t WS_SSP = 19 * MiB;
constexpr size_t WS_PL = 22 * MiB;
constexpr size_t WS_PG = 30 * MiB;
constexpr size_t WS_PA = 158 * MiB;
constexpr size_t WS_MERGED = WS_PA;
constexpr size_t WS_OBF = WS_PA + 64 * MiB;
constexpr size_t WS_YCAT = 414 * MiB;
constexpr size_t WS_PLS = 478 * MiB;
constexpr size_t WS_END = 510 * MiB;
constexpr size_t DO_HB = 0, DO_WIN = 64 * MiB, DO_STATES = 0;
constexpr size_t DO_MD = 32 * MiB, DO_ND = 64 * MiB, DO_QD = 96 * MiB;
constexpr int CW_BAR = 4096;

constexpr int RING_BYTES = 131072;
constexpr int LDSCTL_OFF = 152576, MISC_OFF = LDSCTL_OFF + 320;
constexpr int LDS_BYTES = 153600;

typedef GAS unsigned gu32;
#define RLX_AGENT __ATOMIC_RELAXED, __HIP_MEMORY_SCOPE_AGENT
#define LDS_WAIT() asm volatile("s_waitcnt lgkmcnt(0)" ::: "memory")
#define VM_WAIT() asm volatile("s_waitcnt vmcnt(0)" ::: "memory")
__device__ __forceinline__ unsigned pk2(float lo, float hi) { f32x2 v = {lo, hi}; bf16x2_t b = __builtin_convertvector(v, bf16x2_t); return __builtin_bit_cast(unsigned, b); }
__device__ __forceinline__ bf16_t f2bf(float f) { return (bf16_t)(pk2(f, 0.f) & 0xffffu); }
__device__ __forceinline__ float bflo(unsigned w) { return __uint_as_float(w << 16); }
__device__ __forceinline__ float bfhi(unsigned w) { return __uint_as_float(w & 0xffff0000u); }
__device__ __forceinline__ float bf2f(bf16_t h) { return __uint_as_float(((unsigned)h) << 16); }
__device__ __forceinline__ void unpack8(const u32x4 w, float (&f)[8]) { f[0] = bflo(w.x); f[1] = bfhi(w.x); f[2] = bflo(w.y); f[3] = bfhi(w.y); f[4] = bflo(w.z); f[5] = bfhi(w.z); f[6] = bflo(w.w); f[7] = bfhi(w.w); }
__device__ __forceinline__ u32x4 pack8(const float (&f)[8]) { u32x4 w; w.x = pk2(f[0], f[1]); w.y = pk2(f[2], f[3]); w.z = pk2(f[4], f[5]); w.w = pk2(f[6], f[7]); return w; }
__device__ __forceinline__ void load8(const float* p, float (&f)[8]) { const f32x4 a = *(const f32x4*)p, b = *(const f32x4*)(p + 4); f[0] = a.x; f[1] = a.y; f[2] = a.z; f[3] = a.w; f[4] = b.x; f[5] = b.y; f[6] = b.z; f[7] = b.w; }
__device__ __forceinline__ float sigmoidf_(float x) { return 1.f / (1.f + __expf(-x)); }
__device__ __forceinline__ float tanhf_(float x) { return 1.f - 2.f / (1.f + __expf(2.f * x)); }

namespace pg8 {
constexpr int BM = 256, BK = 64, HALF = 128, HTB = HALF * BK * 2  , STAGE_BYTES = 8 * HTB, NXCD = 8;
__host__ __device__ __forceinline__ int lds_byte(int r, int c) { const int st = (r >> 4) * 2 + (c >> 5), rr = r & 15, cc = c & 31, ob = rr * 64 + cc * 2; return st * 1024 + (ob ^ (((ob >> 9) & 1) << 5)); }
__host__ __device__ __forceinline__ void stage_rc(int b, int& R, int& C) { const int st = b / 1024, sb = b % 1024, swz = sb ^ (((sb >> 9) & 1) << 5); R = (st >> 1) * 16 + swz / 64; C = (st & 1) * 32 + (swz % 64) / 2; }
__host__ __device__ __forceinline__ int perm32(int rho) { const int n = rho >> 4, i = rho & 15; return 8 * (i >> 2) + 4 * n + (i & 3); }

struct Unit { int pm, pn, kb, nt; };
struct Gemm { const bf16_t* A; const bf16_t* Bt; int M, N, K; };

struct StaticOrder {
    int nM, nN, nwg, G, c, ntk, WGM;
    __host__ __device__ void init(int M_, int N_, int G_, int c_, int K_, int wgm_) { nM = M_ / BM; nN = N_ / BM; nwg = nM * nN; G = G_; c = c_; ntk = K_ / BK; WGM = wgm_; }
    __host__ __device__ void tile(int L, int& pm, int& pn) const {
        int wgid = L; if (XCD_REMAP) { const int q = nwg / NXCD, r = nwg % NXCD, xcd = wgid % NXCD, off = wgid / NXCD; wgid = (xcd < r ? xcd * (q + 1) : r * (q + 1) + (xcd - r) * q) + off; }
        if (WGM > 0) { const int nig = WGM * nN, gid = wgid / nig, fm = gid * WGM, gsz = (nM - fm) < WGM ? (nM - fm) : WGM;
            pm = fm + ((wgid % nig) % gsz); pn = (wgid % nig) / gsz;
            if (ROT_COLS) pn = (pn + ROT_COLS * gid) % nN; }
        else { const int W = -WGM, nig = W * nM, gid = wgid / nig, fn = gid * W, gsz = (nN - fn) < W ? (nN - fn) : W;
            pn = fn + ((wgid % nig) % gsz); pm = (wgid % nig) / gsz; }
    }
    __host__ __device__ bool next(int i, Unit& u) const {
        const long L = (long)i * G + c; if (L >= nwg) return false;
        int pm, pn; tile((int)L, pm, pn);
        u.pm = pm; u.pn = pn; u.kb = 0; u.nt = ntk; return true;
    }
};
struct SplitOrder {
    StaticOrder so; int extra_pn;
    __host__ __device__ bool next(int i, Unit& u) const {
        const long L = (long)i * so.G + so.c; const bool normal = L < so.nwg; const int Lq = (int)(L - so.nwg);
        if (!normal && Lq >= 256) return false;
        int pm, pn; so.tile(normal ? (int)L : 0, pm, pn);
        u.pm = normal ? pm : (Lq >> 2); u.pn = normal ? pn : extra_pn; u.kb = normal ? 0 : (Lq & 3) * 1024; u.nt = normal ? so.ntk : 8; return true;
    }
};
struct PairOrder {
    StaticOrder so; int dpm, dpn;
    __host__ __device__ bool next(int i, Unit& u) const { if (!so.next(i >> 1, u)) return false; if (i & 1) { u.pm += dpm; u.pn += dpn; } return true; }
};

template <class Epi, class Sched, bool ALIGN_EPI = false, bool SP2 = false>
__device__ __forceinline__ void gemm_phase(LAS unsigned char* lds, const Gemm g, const Sched& S, const Epi& E) {
    const int tid = threadIdx.x, wid = __builtin_amdgcn_readfirstlane(tid >> 6), lane = tid & 63, wr = wid >> 2, wc = wid & 3, fr = lane & 15, fq = lane >> 4;
    const int K = g.K;
    unsigned voffA[2], voffB[2];
#pragma unroll
    for (int i = 0; i < 2; ++i) { int R, C; stage_rc(tid * 16 + i * 8192, R, C); const int Rb = Epi::PERM ? ((R & ~31) + perm32(R & 31)) : R;
        voffA[i] = (unsigned)(R * K + C) * 2u; voffB[i] = (unsigned)(Rb * K + C) * 2u; }
    const size_t kstep = (size_t)(BK * 2);
    const size_t hstep = (size_t)HALF * K * 2;
    const size_t tstep = 2 * hstep;
    const unsigned ldsw = (unsigned)wid * 1024u;
    const int aoff = lds_byte(wr * 64 + fr, fq * 8), boff = lds_byte(wc * 32 + fr, fq * 8);
#define PG8_SA(b, h) (((b) * 2 + (h)) * HTB)
#define PG8_SB(b, h) ((4 + (b) * 2 + (h)) * HTB)
#define PG8_STAGE(bufoff, gbase, voff) do { _Pragma("unroll") for (int _i = 0; _i < 2; ++_i) \
        __builtin_amdgcn_global_load_lds((const unsigned*)((const char*)(gbase) + (voff)[_i]), (LAS unsigned*)(lds + (bufoff) + ldsw + _i * 8192), 16, 0, 0); } while (0)
#define PG8_LDA(dst, b, h) do { _Pragma("unroll") for (int m = 0; m < 4; ++m) _Pragma("unroll") for (int k = 0; k < 2; ++k) dst[m][k] = *(const LAS bf16x8*)(lds + PG8_SA(b, h) + aoff + m * 2048 + k * 1024); } while (0)
#define PG8_LDB(dst, b, h) do { _Pragma("unroll") for (int n = 0; n < 2; ++n) _Pragma("unroll") for (int k = 0; k < 2; ++k) dst[n][k] = *(const LAS bf16x8*)(lds + PG8_SB(b, h) + boff + n * 2048 + k * 1024); } while (0)
#define PG8_MMA(ai, bj, At, Bt) do { __builtin_amdgcn_s_setprio(1); _Pragma("unroll") for (int m = 0; m < 4; ++m) _Pragma("unroll") for (int n = 0; n < 2; ++n) _Pragma("unroll") for (int k = 0; k < 2; ++k) \
        acc[ai][bj][m][n] = __builtin_amdgcn_mfma_f32_16x16x32_bf16(Bt[n][k], At[m][k], acc[ai][bj][m][n], 0, 0, 0); __builtin_amdgcn_s_setprio(0); } while (0)
#define PG8_WAIT_V(n) asm volatile("s_waitcnt vmcnt(" #n ")" ::: "memory")
#define PG8_WAIT_L(n) asm volatile("s_waitcnt lgkmcnt(" #n ")" ::: "memory")
#define PG8_BAR __builtin_amdgcn_s_barrier()
#define PG8_SCHED __builtin_amdgcn_sched_barrier(0)
    Unit cur, nxt; int ui = 0;
    if (!S.next(0, cur)) return;
    f32x4 acc[2][2][4][2];
#pragma unroll
    for (int a = 0; a < 2; ++a)
#pragma unroll
        for (int b = 0; b < 2; ++b)
#pragma unroll
            for (int m = 0; m < 4; ++m)
#pragma unroll
                for (int n = 0; n < 2; ++n) acc[a][b][m][n] = (f32x4){0.f, 0.f, 0.f, 0.f};
    bf16x8 At[4][2], B0[2][2], B1[2][2];
    const char* cA = (const char*)g.A + (size_t)cur.pm * tstep + cur.kb; const char* cB = (const char*)g.Bt + (size_t)cur.pn * tstep + cur.kb;
    if constexpr (SP2) {
        PG8_STAGE(PG8_SB(0, 0), cB, voffB); PG8_STAGE(PG8_SB(0, 1), cB + hstep, voffB); PG8_STAGE(PG8_SA(0, 0), cA, voffA); PG8_STAGE(PG8_SA(0, 1), cA + hstep, voffA);
        if (wr == 1) PG8_BAR;
        PG8_WAIT_V(2); PG8_BAR;
        PG8_STAGE(PG8_SB(1, 0), cB + kstep, voffB); PG8_STAGE(PG8_SA(1, 0), cA + kstep, voffA); PG8_STAGE(PG8_SB(1, 1), cB + hstep + kstep, voffB);
        PG8_WAIT_V(6); PG8_BAR;
    } else {
        PG8_STAGE(PG8_SB(0, 0), cB, voffB); PG8_STAGE(PG8_SA(0, 0), cA, voffA); PG8_STAGE(PG8_SB(0, 1), cB + hstep, voffB); PG8_STAGE(PG8_SA(0, 1), cA + hstep, voffA);
        if (wr == 1) PG8_BAR;
        PG8_WAIT_V(4); PG8_BAR;
        PG8_STAGE(PG8_SB(1, 0), cB + kstep, voffB); PG8_STAGE(PG8_SA(1, 0), cA + kstep, voffA); PG8_STAGE(PG8_SB(1, 1), cB + hstep + kstep, voffB);
        PG8_WAIT_V(6); PG8_BAR;
    }
    for (;;) {
        const bool has_next = S.next(ui + 1, nxt);
        const char* nA = has_next ? (const char*)g.A + (size_t)nxt.pm * tstep + nxt.kb : cA; const char* nB = has_next ? (const char*)g.Bt + (size_t)nxt.pn * tstep + nxt.kb : cB;
        const int nt = cur.nt;
        for (int t = 0; t < nt; t += 2) {
            const bool last = (t == nt - 2);
            const char* a1 = cA + (size_t)(t + 1) * kstep;
            const char* a2 = last ? nA : cA + (size_t)(t + 2) * kstep; const char* b2 = last ? nB : cB + (size_t)(t + 2) * kstep;
            const char* a3 = a2 + kstep; const char* b3 = b2 + kstep;
            if constexpr (SP2) {
            PG8_LDB(B0, 0, 0); PG8_LDB(B1, 0, 1); PG8_SCHED; PG8_LDA(At, 0, 0); PG8_STAGE(PG8_SA(1, 1), a1 + hstep, voffA);
            PG8_WAIT_V(8); PG8_WAIT_L(0); PG8_BAR; PG8_MMA(0, 0, At, B0); PG8_MMA(0, 1, At, B1); PG8_BAR; PG8_SCHED;
            PG8_LDA(At, 0, 1); PG8_STAGE(PG8_SB(0, 0), b2, voffB); PG8_STAGE(PG8_SB(0, 1), b2 + hstep, voffB); PG8_STAGE(PG8_SA(0, 0), a2, voffA);
            PG8_WAIT_V(8); PG8_WAIT_L(0); PG8_BAR; PG8_MMA(1, 0, At, B0); PG8_MMA(1, 1, At, B1); PG8_BAR; PG8_SCHED;
            PG8_LDB(B0, 1, 0); PG8_LDB(B1, 1, 1); PG8_SCHED; PG8_LDA(At, 1, 0); PG8_STAGE(PG8_SA(0, 1), a2 + hstep, voffA);
            PG8_WAIT_V(8); PG8_WAIT_L(0); PG8_BAR; PG8_MMA(0, 0, At, B0); PG8_MMA(0, 1, At, B1); PG8_BAR; PG8_SCHED;
            PG8_LDA(At, 1, 1); PG8_STAGE(PG8_SB(1, 0), b3, voffB); PG8_STAGE(PG8_SB(1, 1), b3 + hstep, voffB); PG8_STAGE(PG8_SA(1, 0), a3, voffA);
            PG8_WAIT_V(8); PG8_WAIT_L(0); PG8_BAR; PG8_MMA(1, 0, At, B0); PG8_MMA(1, 1, At, B1); PG8_BAR; PG8_SCHED;
            } else {
            PG8_LDB(B0, 0, 0); PG8_SCHED; PG8_LDA(At, 0, 0); PG8_STAGE(PG8_SA(1, 1), a1 + hstep, voffA);
            PG8_WAIT_L(8); PG8_BAR; PG8_WAIT_L(0); PG8_MMA(0, 0, At, B0); PG8_BAR; PG8_SCHED;
            PG8_LDB(B1, 0, 1); PG8_STAGE(PG8_SB(0, 0), b2, voffB);
            PG8_BAR; PG8_WAIT_L(0); PG8_MMA(0, 1, At, B1); PG8_BAR;
            PG8_LDA(At, 0, 1); PG8_STAGE(PG8_SA(0, 0), a2, voffA);
            PG8_BAR; PG8_WAIT_L(0); PG8_MMA(1, 0, At, B0); PG8_BAR; PG8_SCHED;
            PG8_STAGE(PG8_SB(0, 1), b2 + hstep, voffB);
            PG8_WAIT_V(6); PG8_BAR; PG8_MMA(1, 1, At, B1); PG8_BAR;
            PG8_LDB(B0, 1, 0); PG8_SCHED; PG8_LDA(At, 1, 0); PG8_STAGE(PG8_SA(0, 1), a2 + hstep, voffA);
            PG8_WAIT_L(8); PG8_BAR; PG8_WAIT_L(0); PG8_MMA(0, 0, At, B0); PG8_BAR; PG8_SCHED;
            PG8_LDB(B1, 1, 1); PG8_STAGE(PG8_SB(1, 0), b3, voffB);
            PG8_BAR; PG8_WAIT_L(0); PG8_MMA(0, 1, At, B1); PG8_BAR;
            PG8_LDA(At, 1, 1); PG8_STAGE(PG8_SA(1, 0), a3, voffA);
            PG8_BAR; PG8_WAIT_L(0); PG8_MMA(1, 0, At, B0); PG8_BAR; PG8_SCHED;
            PG8_STAGE(PG8_SB(1, 1), b3 + hstep, voffB);
            PG8_WAIT_V(6); PG8_BAR; PG8_MMA(1, 1, At, B1); PG8_BAR;
            }
        }
        if constexpr (ALIGN_EPI) { if (wr == 0) PG8_BAR; }
        const bool zero_acc = E(acc, cur, wr, wc, fr, fq);
        if (!has_next) break;
        if (zero_acc) {
#pragma unroll
        for (int a = 0; a < 2; ++a)
#pragma unroll
            for (int b = 0; b < 2; ++b)
#pragma unroll
                for (int m = 0; m < 4; ++m)
#pragma unroll
                    for (int n = 0; n < 2; ++n) acc[a][b][m][n] = (f32x4){0.f, 0.f, 0.f, 0.f};
        }
        cur = nxt; cA = nA; cB = nB; ++ui;
        if constexpr (ALIGN_EPI) { if (wr == 1) PG8_BAR; }
    }
    PG8_WAIT_V(0);
    if constexpr (!ALIGN_EPI) { if (wr == 0) PG8_BAR; }
    PG8_BAR;
#undef PG8_SA
#undef PG8_SB
#undef PG8_STAGE
#undef PG8_LDA
#undef PG8_LDB
#undef PG8_MMA
#undef PG8_WAIT_V
#undef PG8_WAIT_L
#undef PG8_BAR
#undef PG8_SCHED
}
}

struct EpiIn {
    static constexpr bool PERM = true;
    bf16_t* PA; bf16_t* PG; bf16_t* PL; const float* bmerge;
    __device__ __forceinline__ bool operator()(f32x4 (&acc)[2][2][4][2], const pg8::Unit& u, int wr, int wc, int fr, int fq) const {
        const int row0 = u.pm * 256 + wr * 64 + fr; const int colb = u.pn * 256 + wc * 32 + 8 * fq;
        if (u.pn < 32) {
            const float sc = (u.pn >= 16 && u.pn < 20) ? 0.125f : 1.0f;
#pragma unroll
            for (int ai = 0; ai < 2; ++ai)
#pragma unroll
                for (int m = 0; m < 4; ++m) { bf16_t* rowp = PA + (size_t)(row0 + ai * 128 + m * 16) * NPA + colb;
#pragma unroll
                    for (int bj = 0; bj < 2; ++bj) { const f32x4 v0 = acc[ai][bj][m][0] * sc, v1 = acc[ai][bj][m][1] * sc;
                        u32x4 w; w.x = pk2(v0[0], v0[1]); w.y = pk2(v0[2], v0[3]); w.z = pk2(v1[0], v1[1]); w.w = pk2(v1[2], v1[3]);
                        *(u32x4*)(rowp + bj * 128) = w; } }
        } else if (u.pn < 48) {
            const int j0 = (u.pn - 32) * 128 + wc * 32 + 8 * fq;
            f32x4 bv[2][2];
#pragma unroll
            for (int bj = 0; bj < 2; ++bj)
#pragma unroll
                for (int n = 0; n < 2; ++n) bv[bj][n] = *(const f32x4*)(bmerge + bj * 2048 + j0 + 4 * n);
#pragma unroll
            for (int ai = 0; ai < 2; ++ai)
#pragma unroll
                for (int m = 0; m < 4; ++m) { bf16_t* rowp = PG + (size_t)(row0 + ai * 128 + m * 16) * NPG + j0;
                    float rat[8], ga[8];
#pragma unroll
                    for (int n = 0; n < 2; ++n)
#pragma unroll
                        for (int e = 0; e < 4; ++e) { const float xr = acc[ai][0][m][n][e] + bv[0][n][e], xa = acc[ai][1][m][n][e] + bv[1][n][e];
                            const float dr = 1.0f + __expf(-xr), da = 1.0f + __expf(-xa);
                            ga[4 * n + e] = __builtin_amdgcn_rcpf(da); rat[4 * n + e] = da * __builtin_amdgcn_rcpf(dr); }
                    *(u32x4*)rowp = pack8(rat); *(u32x4*)(rowp + 2048) = pack8(ga); }
        } else {
            const int cl = colb - NPA - NPG;
#pragma unroll
            for (int ai = 0; ai < 2; ++ai)
#pragma unroll
                for (int m = 0; m < 4; ++m) { bf16_t* rowp = PL + (size_t)(u.kb >> 10) * ((size_t)M * NPL) + (size_t)(row0 + ai * 128 + m * 16) * NPL + cl;
#pragma unroll
                    for (int bj = 0; bj < 2; ++bj) { const f32x4 v0 = acc[ai][bj][m][0], v1 = acc[ai][bj][m][1];
                        u32x4 w; w.x = pk2(v0[0], v0[1]); w.y = pk2(v0[2], v0[3]); w.z = pk2(v1[0], v1[1]); w.w = pk2(v1[2], v1[3]);
                        *(u32x4*)(rowp + bj * 128) = w; } }
        }
        return true;
    }
};
struct EpiBranch {
    static constexpr bool PERM = true;
    const bf16_t* PG; bf16_t* MG;
    __device__ __forceinline__ bool operator()(f32x4 (&acc)[2][2][4][2], const pg8::Unit& u, int wr, int wc, int fr, int fq) const {
        const bool first = u.pm < 64;
        const int pm = first ? u.pm : u.pm - 64, pn = first ? u.pn : u.pn - 8;
        const int row0 = pm * 256 + wr * 64 + fr; const int colb = pn * 256 + wc * 32 + 8 * fq;
        const bf16_t* gbase = PG + (first ? 0 : 2048) + colb;
#pragma unroll
        for (int ai = 0; ai < 2; ++ai) {
            u32x4 g_[4][2];
#pragma unroll
            for (int m = 0; m < 4; ++m)
#pragma unroll
                for (int bj = 0; bj < 2; ++bj) g_[m][bj] = *(const u32x4*)(gbase + (size_t)(row0 + ai * 128 + m * 16) * NPG + bj * 128);
#pragma unroll
            for (int m = 0; m < 4; ++m) { const size_t row = (size_t)(row0 + ai * 128 + m * 16);
#pragma unroll
                for (int bj = 0; bj < 2; ++bj) { float g[8]; unpack8(g_[m][bj], g);
#pragma unroll
                    for (int e = 0; e < 4; ++e) { acc[ai][bj][m][0][e] *= g[e]; acc[ai][bj][m][1][e] *= g[4 + e]; }
                    if (!first) { const f32x4 v0 = acc[ai][bj][m][0], v1 = acc[ai][bj][m][1];
                        u32x4 w; w.x = pk2(v0[0], v0[1]); w.y = pk2(v0[2], v0[3]); w.z = pk2(v1[0], v1[1]); w.w = pk2(v1[2], v1[3]);
                        *(u32x4*)(MG + row * DM + colb + bj * 128) = w; } } }
            asm volatile("" ::: "memory");
        }
        return !first;
    }
};
struct EpiOut {
    static constexpr bool PERM = true;
    bf16_t* O; float* SSP;
    __device__ __forceinline__ bool operator()(f32x4 (&acc)[2][2][4][2], const pg8::Unit& u, int wr, int wc, int fr, int fq) const {
        const int row0 = u.pm * 256 + wr * 64 + fr; const int colb = u.pn * 256 + wc * 32 + 8 * fq;
#pragma unroll
        for (int ai = 0; ai < 2; ++ai)
#pragma unroll
            for (int m = 0; m < 4; ++m) { const size_t row = (size_t)(row0 + ai * 128 + m * 16); float ss = 0.f;
#pragma unroll
                for (int bj = 0; bj < 2; ++bj) { const f32x4 v0 = acc[ai][bj][m][0], v1 = acc[ai][bj][m][1];
                    ss += (v0[0] * v0[0] + v0[1] * v0[1]) + (v0[2] * v0[2] + v0[3] * v0[3]) + (v1[0] * v1[0] + v1[1] * v1[1]) + (v1[2] * v1[2] + v1[3] * v1[3]);
                    u32x4 w; w.x = pk2(v0[0], v0[1]); w.y = pk2(v0[2], v0[3]); w.z = pk2(v1[0], v1[1]); w.w = pk2(v1[2], v1[3]);
                    *(u32x4*)(O + row * DM + colb + bj * 128) = w; }
                ss += __shfl_xor(ss, 16); ss += __shfl_xor(ss, 32);
                if (fq == 0) SSP[row * 32 + u.pn * 4 + wc] = ss; }
        return true;
    }
};

#define XB_TMO      128
#define XB_XCNT(j)  (256  + 64 * (j))
#define XB_XSUB(j)  (1280 + 64 * (j))
#define XB_XGEN(j)  (2304 + 64 * (j))
#define XB_TOP      3328
#define XB_TOPGEN   3392
#define XCD_BAR_WORDS 3456
#define XB_SPIN_CAP (1u << 18)
__device__ __forceinline__ unsigned xb_ld(unsigned* p)              { return __hip_atomic_load(p, __ATOMIC_RELAXED, __HIP_MEMORY_SCOPE_AGENT); }
__device__ __forceinline__ unsigned xb_add(unsigned* p, unsigned v) { return __hip_atomic_fetch_add(p, v, __ATOMIC_RELAXED, __HIP_MEMORY_SCOPE_AGENT); }
__device__ __forceinline__ unsigned xb_xcc_id() { return (unsigned)__builtin_amdgcn_s_getreg((3 << 11) | 20) & 0xFu; }
#define XB_SPIN(cond, bar) do { unsigned _sp = 0; while (cond) { __builtin_amdgcn_s_sleep(1); \
    if ((++_sp & 255u) == 0u) { if (xb_ld(&(bar)[XB_TMO])) break; if (_sp > XB_SPIN_CAP) { atomicAdd(&(bar)[XB_TMO], 1u); break; } } } } while (0)
struct XcdBarrier { unsigned* bar; unsigned x; volatile LAS unsigned* st; };
__device__ __forceinline__ XcdBarrier xcd_barrier_post(unsigned* bar, volatile LAS unsigned* st) {
    XcdBarrier b; b.bar = bar; b.x = xb_xcc_id(); b.st = st;
    if (threadIdx.x == 0) (void)xb_add(&bar[XB_XCNT(b.x)], 1u);
    return b;
}
__device__ __forceinline__ void xcd_barrier_complete(unsigned* bar, unsigned x, unsigned& nloc, unsigned& nx) {
    const unsigned G = gridDim.x * gridDim.y * gridDim.z;
    unsigned sum, cnt, mine, sp = 0u;
    for (;;) {
        sum = 0u; cnt = 0u; mine = 0u;
#pragma unroll
        for (unsigned j = 0; j < 16; ++j) { const unsigned c = xb_ld(&bar[XB_XCNT(j)]); sum += c; cnt += (c > 0u) ? 1u : 0u; mine = (j == x) ? c : mine; }
        if (sum == G) break;
        __builtin_amdgcn_s_sleep(1);
        if ((++sp & 255u) == 0u) { if (xb_ld(&bar[XB_TMO])) break; if (sp > XB_SPIN_CAP) { atomicAdd(&bar[XB_TMO], 1u); break; } }
    }
    nloc = mine > 0u ? mine : 1u; nx = cnt > 0u ? cnt : 1u;
}
__device__ __forceinline__ void xcd_barrier(const XcdBarrier& b) {
    asm volatile("s_waitcnt vmcnt(0)" ::: "memory");
    __syncthreads();
    if (threadIdx.x == 0) {
        unsigned* bar = b.bar;
        __builtin_amdgcn_s_waitcnt(0);
        unsigned nloc = b.st[0], nx = b.st[1];
        if (nloc == 0u) { xcd_barrier_complete(bar, b.x, nloc, nx); b.st[0] = nloc; b.st[1] = nx; }
        const unsigned old = xb_add(&bar[XB_XSUB(b.x)], 1u);
        const unsigned gen = old / nloc;
        if (old + 1u == (gen + 1u) * nloc) {
            __builtin_amdgcn_fence(__ATOMIC_RELEASE, "agent");
            asm volatile("s_waitcnt vmcnt(0)" ::: "memory");
            const unsigned og = xb_add(&bar[XB_TOP], 1u);
            const unsigned tg = og / nx;
            if (og + 1u == (tg + 1u) * nx) xb_add(&bar[XB_TOPGEN], 1u);
            else XB_SPIN(xb_ld(&bar[XB_TOPGEN]) == tg, bar);
            __builtin_amdgcn_fence(__ATOMIC_ACQUIRE, "agent");
            xb_add(&bar[XB_XGEN(b.x)], 1u);
            asm volatile("s_waitcnt vmcnt(0)" ::: "memory");
        } else {
            XB_SPIN(xb_ld(&bar[XB_XGEN(b.x)]) == gen, bar);
            __builtin_amdgcn_fence(__ATOMIC_ACQUIRE, "agent");
            asm volatile("s_waitcnt vmcnt(0)" ::: "memory");
        }
    }
    __syncthreads();
}

struct Frame {
    LAS unsigned char* lds;
    int tid, lane, wave, G, bid;
    const float *x, *pre_g, *post_g, *w_in, *mu_rkv, *mu_wa, *w0, *w1, *w2, *a0, *a1, *a2, *k_k, *k_a, *r_k, *lnx_g, *lnx_b, *rel_bias, *w_br, *w_ba, *b_merge, *w_out;
    float* out;
    bf16_t *HB, *WIN_T, *WCAT_T, *WOUT_T, *W2T, *A2T, *PA, *PG, *PL, *YCAT, *MERGED, *STATES;
    float *BONUS, *SSP;
    bf16_t* OBF; bf16_t *MD, *ND, *QD; unsigned* queue;
};

__device__ __forceinline__ float wave_sum(float v) {
#pragma unroll
    for (int o = 1; o < 64; o <<= 1) v += __shfl_xor(v, o);
    return v;
}

__device__ __forceinline__ void p0_transpose_item(const float* W, int K, int N, bf16_t* WT, int row_off, LAS float* scr, int item, int lane, const float* mu, float s0, float s1, bool gate_remap = false) {
    const int nblk = N / 32, kb = item / nblk, nb = item % nblk, k0 = 64 * kb, n0 = 32 * nb;
    int d0 = n0; if (gate_remap && n0 >= NPA) { const int g = n0 - NPA, br = g >> 11, j0 = g & 2047; d0 = NPA + 256 * (j0 >> 7) + 128 * br + (j0 & 127); }
    f32x4 v4[8];
#pragma unroll
    for (int i = 0; i < 8; ++i) { const int kk = 8 * i + (lane >> 3); v4[i] = *(const f32x4*)(W + (size_t)(k0 + kk) * N + n0 + (lane & 7) * 4); }
#pragma unroll
    for (int i = 0; i < 8; ++i) { const int kk = 8 * i + (lane >> 3); f32x4 v = v4[i]; if (mu) v = v * (s0 + s1 * mu[k0 + kk]);
        LAS float* d = scr + kk * 33 + (lane & 7) * 4; d[0] = v[0]; d[1] = v[1]; d[2] = v[2]; d[3] = v[3]; }
    LDS_WAIT(); asm volatile("" ::: "memory");
    const int c = lane & 7;
#pragma unroll
    for (int j = 0; j < 4; ++j) { const int n = (lane >> 3) + 8 * j; const LAS float* s = scr + (8 * c) * 33 + n;
        u32x4 o; o.x = pk2(s[0 * 33], s[1 * 33]); o.y = pk2(s[2 * 33], s[3 * 33]); o.z = pk2(s[4 * 33], s[5 * 33]); o.w = pk2(s[6 * 33], s[7 * 33]);
        *(u32x4*)(WT + (size_t)(row_off + d0 + n) * K + k0 + 8 * c) = o; }
    LDS_WAIT(); asm volatile("" ::: "memory");
}
__device__ __forceinline__ void p0_prologue(Frame& F) {
    LAS float* scr = (LAS float*)(F.lds + F.wave * 16384);
    const int gw = F.bid * NWAVES + F.wave, NGW = F.G * NWAVES;
    constexpr int I_IN = (DM / 64) * (NPA + NPG) / 32, I_L = (DM / 64) * (64 / 32), I_BR = (DBR / 64) * (DM / 32), I_OUT = (DM / 64) * (DM / 32), I_W2 = (64 / 64) * (DBR / 32);
    constexpr int NITEMS = I_IN + 4 * I_L + 2 * I_BR + I_OUT + 2 * I_W2;
    for (int it = gw; it < NITEMS; it += NGW) {
        int r = it;
        if (r < I_IN) { p0_transpose_item(F.w_in, DM, NPA + NPG, F.WIN_T, 0, scr, r, F.lane, nullptr, 1.f, 0.f, true); continue; } r -= I_IN;
        if (r < I_L) { p0_transpose_item(F.w1, DM, 64, F.WIN_T, NPA + NPG + 0, scr, r, F.lane, F.mu_wa, 1.f, -1.f); continue; } r -= I_L;
        if (r < I_L) { p0_transpose_item(F.w1, DM, 64, F.WIN_T, NPA + NPG + 64, scr, r, F.lane, F.mu_wa, 0.f, 1.f); continue; } r -= I_L;
        if (r < I_L) { p0_transpose_item(F.a1, DM, 64, F.WIN_T, NPA + NPG + 128, scr, r, F.lane, F.mu_wa + DM, 1.f, -1.f); continue; } r -= I_L;
        if (r < I_L) { p0_transpose_item(F.a1, DM, 64, F.WIN_T, NPA + NPG + 192, scr, r, F.lane, F.mu_wa + DM, 0.f, 1.f); continue; } r -= I_L;
        if (r < I_BR) { p0_transpose_item(F.w_br, DBR, DM, F.WCAT_T, 0, scr, r, F.lane, nullptr, 1.f, 0.f); continue; } r -= I_BR;
        if (r < I_BR) { p0_transpose_item(F.w_ba, DBR, DM, F.WCAT_T, DM, scr, r, F.lane, nullptr, 1.f, 0.f); continue; } r -= I_BR;
        if (r < I_OUT) { p0_transpose_item(F.w_out, DM, DM, F.WOUT_T, 0, scr, r, F.lane, nullptr, 1.f, 0.f); continue; } r -= I_OUT;
        if (r < I_W2) { p0_transpose_item(F.w2, 64, DBR, F.W2T, 0, scr, r, F.lane, nullptr, 1.f, 0.f); continue; } r -= I_W2;
        p0_transpose_item(F.a2, 64, DBR, F.A2T, 0, scr, r, F.lane, nullptr, 1.f, 0.f);
    }
    for (int m = gw; m < M; m += 2 * NGW) {
        const int m2 = (m + NGW < M) ? m + NGW : m;
        const f32x4* xr = (const f32x4*)(F.x + (size_t)m * DM) + F.lane; const f32x4* xr2 = (const f32x4*)(F.x + (size_t)m2 * DM) + F.lane; const f32x4* gr = (const f32x4*)F.pre_g + F.lane;
        f32x4 v[8], w[8]; float s = 0.f, s2 = 0.f;
#pragma unroll
        for (int j = 0; j < 8; ++j) { v[j] = xr[64 * j]; w[j] = xr2[64 * j]; }
#pragma unroll
        for (int j = 0; j < 8; ++j) { s += (v[j].x * v[j].x + v[j].y * v[j].y) + (v[j].z * v[j].z + v[j].w * v[j].w); s2 += (w[j].x * w[j].x + w[j].y * w[j].y) + (w[j].z * w[j].z + w[j].w * w[j].w); }
        const float rstd = 1.0f / sqrtf(wave_sum(s) * (1.f / DM) + NORM_EPS), rstd2 = 1.0f / sqrtf(wave_sum(s2) * (1.f / DM) + NORM_EPS);
        u32x2* o8 = (u32x2*)(F.HB + (size_t)m * DM) + F.lane; u32x2* o82 = (u32x2*)(F.HB + (size_t)m2 * DM) + F.lane;
#pragma unroll
        for (int j = 0; j < 8; ++j) { const f32x4 g = gr[64 * j]; u32x2 a; a.x = pk2(v[j].x * rstd * g.x, v[j].y * rstd * g.y); a.y = pk2(v[j].z * rstd * g.z, v[j].w * rstd * g.w); o8[64 * j] = a;
            u32x2 c; c.x = pk2(w[j].x * rstd2 * g.x, w[j].y * rstd2 * g.y); c.y = pk2(w[j].z * rstd2 * g.z, w[j].w * rstd2 * g.w); o82[64 * j] = c; }
    }
}

constexpr int LSTR = 72;
constexpr int SLOT = 64 * LSTR * 2;
__device__ __forceinline__ f32x4 mm16(const LAS bf16_t* A, int m0, const LAS bf16_t* Bt, int n0, f32x4 acc, int fr, int fq) {
#pragma unroll
    for (int ks = 0; ks < 2; ++ks) {
        const bf16x8 a = *(const LAS bf16x8*)(A + (m0 + fr) * LSTR + ks * 32 + fq * 8);
        const bf16x8 b = *(const LAS bf16x8*)(Bt + (n0 + fr) * LSTR + ks * 32 + fq * 8);
        acc = __builtin_amdgcn_mfma_f32_16x16x32_bf16(a, b, acc, 0, 0, 0);
    }
    return acc;
}

typedef short v4i16_t __attribute__((ext_vector_type(4)));
__device__ __forceinline__ s16x4 tr4(const LAS bf16_t* p) { return __builtin_bit_cast(s16x4, __builtin_amdgcn_ds_read_tr16_b64_v4i16((LAS v4i16_t*)p)); }
__device__ __forceinline__ s16x4 frag_tr16(const LAS bf16_t* X, int k0, int n0, int lane) {
    const int g = lane >> 4, q = (lane & 15) >> 2, p = lane & 3;
    return tr4(X + (k0 + 4 * g + q) * LSTR + n0 + 4 * p);
}
__device__ __forceinline__ bf16x8 frag_tr32(const LAS bf16_t* X, int k0, int n0, int lane) {
    const int g = lane >> 4, q = (lane & 15) >> 2, p = lane & 3;
    const s16x4 lo = tr4(X + (k0 + 8 * g + q) * LSTR + n0 + 4 * p), hi = tr4(X + (k0 + 8 * g + 4 + q) * LSTR + n0 + 4 * p);
    return (bf16x8){lo[0], lo[1], lo[2], lo[3], hi[0], hi[1], hi[2], hi[3]};
}

constexpr int P2_GRP_BYTES = 6 * SLOT + 20 * 64 * 16;
struct KVRegs { u32x4 k0, k1, v0, v1; };
__device__ __forceinline__ void kv_load(KVRegs& R, const bf16_t* p, int key0, int d80, int key1, int d81) {
    R.k0 = *(const u32x4*)(p + (size_t)key0 * NPA + PA_KA + d80); R.k1 = *(const u32x4*)(p + (size_t)key1 * NPA + PA_KA + d81);
    R.v0 = *(const u32x4*)(p + (size_t)key0 * NPA + PA_VA + d80); R.v1 = *(const u32x4*)(p + (size_t)key1 * NPA + PA_VA + d81);
}
__device__ __forceinline__ void kv_store(const KVRegs& R, LAS unsigned char* kvb, int key0, int d80, int key1, int d81) {
    LAS bf16_t* Ks = (LAS bf16_t*)kvb; LAS bf16_t* Vs = (LAS bf16_t*)(kvb + SLOT);
    *(LAS u32x4*)(Ks + key0 * LSTR + d80) = R.k0; *(LAS u32x4*)(Ks + key1 * LSTR + d81) = R.k1; *(LAS u32x4*)(Vs + key0 * LSTR + d80) = R.v0; *(LAS u32x4*)(Vs + key1 * LSTR + d81) = R.v1;
}
constexpr int P2_CPI = 2, P2_NITEMS = BATCH * (NH / 2) * (NCHUNK / P2_CPI);
__device__ __forceinline__ void p2_advance(int cr, int& ci, int& j) { if (j == 8) { ++ci; const int nc = cr * P2_CPI + ci; j = (nc >= 8) ? 0 : 8 - nc; } else ++j; }
__device__ __forceinline__ void p2_attention(Frame& F) {
    const int tid = F.tid, lane = F.lane, wave = F.wave, fr = lane & 15, fq = lane >> 4;
    const int grp = wave >> 2, wq = wave & 3, tg = tid & 255;
    LAS unsigned char* gbase = F.lds + grp * P2_GRP_BYTES;
    LAS f32x4* Tb = (LAS f32x4*)(gbase + 6 * SLOT);
    const int key0 = (tg * 2) >> 3, d80 = ((tg * 2) & 7) * 8, key1 = (tg * 2 + 1) >> 3, d81 = ((tg * 2 + 1) & 7) * 8;
    const float L2E = 1.4426950408889634f;
    volatile LAS int* qslot = (volatile LAS int*)(F.lds + MISC_OFF + 64);
    int hp_prev = -1;
    for (;;) {
        __syncthreads();
        if (tid == 0) *qslot = (int)__hip_atomic_fetch_add(F.queue, 1u, __ATOMIC_RELAXED, __HIP_MEMORY_SCOPE_AGENT);
        __syncthreads();
        const int vb = *qslot;
        if (vb >= P2_NITEMS) break;
        constexpr int NR = NCHUNK / P2_CPI; const int b = vb / (NR * 8), hp = (vb / NR) & 7, cr = vb % NR, h = hp * 2 + grp;
        if (hp != hp_prev) for (int e = tg; e < 20 * 64; e += 256) { const int u = e / 64 - 3, ln = e & 63, lfr = ln & 15, lfq = ln >> 4; f32x4 t4;
#pragma unroll
            for (int r = 0; r < 4; ++r) { int rel = 16 * u + (lfr - 4 * lfq - r); rel = rel < -256 ? -256 : (rel > 256 ? 256 : rel); t4[r] = F.rel_bias[h * 513 + rel + 256]; }
            Tb[e] = t4; }
        hp_prev = hp;
        const float bcst = F.rel_bias[h * 513 + 512];
        const bf16_t* kvbase = F.PA + (size_t)b * SEQ * NPA + h * 64;
        int ci = 0, j = (cr * P2_CPI >= 8) ? 0 : 8 - cr * P2_CPI;
        int lci = ci, lj = j;
        KVRegs RA, RB;
        kv_load(RA, kvbase + (size_t)(cr * P2_CPI + lci - 8 + lj) * 64 * NPA, key0, d80, key1, d81); p2_advance(cr, lci, lj);
        kv_store(RA, gbase, key0, d80, key1, d81);
        kv_load(RA, kvbase + (size_t)(cr * P2_CPI + lci - 8 + lj) * 64 * NPA, key0, d80, key1, d81); p2_advance(cr, lci, lj);
        __syncthreads();
        size_t mrow0 = (size_t)b * SEQ + (size_t)(cr * P2_CPI) * 64;
        bf16x8 qa[2];
#pragma unroll
        for (int ks = 0; ks < 2; ++ks) qa[ks] = *(const bf16x8*)(F.PA + (mrow0 + 16 * wq + fr) * NPA + PA_Q + h * 64 + ks * 32 + fq * 8);
        float mrun = -1e30f, lsum = 0.f; f32x4 o[4];
#pragma unroll
        for (int dt = 0; dt < 4; ++dt) o[dt] = (f32x4){0.f, 0.f, 0.f, 0.f};
        int bufc = 0;
#define P2_STEP(RW, RL) { \
            const bool more1 = (ci < P2_CPI - 1) || (j < 8);                           \
            const bool more2 = lci < P2_CPI;                                           \
            if (more2) { kv_load(RL, kvbase + (size_t)(cr * P2_CPI + lci - 8 + lj) * 64 * NPA, key0, d80, key1, d81); p2_advance(cr, lci, lj); } \
            const LAS bf16_t* Ks = (const LAS bf16_t*)(gbase + bufc * 2 * SLOT); const LAS bf16_t* Vs = (const LAS bf16_t*)(gbase + bufc * 2 * SLOT + SLOT); \
            f32x4 s[4]; \
            _Pragma("unroll") for (int nt = 0; nt < 4; ++nt) { const int u = wq - nt + 4 * (8 - j); \
                s[nt] = (u >= 17) ? (f32x4){bcst, bcst, bcst, bcst} : Tb[(u + 3) * 64 + lane]; \
                _Pragma("unroll") for (int ks = 0; ks < 2; ++ks) { const bf16x8 kb = *(const LAS bf16x8*)(Ks + (16 * nt + fr) * LSTR + ks * 32 + fq * 8); \
                    s[nt] = __builtin_amdgcn_mfma_f32_16x16x32_bf16(kb, qa[ks], s[nt], 0, 0, 0); } } \
            float rmax = fmaxf(fmaxf(s[0][0], s[0][1]), fmaxf(s[0][2], s[0][3])); \
            _Pragma("unroll") for (int nt = 1; nt < 4; ++nt) rmax = fmaxf(rmax, fmaxf(fmaxf(s[nt][0], s[nt][1]), fmaxf(s[nt][2], s[nt][3]))); \
            rmax = fmaxf(rmax, __shfl_xor(rmax, 16)); rmax = fmaxf(rmax, __shfl_xor(rmax, 32)); \
            const float mn = fmaxf(mrun, rmax); const float alpha = __builtin_amdgcn_exp2f((mrun - mn) * L2E); mrun = mn; \
            const float mnl = mn * L2E; float ps = 0.f; \
            _Pragma("unroll") for (int nt = 0; nt < 4; ++nt) _Pragma("unroll") for (int r = 0; r < 4; ++r) { s[nt][r] = __builtin_amdgcn_exp2f(fmaf(s[nt][r], L2E, -mnl)); ps += s[nt][r]; } \
            lsum = lsum * alpha + ps; \
            _Pragma("unroll") for (int dt = 0; dt < 4; ++dt) o[dt] = o[dt] * alpha; \
            bf16x8 pb[2]; \
            _Pragma("unroll") for (int ks = 0; ks < 2; ++ks) { u32x4 w; w.x = pk2(s[2 * ks][0], s[2 * ks][1]); w.y = pk2(s[2 * ks][2], s[2 * ks][3]); w.z = pk2(s[2 * ks + 1][0], s[2 * ks + 1][1]); w.w = pk2(s[2 * ks + 1][2], s[2 * ks + 1][3]); pb[ks] = __builtin_bit_cast(bf16x8, w); } \
            _Pragma("unroll") for (int dt = 0; dt < 4; ++dt) _Pragma("unroll") for (int ks = 0; ks < 2; ++ks) { const s16x4 v0 = frag_tr16(Vs, 32 * ks, 16 * dt, lane), v1 = frag_tr16(Vs, 32 * ks + 16, 16 * dt, lane); \
                    const bf16x8 va = (bf16x8){v0[0], v0[1], v0[2], v0[3], v1[0], v1[1], v1[2], v1[3]}; \
                    o[dt] = __builtin_amdgcn_mfma_f32_16x16x32_bf16(va, pb[ks], o[dt], 0, 0, 0); } \
            if (j == 8) { \
                float l = lsum; l += __shfl_xor(l, 16); l += __shfl_xor(l, 32); \
                const float inv = 1.0f / l; const size_t m = mrow0 + 16 * wq + fr; \
                _Pragma("unroll") for (int dt = 0; dt < 4; ++dt) { const int col = h * 64 + 16 * dt + 4 * fq; \
                    const u32x2 zw = *(const u32x2*)(F.PA + m * NPA + PA_ZA + col); \
                    const float z0 = bflo(zw.x), z1 = bfhi(zw.x), z2 = bflo(zw.y), z3 = bfhi(zw.y); \
                    u32x2 yw; yw.x = pk2(o[dt][0] * inv * z0 * sigmoidf_(z0), o[dt][1] * inv * z1 * sigmoidf_(z1)); yw.y = pk2(o[dt][2] * inv * z2 * sigmoidf_(z2), o[dt][3] * inv * z3 * sigmoidf_(z3)); \
                    *(u32x2*)(F.YCAT + ((size_t)M + m) * DBR + col) = yw; } \
                if (more1) { \
                    mrow0 = (size_t)b * SEQ + (size_t)(cr * P2_CPI + ci + 1) * 64; \
                    _Pragma("unroll") for (int ks = 0; ks < 2; ++ks) qa[ks] = *(const bf16x8*)(F.PA + (mrow0 + 16 * wq + fr) * NPA + PA_Q + h * 64 + ks * 32 + fq * 8); \
                    mrun = -1e30f; lsum = 0.f; \
                    _Pragma("unroll") for (int dt = 0; dt < 4; ++dt) o[dt] = (f32x4){0.f, 0.f, 0.f, 0.f}; \
                } \
            } \
            const int bufn = (bufc == 2) ? 0 : bufc + 1; \
            if (more1) kv_store(RW, gbase + bufn * 2 * SLOT, key0, d80, key1, d81); \
            __syncthreads(); \
            if (!more1) break; \
            p2_advance(cr, ci, j); bufc = bufn; }
        for (;;) {
            P2_STEP(RA, RB)
            P2_STEP(RB, RA)
        }
#undef P2_STEP
    }
}

constexpr int FSTR = 68;
constexpr int DSTR = 24;
__device__ __forceinline__ f32x4 mfma16(s16x4 a, s16x4 b, f32x4 c) {
    const bf16x8 a8 = (bf16x8){a[0], a[1], a[2], a[3], 0, 0, 0, 0}, b8 = (bf16x8){b[0], b[1], b[2], b[3], 0, 0, 0, 0};
    return __builtin_amdgcn_mfma_f32_16x16x32_bf16(a8, b8, c, 0, 0, 0); }
__device__ __forceinline__ s16x4 cvt_hi(const f32x4 v) { u32x2 w; w.x = pk2(v[0], v[1]); w.y = pk2(v[2], v[3]); return __builtin_bit_cast(s16x4, w); }
__device__ __forceinline__ s16x4 cvt_lo(const f32x4 v, const s16x4 hi) { const u32x2 h = __builtin_bit_cast(u32x2, hi);
    u32x2 w; w.x = pk2(v[0] - bflo(h.x), v[1] - bfhi(h.x)); w.y = pk2(v[2] - bflo(h.y), v[3] - bfhi(h.y)); return __builtin_bit_cast(s16x4, w); }
struct P3Loads { u32x4 w2, a2, pr, pk, pv, qr, qk, qv; f32x4 mur[2], muk[2], muv[2], kkp[2], kap[2], rkp[2]; };
__device__ __forceinline__ void p3_load(Frame& F, P3Loads& G, int h, size_t m, int t_e, int c8, bool hasprev) {
    const u32x4 zero4 = (u32x4){0u, 0u, 0u, 0u};
    G.w2 = *(const u32x4*)(F.W2T + (size_t)(h * 64 + t_e) * 64 + c8); G.a2 = *(const u32x4*)(F.A2T + (size_t)(h * 64 + t_e) * 64 + c8);
    const bf16_t* rowp = F.PA + m * NPA + h * 64 + c8;
    G.pr = *(const u32x4*)(rowp + PA_R); G.pk = *(const u32x4*)(rowp + PA_K); G.pv = *(const u32x4*)(rowp + PA_V);
    G.qr = hasprev ? *(const u32x4*)(rowp - NPA + PA_R) : zero4; G.qk = hasprev ? *(const u32x4*)(rowp - NPA + PA_K) : zero4; G.qv = hasprev ? *(const u32x4*)(rowp - NPA + PA_V) : zero4;
    const int ch0 = h * 64 + c8;
#pragma unroll
    for (int q = 0; q < 2; ++q) { G.mur[q] = *(const f32x4*)(F.mu_rkv + ch0 + 4 * q); G.muk[q] = *(const f32x4*)(F.mu_rkv + DBR + ch0 + 4 * q); G.muv[q] = *(const f32x4*)(F.mu_rkv + 2 * DBR + ch0 + 4 * q);
        G.kkp[q] = *(const f32x4*)(F.k_k + ch0 + 4 * q); G.kap[q] = *(const f32x4*)(F.k_a + ch0 + 4 * q); G.rkp[q] = *(const f32x4*)(F.r_k + ch0 + 4 * q); }
}
__device__ __forceinline__ void p3_prep(Frame& F) {
    const int wave = F.wave;
    LAS unsigned char* L = F.lds;
    LAS bf16_t* X_A = (LAS bf16_t*)(L + 0 * SLOT);
    LAS bf16_t* X_B = (LAS bf16_t*)(L + 1 * SLOT);
    LAS bf16_t* X_K = (LAS bf16_t*)(L + 2 * SLOT);
    LAS bf16_t* X_R = (LAS bf16_t*)(L + 3 * SLOT);
    LAS bf16_t* X_V = (LAS bf16_t*)(L + 4 * SLOT);
    LAS bf16_t* S_TW = (LAS bf16_t*)(L + 5 * SLOT);
    LAS bf16_t* S_TA = (LAS bf16_t*)(L + 6 * SLOT);
    LAS bf16_t* A_AB = (LAS bf16_t*)(L + 7 * SLOT);
    LAS bf16_t* A_AK = (LAS bf16_t*)(L + 8 * SLOT);
    LAS bf16_t* A_RB = (LAS bf16_t*)(L + 9 * SLOT);
    LAS bf16_t* A_RK = (LAS bf16_t*)(L + 10 * SLOT);
    LAS bf16_t* DB = (LAS bf16_t*)(L + 11 * SLOT);
    LAS float* CLf = (LAS float*)(L + 12 * SLOT);
    LAS float* Af = CLf + 64 * FSTR;
    LAS float* GL = Af + 64 * FSTR;
    LAS bf16_t* ST_Q = A_AK; LAS bf16_t* ST_Y = X_A; LAS bf16_t* ST_M = X_V; LAS bf16_t* ST_N = (LAS bf16_t*)CLf;
    const int mt = wave >> 1, ntb = (wave & 1) * 2;
    for (int vb = F.bid; vb < 256; vb += F.G) {
        const int b = vb >> 7, c = vb & 127; const size_t mrow0 = (size_t)b * SEQ + (size_t)c * 64;
        {
            const int t_e = F.tid >> 3, c8 = (F.tid & 7) * 8; const size_t m = mrow0 + t_e; const bool hasprev = (c > 0) || (t_e > 0);
            const u32x4 zero4 = (u32x4){0u, 0u, 0u, 0u};
            float sw[8], sa[8];
#pragma unroll
            for (int e = 0; e < 8; ++e) { sw[e] = 0.f; sa[e] = 0.f; }
#pragma unroll
            for (int q = 0; q < 4; ++q) { const bf16_t* slab = F.PL + (size_t)q * ((size_t)M * NPL);
                const u32x4 g_law = *(const u32x4*)(slab + m * NPL + 0 + c8), g_laa = *(const u32x4*)(slab + m * NPL + 128 + c8);
                const u32x4 g_lbw = hasprev ? *(const u32x4*)(slab + (m - 1) * NPL + 64 + c8) : zero4, g_lba = hasprev ? *(const u32x4*)(slab + (m - 1) * NPL + 192 + c8) : zero4;
                float law[8], laa[8], lbw[8], lba[8];
                unpack8(g_law, law); unpack8(g_laa, laa); unpack8(g_lbw, lbw); unpack8(g_lba, lba);
#pragma unroll
                for (int e = 0; e < 8; ++e) { sw[e] += law[e] + lbw[e]; sa[e] += laa[e] + lba[e]; } }
            float tw[8], ta[8];
#pragma unroll
            for (int e = 0; e < 8; ++e) { tw[e] = tanhf_(sw[e]); ta[e] = sa[e]; }
            __syncthreads();
            *(LAS u32x4*)(S_TW + t_e * LSTR + c8) = pack8(tw); *(LAS u32x4*)(S_TA + t_e * LSTR + c8) = pack8(ta);
        }
        P3Loads G; p3_load(F, G, 0, mrow0 + (F.tid >> 3), F.tid >> 3, (F.tid & 7) * 8, (c > 0) || ((F.tid >> 3) > 0));
        for (int h = 0; h < NH; ++h) {
            int tid = F.tid; asm volatile("" : "+v"(tid));
            const int lane = tid & 63, fr = lane & 15, fq = lane >> 4;
            const int t_e = tid >> 3, c8 = (tid & 7) * 8;
            const size_t m = mrow0 + t_e; const bool hasprev = (c > 0) || (t_e > 0);
            const u32x4 g_w2 = G.w2, g_a2 = G.a2, g_pr = G.pr, g_pk = G.pk, g_pv = G.pv, g_qr = G.qr, g_qk = G.qk, g_qv = G.qv;
            float mur[8], muk[8], muv[8], kkp[8], kap[8], rkp[8];
#pragma unroll
            for (int e = 0; e < 8; ++e) { mur[e] = G.mur[e >> 2][e & 3]; muk[e] = G.muk[e >> 2][e & 3]; muv[e] = G.muv[e >> 2][e & 3]; kkp[e] = G.kkp[e >> 2][e & 3]; kap[e] = G.kap[e >> 2][e & 3]; rkp[e] = G.rkp[e >> 2][e & 3]; }
            __syncthreads();
            *(LAS u32x4*)(A_AB + t_e * LSTR + c8) = g_w2; *(LAS u32x4*)(A_AK + t_e * LSTR + c8) = g_a2;
            __syncthreads();
#pragma unroll
            for (int q = 0; q < 2; ++q) { const int nt = ntb + q; const int ch = 16 * nt + fr;
                f32x4 dw = (f32x4){0.f, 0.f, 0.f, 0.f}, da = (f32x4){0.f, 0.f, 0.f, 0.f};
#pragma unroll
                for (int ks = 0; ks < 2; ++ks) {
                    const bf16x8 aw = *(const LAS bf16x8*)(S_TW + (16 * mt + fr) * LSTR + ks * 32 + fq * 8), aa = *(const LAS bf16x8*)(S_TA + (16 * mt + fr) * LSTR + ks * 32 + fq * 8);
                    const bf16x8 bw = *(const LAS bf16x8*)(A_AB + ch * LSTR + ks * 32 + fq * 8), ba = *(const LAS bf16x8*)(A_AK + ch * LSTR + ks * 32 + fq * 8);
                    dw = __builtin_amdgcn_mfma_f32_16x16x32_bf16(aw, bw, dw, 0, 0, 0); da = __builtin_amdgcn_mfma_f32_16x16x32_bf16(aa, ba, da, 0, 0, 0); }
                const float w0v = F.w0[h * 64 + ch], a0v = F.a0[h * 64 + ch];
#pragma unroll
                for (int r = 0; r < 4; ++r) { const int t = 16 * mt + 4 * fq + r;
                    CLf[t * FSTR + ch] = -DECAY_SCALE * sigmoidf_(w0v + dw[r]); Af[t * FSTR + ch] = sigmoidf_(a0v + da[r]); } }
            __syncthreads();
#pragma unroll
            for (int q = 0; q < 8; ++q) { const int ch = wave * 8 + q; float xv = CLf[lane * FSTR + ch];
#pragma unroll
                for (int off = 1; off < 64; off <<= 1) { const float y = __shfl_up(xv, off); if (lane >= off) xv += y; }
                CLf[lane * FSTR + ch] = xv; }
            __syncthreads();
            {
                float pr[8], pk[8], pv[8], qr[8], qk[8], qv[8];
                unpack8(g_pr, pr); unpack8(g_pk, pk); unpack8(g_pv, pv); unpack8(g_qr, qr); unpack8(g_qk, qk); unpack8(g_qv, qv);
                float rr[8], kk[8], vv[8], kn[8], av[8], cl[8], clp[8]; float nrm = 0.f;
#pragma unroll
                for (int e = 0; e < 8; ++e) {
                    rr[e] = pr[e] + (qr[e] - pr[e]) * mur[e]; kk[e] = pk[e] + (qk[e] - pk[e]) * muk[e]; vv[e] = pv[e] + (qv[e] - pv[e]) * muv[e];
                    kn[e] = kk[e] * kkp[e]; nrm += kn[e] * kn[e];
                    av[e] = Af[t_e * FSTR + c8 + e]; cl[e] = CLf[t_e * FSTR + c8 + e]; clp[e] = (t_e > 0) ? CLf[(t_e - 1) * FSTR + c8 + e] : 0.f; }
                nrm += __shfl_xor(nrm, 1); nrm += __shfl_xor(nrm, 2); nrm += __shfl_xor(nrm, 4);
                const float inrm = 1.0f / fmaxf(sqrtf(nrm), 1e-12f);
                float at_[8], bt_[8], kt_[8], rt_[8]; float bon = 0.f;
#pragma unroll
                for (int e = 0; e < 8; ++e) {
                    const float kkn = kn[e] * inrm; const float kmod = kk[e] * (1.0f + (av[e] - 1.0f) * kap[e]);
                    const float gin = __expf(cl[e]), gex = __expf(clp[e]), ginv = __expf(-cl[e]);
                    at_[e] = -kkn * gex; bt_[e] = kkn * av[e] * ginv; kt_[e] = kmod * ginv; rt_[e] = rr[e] * gin;
                    bon += rr[e] * kmod * rkp[e]; }
                bon += __shfl_xor(bon, 1); bon += __shfl_xor(bon, 2); bon += __shfl_xor(bon, 4);
                if ((tid & 7) == 0) F.BONUS[m * NH + h] = bon;
                if (t_e == 63) {
#pragma unroll
                    for (int e = 0; e < 8; ++e) GL[c8 + e] = __expf(cl[e]); }
                *(LAS u32x4*)(X_A + t_e * LSTR + c8) = pack8(at_); *(LAS u32x4*)(X_B + t_e * LSTR + c8) = pack8(bt_);
                *(LAS u32x4*)(X_K + t_e * LSTR + c8) = pack8(kt_); *(LAS u32x4*)(X_R + t_e * LSTR + c8) = pack8(rt_);
                *(LAS u32x4*)(X_V + t_e * LSTR + c8) = pack8(vv);
            }
            __syncthreads();
            if (h + 1 < NH) p3_load(F, G, h + 1, m, t_e, c8, hasprev);
#pragma unroll
            for (int q = 0; q < 2; ++q) { const int it = mt, tt = ntb + q; const int t = 16 * tt + fr, i0 = 16 * it + 4 * fq;
                const f32x4 z4 = (f32x4){0.f, 0.f, 0.f, 0.f};
                const f32x4 d_ab = mm16(X_B, 16 * it, X_A, 16 * tt, z4, fr, fq), d_ak = mm16(X_K, 16 * it, X_A, 16 * tt, z4, fr, fq);
                const f32x4 d_rb = mm16(X_B, 16 * it, X_R, 16 * tt, z4, fr, fq), d_rk = mm16(X_K, 16 * it, X_R, 16 * tt, z4, fr, fq);
                f32x4 e_ab, e_ak, e_rb, e_rk;
#pragma unroll
                for (int r = 0; r < 4; ++r) { const int i = i0 + r; e_ab[r] = (i < t) ? d_ab[r] : 0.f; e_ak[r] = (i < t) ? d_ak[r] : 0.f; e_rb[r] = (i <= t) ? d_rb[r] : 0.f; e_rk[r] = (i <= t) ? d_rk[r] : 0.f; }
                *(LAS s16x4*)(A_AB + t * LSTR + i0) = cvt_hi(e_ab); *(LAS s16x4*)(A_AK + t * LSTR + i0) = cvt_hi(e_ak);
                *(LAS s16x4*)(A_RB + t * LSTR + i0) = cvt_hi(e_rb); *(LAS s16x4*)(A_RK + t * LSTR + i0) = cvt_hi(e_rk); }
            __syncthreads();
            f32x4 rhs[4]; bf16x8 vf[2];
            const int ct = wave & 3;
            if (wave < 4) {
                const s16x4 a_t = *(const LAS s16x4*)(A_AB + (16 * wave + fr) * LSTR + 16 * wave + 4 * fq);
                const s16x4 a_c = frag_tr16(A_AB, 16 * wave, 16 * wave, lane);
                const f32x4 z4 = (f32x4){0.f, 0.f, 0.f, 0.f};
                f32x4 iden;
#pragma unroll
                for (int r = 0; r < 4; ++r) iden[r] = (4 * fq + r == fr) ? 1.0f : 0.0f;
                const u32x2 atw = __builtin_bit_cast(u32x2, a_t), acw = __builtin_bit_cast(u32x2, a_c);
                f32x4 Sc = iden + (f32x4){bflo(acw.x), bfhi(acw.x), bflo(acw.y), bfhi(acw.y)}, St = iden + (f32x4){bflo(atw.x), bfhi(atw.x), bflo(atw.y), bfhi(atw.y)};
                f32x4 Pc = mfma16(a_t, a_c, z4), Pt = mfma16(a_c, a_t, z4);
#pragma unroll
                for (int lvl = 0; lvl < 3; ++lvl) {
                    const s16x4 pt = cvt_hi(Pt), pc = cvt_hi(Pc);
                    const s16x4 sh = cvt_hi(Sc), sl = cvt_lo(Sc, sh);
                    const f32x4 Sc2 = mfma16(pt, sl, mfma16(pt, sh, Sc)), St2 = mfma16(sl, pt, mfma16(sh, pt, St));
                    Sc = Sc2; St = St2;
                    if (lvl < 2) { const f32x4 Pc2 = mfma16(pt, pc, z4), Pt2 = mfma16(pc, pt, z4); Pc = Pc2; Pt = Pt2; }
                }
                *(LAS s16x4*)(DB + (16 * wave + fr) * DSTR + 4 * fq) = cvt_hi(St);
#pragma unroll
                for (int bi = 0; bi < 4; ++bi)
#pragma unroll
                    for (int r = 0; r < 4; ++r) rhs[bi][r] = bf2f(X_A[(16 * bi + 4 * fq + r) * LSTR + 16 * ct + fr]);
                vf[0] = (bf16x8){0, 0, 0, 0, 0, 0, 0, 0}; vf[1] = vf[0];
            } else {
#pragma unroll
                for (int ks = 0; ks < 2; ++ks) vf[ks] = frag_tr32(X_V, ks * 32, 16 * ct, lane);
#pragma unroll
                for (int bi = 0; bi < 4; ++bi) { rhs[bi] = (f32x4){0.f, 0.f, 0.f, 0.f};
#pragma unroll
                    for (int ks = 0; ks < 2; ++ks) rhs[bi] = __builtin_amdgcn_mfma_f32_16x16x32_bf16(*(const LAS bf16x8*)(A_AK + (16 * bi + fr) * LSTR + ks * 32 + fq * 8), vf[ks], rhs[bi], 0, 0, 0); }
            }
            __syncthreads();
            s16x4 xb[4];
#pragma unroll
            for (int bi = 0; bi < 4; ++bi) {
                f32x4 acc = rhs[bi];
#pragma unroll
                for (int bj = 0; bj < 4; ++bj) if (bj < bi) acc = mfma16(*(const LAS s16x4*)(A_AB + (16 * bi + fr) * LSTR + 16 * bj + 4 * fq), xb[bj], acc);
                const s16x4 hi = cvt_hi(acc), lo = cvt_lo(acc, hi); const s16x4 df = *(const LAS s16x4*)(DB + (16 * bi + fr) * DSTR + 4 * fq);
                f32x4 x = mfma16(df, hi, (f32x4){0.f, 0.f, 0.f, 0.f}); x = mfma16(df, lo, x);
                xb[bi] = cvt_hi(x);
            }
            const int col = 16 * ct + fr; const int c4 = 16 * ct + 4 * fq;
#pragma unroll
            for (int bi = 0; bi < 4; ++bi) {
                f32x4 acc; const int t = 16 * bi + fr;
                if (wave < 4) { const u32x2 rw = *(const LAS u32x2*)(X_R + t * LSTR + c4); acc[0] = bflo(rw.x); acc[1] = bfhi(rw.x); acc[2] = bflo(rw.y); acc[3] = bfhi(rw.y); }
                else {
                    acc = (f32x4){0.f, 0.f, 0.f, 0.f};
#pragma unroll
                    for (int ks = 0; ks < 2; ++ks) acc = __builtin_amdgcn_mfma_f32_16x16x32_bf16(vf[ks], *(const LAS bf16x8*)(A_RK + t * LSTR + ks * 32 + fq * 8), acc, 0, 0, 0);
                }
#pragma unroll
                for (int bj = 0; bj < 4; ++bj) if (bj <= bi) acc = mfma16(xb[bj], *(const LAS s16x4*)(A_RB + t * LSTR + 16 * bj + 4 * fq), acc);
                const s16x4 o4 = cvt_hi(acc);
                if (wave < 4) *(LAS s16x4*)(ST_Q + t * LSTR + c4) = o4; else *(LAS s16x4*)(ST_Y + t * LSTR + c4) = o4;
            }
#pragma unroll
            for (int mk = 0; mk < 4; ++mk) {
                f32x4 acc = (f32x4){0.f, 0.f, 0.f, 0.f};
                if (wave < 4) {
#pragma unroll
                    for (int bj = 0; bj < 4; ++bj) acc = mfma16(xb[bj], frag_tr16(X_B, 16 * bj, 16 * mk, lane), acc);
                    const int k = 16 * mk + fr; const float gl = GL[k];
#pragma unroll
                    for (int r = 0; r < 4; ++r) acc[r] = gl * (acc[r] + ((k == c4 + r) ? 1.0f : 0.0f));
                    *(LAS s16x4*)(ST_M + k * LSTR + 32 * (ct >> 1) + 8 * fq + 4 * (ct & 1)) = cvt_hi(acc);
                } else {
#pragma unroll
                    for (int ks = 0; ks < 2; ++ks) acc = __builtin_amdgcn_mfma_f32_16x16x32_bf16(frag_tr32(X_K, ks * 32, 16 * mk, lane), vf[ks], acc, 0, 0, 0);
#pragma unroll
                    for (int bj = 0; bj < 4; ++bj) acc = mfma16(frag_tr16(X_B, 16 * bj, 16 * mk, lane), xb[bj], acc);
                    const f32x4 gl4 = *(const LAS f32x4*)(GL + 16 * mk + 4 * fq);
                    acc = acc * gl4;
                    *(LAS s16x4*)(ST_N + col * LSTR + 16 * mk + 4 * fq) = cvt_hi(acc);
                }
            }
            __syncthreads();
            { const size_t mr = mrow0 + t_e;
              const size_t ub = (size_t)((b * NH + h) * NCHUNK + c) * 4096 + t_e * 64 + c8;
              *(u32x4*)(F.QD + ub) = *(const LAS u32x4*)(ST_Q + t_e * LSTR + c8);
              *(u32x4*)(F.YCAT + mr * DBR + h * 64 + c8) = *(const LAS u32x4*)(ST_Y + t_e * LSTR + c8);
              *(u32x4*)(F.MD + ub) = *(const LAS u32x4*)(ST_M + t_e * LSTR + c8);
              *(u32x4*)(F.ND + ub) = *(const LAS u32x4*)(ST_N + t_e * LSTR + c8); }
        }
    }
}

struct ScanBuf { u32x4 m[4][2]; u32x2 nn[4]; };
__device__ __forceinline__ void scan_load(ScanBuf& B, const bf16_t* PA, size_t mrow0, int h, int v, int fr, int fq) {
#pragma unroll
    for (int i = 0; i < 4; ++i) { const bf16_t* mrowp = PA + (mrow0 + 16 * i + fr) * NPA + PA_KA + h * 64;
#pragma unroll
        for (int ks = 0; ks < 2; ++ks) B.m[i][ks] = *(const u32x4*)(mrowp + 32 * ks + 8 * fq);
        B.nn[i] = *(const u32x2*)(PA + (mrow0 + v) * NPA + PA_VA + h * 64 + 16 * i + 4 * fq); }
}
__device__ __forceinline__ void scan_step(f32x4 (&st)[4], const ScanBuf& B, bf16_t* sp, int fq) {
    u32x2 pk[4];
#pragma unroll
    for (int i = 0; i < 4; ++i) { pk[i].x = pk2(st[i][0], st[i][1]); pk[i].y = pk2(st[i][2], st[i][3]); *(u32x2*)(sp + 16 * i + 4 * fq) = pk[i]; }
    bf16x8 bfr[2];
#pragma unroll
    for (int ks = 0; ks < 2; ++ks) { u32x4 w; w.x = pk[2 * ks].x; w.y = pk[2 * ks].y; w.z = pk[2 * ks + 1].x; w.w = pk[2 * ks + 1].y; bfr[ks] = __builtin_bit_cast(bf16x8, w); }
#pragma unroll
    for (int i = 0; i < 4; ++i) { f32x4 n; n[0] = bflo(B.nn[i].x); n[1] = bfhi(B.nn[i].x); n[2] = bflo(B.nn[i].y); n[3] = bfhi(B.nn[i].y);
#pragma unroll
        for (int ks = 0; ks < 2; ++ks) n = __builtin_amdgcn_mfma_f32_16x16x32_bf16(__builtin_bit_cast(bf16x8, B.m[i][ks]), bfr[ks], n, 0, 0, 0);
        st[i] = n; }
}
constexpr int SC_NST = 2;
constexpr int SC_STEP_BYTES = 8192 + 2048, SC_SLOT_BYTES = SC_NST * SC_STEP_BYTES, SC_NSLOT = 6;
constexpr int SC_SO_OFF = SC_NSLOT * SC_SLOT_BYTES, SC_SO_STEP = 16 * LSTR * 2, SC_SO_SLOT = SC_NST * SC_SO_STEP;
__device__ __forceinline__ void scan_dma(Frame& F, int wave, int lane, int it, LAS unsigned char* slot, size_t row0, int h, int vt) {
    const int r8 = lane >> 3, cg = ((lane & 7) ^ r8) * 8;
#pragma unroll
    for (int q = 0; q < 4; ++q) { const int j = (wave - 1) + 5 * q;
        { const int st = j / 10, w10 = j % 10; const size_t ubase = row0;
            const bf16_t* g = (w10 < 8) ? F.MD + ubase + (size_t)(SC_NST * it + st) * 4096 + (8 * w10 + r8) * 64 + cg : F.ND + ubase + (size_t)(SC_NST * it + st) * 4096 + (16 * vt + 8 * (w10 - 8) + r8) * 64 + cg;
            __builtin_amdgcn_global_load_lds((const unsigned*)g, (LAS unsigned*)(slot + st * SC_STEP_BYTES + w10 * 1024), 16, 0, 0); } }
}
__device__ __forceinline__ void scan_flush(int L2, int it, const LAS unsigned char* so, bf16_t* sp0v0) {
#pragma unroll
    for (int st = 0; st < SC_NST; ++st) { const int rr = (L2 >> 3) & 15, ch = L2 & 7;
        *(u32x4*)(sp0v0 + (size_t)(SC_NST * it + st) * 4096 + rr * 64 + ch * 8) = *(const LAS u32x4*)(so + st * SC_SO_STEP + rr * (LSTR * 2) + ch * 16); }
}
__device__ __forceinline__ void p4_scan(Frame& F) {
    const int lane = F.lane, wave = F.wave, fr = lane & 15, fq = lane >> 4;
    constexpr int NIT = NCHUNK / SC_NST;
    for (int vb = F.bid; vb < 128; vb += F.G) {
        const int b = vb >> 6, h = (vb >> 2) & 15, vt = vb & 3;
        const size_t row0 = (size_t)((b * NH + h) * NCHUNK) * 4096;
        const int L = (wave - 1) * 64 + lane;
        bf16_t* sp0v0 = F.STATES + ((size_t)((b * NH + h) * NCHUNK)) * 4096 + (16 * vt) * 64;
        __syncthreads();
        if (wave >= 1 && wave <= 5) {
#pragma unroll
            for (int p = 0; p < 5; ++p) scan_dma(F, wave, lane, p, F.lds + p * SC_SLOT_BYTES, row0, h, vt);
        }
        asm volatile("s_waitcnt vmcnt(0)\n\ts_barrier" ::: "memory");
        f32x4 st[4];
#pragma unroll
        for (int i = 0; i < 4; ++i) st[i] = (f32x4){0.f, 0.f, 0.f, 0.f};
        int cur = 0, cur3 = 0;
        for (int it = 0; it < NIT; ++it) {
            if (wave >= 6) {
                if (it >= 1) scan_flush(L - 320, it - 1, F.lds + SC_SO_OFF + ((cur3 == 0) ? 2 : cur3 - 1) * SC_SO_SLOT, sp0v0);
            } else if (wave >= 1) {
                const int s5 = (cur == 0) ? 5 : cur - 1;
                if (it + 5 < NIT) scan_dma(F, wave, lane, it + 5, F.lds + s5 * SC_SLOT_BYTES, row0, h, vt);
                asm volatile("s_waitcnt vmcnt(16)" ::: "memory");
            } else {
                const LAS unsigned char* slot = F.lds + cur * SC_SLOT_BYTES; LAS unsigned char* so = F.lds + SC_SO_OFF + cur3 * SC_SO_SLOT;
#pragma unroll
                for (int s4 = 0; s4 < SC_NST; ++s4) {
                    u32x2 pk[4];
#pragma unroll
                    for (int i = 0; i < 4; ++i) { pk[i].x = pk2(st[i][0], st[i][1]); pk[i].y = pk2(st[i][2], st[i][3]); *(LAS u32x2*)(so + s4 * SC_SO_STEP + fr * (LSTR * 2) + (16 * i + 4 * fq) * 2) = pk[i]; }
                    bf16x8 bfr[2];
#pragma unroll
                    for (int ks = 0; ks < 2; ++ks) { u32x4 w; w.x = pk[2 * ks].x; w.y = pk[2 * ks].y; w.z = pk[2 * ks + 1].x; w.w = pk[2 * ks + 1].y; bfr[ks] = __builtin_bit_cast(bf16x8, w); }
#pragma unroll
                    for (int i = 0; i < 4; ++i) {
                        const u32x2 nn = *(const LAS u32x2*)(slot + s4 * SC_STEP_BYTES + 8192 + fr * 128 + (((2 * i + (fq >> 1)) ^ (fr & 7)) * 16) + (fq & 1) * 8);
                        f32x4 n; n[0] = bflo(nn.x); n[1] = bfhi(nn.x); n[2] = bflo(nn.y); n[3] = bfhi(nn.y);
#pragma unroll
                        for (int ks = 0; ks < 2; ++ks) { const u32x4 mf = *(const LAS u32x4*)(slot + s4 * SC_STEP_BYTES + (16 * i + fr) * 128 + (((4 * ks + fq) ^ (fr & 7)) * 16));
                            n = __builtin_amdgcn_mfma_f32_16x16x32_bf16(__builtin_bit_cast(bf16x8, mf), bfr[ks], n, 0, 0, 0); }
                        st[i] = n; }
                }
            }
            asm volatile("s_waitcnt lgkmcnt(0)\n\ts_barrier" ::: "memory");
            cur = (cur == 5) ? 0 : cur + 1; cur3 = (cur3 == 2) ? 0 : cur3 + 1;
        }
        if (wave >= 6) scan_flush(L - 320, NIT - 1, F.lds + SC_SO_OFF + ((cur3 == 0) ? 2 : cur3 - 1) * SC_SO_SLOT, sp0v0);
    }
}

__device__ __forceinline__ void p5_out(Frame& F) {
    const int lane = F.lane, wave = F.wave, fr = lane & 15, fq = lane >> 4, grp = wave >> 2, wq = wave & 3;
    for (int u = F.bid * 2 + grp; u < BATCH * NH * NCHUNK; u += F.G * 2) {
        const int c = u & 127, h = (u >> 7) & 15, b = u >> 11; const size_t mrow0 = (size_t)b * SEQ + (size_t)c * 64;
        const bf16_t* sp = F.STATES + (size_t)u * 4096;
        const int t = 16 * wq + fr; const size_t m = mrow0 + t; const bool hasprev = (c > 0) || (t > 0);
        bf16x8 qa[2];
#pragma unroll
        for (int ks = 0; ks < 2; ++ks) qa[ks] = *(const bf16x8*)(F.QD + (size_t)u * 4096 + t * 64 + ks * 32 + fq * 8);
        f32x4 y[4];
#pragma unroll
        for (int nt = 0; nt < 4; ++nt) {
            const u32x2 yl = *(const u32x2*)(F.YCAT + m * DBR + h * 64 + 16 * nt + 4 * fq);
            y[nt] = (f32x4){bflo(yl.x), bfhi(yl.x), bflo(yl.y), bfhi(yl.y)};
#pragma unroll
            for (int ks = 0; ks < 2; ++ks) { const bf16x8 sb = *(const bf16x8*)(sp + (16 * nt + fr) * 64 + ks * 32 + fq * 8);
                y[nt] = __builtin_amdgcn_mfma_f32_16x16x32_bf16(sb, qa[ks], y[nt], 0, 0, 0); } }
        float s = 0.f;
#pragma unroll
        for (int nt = 0; nt < 4; ++nt) s += (y[nt][0] + y[nt][1]) + (y[nt][2] + y[nt][3]);
        s += __shfl_xor(s, 16); s += __shfl_xor(s, 32);
        const float mean = s * (1.0f / 64.0f);
        float q = 0.f;
#pragma unroll
        for (int nt = 0; nt < 4; ++nt)
#pragma unroll
            for (int r = 0; r < 4; ++r) { const float d = y[nt][r] - mean; q += d * d; }
        q += __shfl_xor(q, 16); q += __shfl_xor(q, 32);
        const float rstd = 1.0f / sqrtf(q * (1.0f / 64.0f) + GN_EPS);
        const float bon = F.BONUS[m * NH + h];
#pragma unroll
        for (int nt = 0; nt < 4; ++nt) { const int ch = h * 64 + 16 * nt + 4 * fq;
            const u32x2 pvw = *(const u32x2*)(F.PA + m * NPA + PA_V + ch); const u32x2 qvw = hasprev ? *(const u32x2*)(F.PA + (m - 1) * NPA + PA_V + ch) : (u32x2){0u, 0u};
            const u32x2 zw = *(const u32x2*)(F.PA + m * NPA + PA_ZR + ch);
            const f32x4 mu4 = *(const f32x4*)(F.mu_rkv + 2 * DBR + ch), g4 = *(const f32x4*)(F.lnx_g + ch), b4 = *(const f32x4*)(F.lnx_b + ch);
            const f32x4 pv = (f32x4){bflo(pvw.x), bfhi(pvw.x), bflo(pvw.y), bfhi(pvw.y)}, qv = (f32x4){bflo(qvw.x), bfhi(qvw.x), bflo(qvw.y), bfhi(qvw.y)};
            const f32x4 z = (f32x4){bflo(zw.x), bfhi(zw.x), bflo(zw.y), bfhi(zw.y)};
            const f32x4 vv = pv + (qv - pv) * mu4;
            f32x4 o4;
#pragma unroll
            for (int r = 0; r < 4; ++r) o4[r] = ((y[nt][r] - mean) * rstd * g4[r] + b4[r] + bon * vv[r]) * (z[r] * sigmoidf_(z[r]));
            u32x2 ow; ow.x = pk2(o4[0], o4[1]); ow.y = pk2(o4[2], o4[3]);
            *(u32x2*)(F.YCAT + m * DBR + ch) = ow; }
    }
}

__device__ __forceinline__ void p8_final(Frame& F) {
    const int gw = F.bid * NWAVES + F.wave, NGW = F.G * NWAVES;
    for (int m0 = gw; m0 < M; m0 += 2 * NGW) {
#pragma unroll
        for (int q = 0; q < 2; ++q) { const int m = (m0 + q * NGW < M) ? m0 + q * NGW : m0;
            const f32x4* xr = (const f32x4*)(F.x + (size_t)m * DM) + 2 * F.lane; const f32x4* gr = (const f32x4*)F.post_g + 2 * F.lane;
            const u32x4* orow = (const u32x4*)(F.OBF + (size_t)m * DM) + F.lane;
            f32x4* outr = (f32x4*)(F.out + (size_t)m * DM) + 2 * F.lane;
            u32x4 ow[4]; f32x4 x0[4], x1[4];
#pragma unroll
            for (int jj = 0; jj < 4; ++jj) { ow[jj] = orow[64 * jj]; x0[jj] = xr[128 * jj]; x1[jj] = xr[128 * jj + 1]; }
            float ss = (F.lane < 32) ? F.SSP[(size_t)m * 32 + F.lane] : 0.f;
            ss = wave_sum(ss);
            const float rstd = 1.0f / sqrtf(ss * (1.f / DM) + NORM_EPS);
#pragma unroll
            for (int jj = 0; jj < 4; ++jj) { float ov[8]; unpack8(ow[jj], ov);
                const f32x4 g0 = gr[128 * jj], g1 = gr[128 * jj + 1];
                outr[128 * jj] = x0[jj] + (f32x4){ov[0], ov[1], ov[2], ov[3]} * rstd * g0; outr[128 * jj + 1] = x1[jj] + (f32x4){ov[4], ov[5], ov[6], ov[7]} * rstd * g1; }
        }
    }
}

struct Args { const float* in[22]; float* out; unsigned char* ws; int ph_lo, ph_hi, li, pad; };
constexpr int N_PHASES = 9;
__global__ void __launch_bounds__(NTHREADS, 2) mk_fwd(Args args) {
    extern __shared__ __attribute__((aligned(16))) unsigned char lds[];
    Frame F;
    F.lds = (LAS unsigned char*)lds;
    F.tid = threadIdx.x; F.lane = F.tid & 63; F.wave = __builtin_amdgcn_readfirstlane(F.tid >> 6);
    F.G = gridDim.x; F.bid = blockIdx.x;
    unsigned char* ws = args.ws;
    F.x = args.in[0]; F.pre_g = args.in[1]; F.post_g = args.in[2]; F.w_in = args.in[3]; F.mu_rkv = args.in[4]; F.mu_wa = args.in[5]; F.w0 = args.in[6]; F.w1 = args.in[7]; F.w2 = args.in[8];
    F.a0 = args.in[9]; F.a1 = args.in[10]; F.a2 = args.in[11]; F.k_k = args.in[12]; F.k_a = args.in[13]; F.r_k = args.in[14]; F.lnx_g = args.in[15]; F.lnx_b = args.in[16]; F.rel_bias = args.in[17];
    F.w_br = args.in[18]; F.w_ba = args.in[19]; F.b_merge = args.in[20]; F.w_out = args.in[21]; F.out = args.out;
    F.HB = (bf16_t*)((unsigned char*)args.out + DO_HB); F.WIN_T = (bf16_t*)((unsigned char*)args.out + DO_WIN); F.STATES = (bf16_t*)((unsigned char*)args.out + DO_STATES);
    F.MD = (bf16_t*)((unsigned char*)args.out + DO_MD); F.ND = (bf16_t*)((unsigned char*)args.out + DO_ND); F.QD = (bf16_t*)((unsigned char*)args.out + DO_QD);
    F.WCAT_T = (bf16_t*)(ws + WS_WCAT); F.WOUT_T = (bf16_t*)(ws + WS_WOUT); F.W2T = (bf16_t*)(ws + WS_W2T); F.A2T = F.W2T + DBR * 64;
    F.BONUS = (float*)(ws + WS_BONUS); F.SSP = (float*)(ws + WS_SSP); F.PL = (bf16_t*)(ws + WS_PLS); F.PG = (bf16_t*)(ws + WS_PG); F.PA = (bf16_t*)(ws + WS_PA);
    F.MERGED = (bf16_t*)(ws + WS_MERGED); F.YCAT = (bf16_t*)(ws + WS_YCAT); F.OBF = (bf16_t*)(ws + WS_OBF); F.queue = (unsigned*)(ws + WS_CTL) + 65536;
    for (int u = F.tid; u < (LDS_BYTES - LDSCTL_OFF) / 4; u += NTHREADS) ((LAS unsigned*)(F.lds + LDSCTL_OFF))[u] = 0u;
    __syncthreads();
    const int lo = args.ph_lo, hi = args.ph_hi;
    XcdBarrier bar; bar.bar = (unsigned*)(ws + WS_CTL) + CW_BAR; bar.x = 0; bar.st = nullptr;
    if (hi - lo > 1) bar = xcd_barrier_post((unsigned*)(ws + WS_CTL) + CW_BAR, (volatile LAS unsigned*)(F.lds + MISC_OFF) + 8);
#define IN(k) (lo <= (k) && (k) < hi)
#define SEAM(k) do { if (IN(k) && IN((k) + 1)) xcd_barrier(bar); } while (0)
#define PHASE(k, ...) do { if (IN(k)) { __VA_ARGS__; SEAM(k); if (PROBE_REP == (k)) { __VA_ARGS__; xcd_barrier(bar); } } } while (0)
    PHASE(0, p0_prologue(F));
    PHASE(1, {
        pg8::Gemm g{F.HB, F.WIN_T, M, NIN, DM}; pg8::SplitOrder S; S.so.init(M, NPA + NPG, F.G, F.bid, DM, WGM_P1); S.extra_pn = (NPA + NPG) / 256;
        EpiIn E{F.PA, F.PG, F.PL, F.b_merge};
        pg8::gemm_phase<EpiIn, pg8::SplitOrder, P1_ALIGN, P1_SP2>(F.lds, g, S, E);
    });
    PHASE(3, p3_prep(F));
    PHASE(4, { p4_scan(F); p2_attention(F); });
    PHASE(5, p5_out(F));
    PHASE(6, {
        pg8::Gemm g{F.YCAT, F.WCAT_T, 2 * M, 2 * DM, DBR}; pg8::PairOrder S; S.so.init(M, DM, F.G, F.bid, DBR, WGM_P6); S.dpm = M / 256; S.dpn = DM / 256;
        EpiBranch E{F.PG, F.MERGED};
        pg8::gemm_phase<EpiBranch, pg8::PairOrder, true, true>(F.lds, g, S, E);
    });
    PHASE(7, {
        pg8::Gemm g{F.MERGED, F.WOUT_T, M, DM, DM}; pg8::StaticOrder S; S.init(M, DM, F.G, F.bid, DM, WGM_P7);
        EpiOut E{F.OBF, F.SSP};
        pg8::gemm_phase<EpiOut, pg8::StaticOrder, true, true>(F.lds, g, S, E);
    });
    if (IN(8)) { p8_final(F); }
#undef PHASE
#undef IN
#undef SEAM
}

extern "C" void kernel_launch(void* const* d_in, const int* in_sizes, int n_in, void* d_out, int out_size, void* d_ws, size_t ws_size, hipStream_t stream) {
    static int grid = 0;
    if (grid == 0) {
        if (n_in != 22 || in_sizes[0] != M * DM || out_size != M * DM || ws_size < WS_END) { fprintf(stderr, "kernel_launch: unexpected shapes (n_in %d in0 %d out %d ws %zu); nothing launched\n", n_in, n_in > 0 ? in_sizes[0] : -1, out_size, ws_size); grid = -1; return; }
        int dev = 0, cus = 0;
        if (hipGetDevice(&dev) != hipSuccess || hipDeviceGetAttribute(&cus, hipDeviceAttributeMultiprocessorCount, dev) != hipSuccess) { fprintf(stderr, "kernel_launch: device query failed\n"); grid = -1; return; }
        if (hipFuncSetAttribute((const void*)mk_fwd, hipFuncAttributeMaxDynamicSharedMemorySize, LDS_BYTES) != hipSuccess) { fprintf(stderr, "kernel_launch: hipFuncSetAttribute failed\n"); grid = -1; return; }
        int per_cu = 0;
        if (hipOccupancyMaxActiveBlocksPerMultiprocessor(&per_cu, (const void*)mk_fwd, NTHREADS, LDS_BYTES) != hipSuccess || per_cu < 1) fprintf(stderr, "kernel_launch: note: occupancy query reports %d blocks per CU\n", per_cu);
        (void)hipGetLastError();
        grid = cus > 256 ? 256 : cus;
        if (grid != 256) { fprintf(stderr, "kernel_launch: this build needs a 256-CU device (got %d); nothing launched\n", cus); grid = -1; return; }
    }
    if (grid < 0) return;
    (void)hipMemsetAsync((char*)d_ws + WS_CTL, 0, CTL_ZERO_BYTES, stream);
    Args a{};
    for (int i = 0; i < 22; ++i) a.in[i] = (const float*)d_in[i];
    a.out = (float*)d_out; a.ws = (unsigned char*)d_ws;
#if MK_N_LAUNCHES == 1
    a.ph_lo = 0; a.ph_hi = N_PHASES; a.li = 0;
    hipLaunchKernelGGL(mk_fwd, dim3(grid), dim3(NTHREADS), LDS_BYTES, stream, a);
#else
    for (int li = 0; li < N_PHASES; ++li) { a.ph_lo = li; a.ph_hi = li + 1; a.li = li; hipLaunchKernelGGL(mk_fwd, dim3(grid), dim3(NTHREADS), LDS_BYTES, stream, a); }
#endif
}
```

```cpp
#include <hip/hip_runtime.h>
#include <cstdio>
#include <cstdint>

#ifndef MK_N_LAUNCHES
#define MK_N_LAUNCHES 1
#endif
#ifndef WGM_P1
#define WGM_P1 6
#endif
#ifndef WGM_P6
#define WGM_P6 2
#endif
#ifndef WGM_P7
#define WGM_P7 2
#endif
#ifndef P1_ALIGN
#define P1_ALIGN true
#endif
#ifndef P1_SP2
#define P1_SP2 true
#endif
#ifndef XCD_REMAP
#define XCD_REMAP 1
#endif
#ifndef ROT_COLS
#define ROT_COLS 0
#endif
#ifndef PROBE_REP
#define PROBE_REP -1
#endif

#define LAS __attribute__((address_space(3)))
#define GAS __attribute__((address_space(1)))
typedef unsigned short bf16_t;
typedef short bf16x8 __attribute__((ext_vector_type(8)));
typedef short s16x4 __attribute__((ext_vector_type(4)));
typedef float f32x4 __attribute__((ext_vector_type(4)));
typedef float f32x2 __attribute__((ext_vector_type(2)));
typedef unsigned u32x4 __attribute__((ext_vector_type(4)));
typedef unsigned u32x2 __attribute__((ext_vector_type(2)));
typedef __bf16 bf16x2_t __attribute__((ext_vector_type(2)));

constexpr int BATCH = 2, SEQ = 8192, DM = 2048, DBR = 1024, NH = 16, HD = 64, CHUNK = 64, NCHUNK = SEQ / CHUNK, M = BATCH * SEQ;
constexpr int NPA = 8192, NPG = 4096, NPL = 256, NIN = NPA + NPG + NPL;
constexpr int PA_R = 0, PA_K = 1024, PA_V = 2048, PA_ZR = 3072, PA_Q = 4096, PA_KA = 5120, PA_VA = 6144, PA_ZA = 7168;
constexpr float NORM_EPS = 1e-6f, GN_EPS = 64e-5f, DECAY_SCALE = 0.606531f;
constexpr int NWAVES = 8, NTHREADS = 512;

constexpr size_t MiB = 1u << 20;
constexpr size_t WS_CTL = 0, CTL_ZERO_BYTES = 1 * MiB;
constexpr size_t WS_WCAT = 1 * MiB;
constexpr size_t WS_WOUT = 9 * MiB;
constexpr size_t WS_W2T = 17 * MiB;
constexpr size_t WS_BONUS = 18 * MiB;
constexpr size_t WS_SSP = 19 * MiB;
constexpr size_t WS_PL = 22 * MiB;
constexpr size_t WS_PG = 30 * MiB;
constexpr size_t WS_PA = 158 * MiB;
constexpr size_t WS_MERGED = WS_PA;
constexpr size_t WS_OBF = WS_PA + 64 * MiB;
constexpr size_t WS_YCAT = 414 * MiB;
constexpr size_t WS_PLS = 478 * MiB;
constexpr size_t WS_END = 510 * MiB;
constexpr size_t DO_HB = 0, DO_WIN = 64 * MiB, DO_STATES = 0;
constexpr size_t DO_MD = 32 * MiB, DO_ND = 64 * MiB, DO_QD = 96 * MiB;
constexpr int CW_BAR = 4096;

constexpr int RING_BYTES = 131072;
constexpr int LDSCTL_OFF = 152576, MISC_OFF = LDSCTL_OFF + 320;
constexpr int LDS_BYTES = 153600;

typedef GAS unsigned gu32;
#define RLX_AGENT __ATOMIC_RELAXED, __HIP_MEMORY_SCOPE_AGENT
#define LDS_WAIT() asm volatile("s_waitcnt lgkmcnt(0)" ::: "memory")
#define VM_WAIT() asm volatile("s_waitcnt vmcnt(0)" ::: "memory")
__device__ __forceinline__ unsigned pk2(float lo, float hi) { f32x2 v = {lo, hi}; bf16x2_t b = __builtin_convertvector(v, bf16x2_t); return __builtin_bit_cast(unsigned, b); }
__device__ __forceinline__ bf16_t f2bf(float f) { return (bf16_t)(pk2(f, 0.f) & 0xffffu); }
__device__ __forceinline__ float bflo(unsigned w) { return __uint_as_float(w << 16); }
__device__ __forceinline__ float bfhi(unsigned w) { return __uint_as_float(w & 0xffff0000u); }
__device__ __forceinline__ float bf2f(bf16_t h) { return __uint_as_float(((unsigned)h) << 16); }
__device__ __forceinline__ void unpack8(const u32x4 w, float (&f)[8]) { f[0] = bflo(w.x); f[1] = bfhi(w.x); f[2] = bflo(w.y); f[3] = bfhi(w.y); f[4] = bflo(w.z); f[5] = bfhi(w.z); f[6] = bflo(w.w); f[7] = bfhi(w.w); }
__device__ __forceinline__ u32x4 pack8(const float (&f)[8]) { u32x4 w; w.x = pk2(f[0], f[1]); w.y = pk2(f[2], f[3]); w.z = pk2(f[4], f[5]); w.w = pk2(f[6], f[7]); return w; }
__device__ __forceinline__ void load8(const float* p, float (&f)[8]) { const f32x4 a = *(const f32x4*)p, b = *(const f32x4*)(p + 4); f[0] = a.x; f[1] = a.y; f[2] = a.z; f[3] = a.w; f[4] = b.x; f[5] = b.y; f[6] = b.z; f[7] = b.w; }
__device__ __forceinline__ float sigmoidf_(float x) { return 1.f / (1.f + __expf(-x)); }
__device__ __forceinline__ float tanhf_(float x) { return 1.f - 2.f / (1.f + __expf(2.f * x)); }

namespace pg8 {
constexpr int BM = 256, BK = 64, HALF = 128, HTB = HALF * BK * 2  , STAGE_BYTES = 8 * HTB, NXCD = 8;
__host__ __device__ __forceinline__ int lds_byte(int r, int c) { const int st = (r >> 4) * 2 + (c >> 5), rr = r & 15, cc = c & 31, ob = rr * 64 + cc * 2; return st * 1024 + (ob ^ (((ob >> 9) & 1) << 5)); }
__host__ __device__ __forceinline__ void stage_rc(int b, int& R, int& C) { const int st = b / 1024, sb = b % 1024, swz = sb ^ (((sb >> 9) & 1) << 5); R = (st >> 1) * 16 + swz / 64; C = (st & 1) * 32 + (swz % 64) / 2; }
__host__ __device__ __forceinline__ int perm32(int rho) { const int n = rho >> 4, i = rho & 15; return 8 * (i >> 2) + 4 * n + (i & 3); }

struct Unit { int pm, pn, kb, nt; };
struct Gemm { const bf16_t* A; const bf16_t* Bt; int M, N, K; };

struct StaticOrder {
    int nM, nN, nwg, G, c, ntk, WGM;
    __host__ __device__ void init(int M_, int N_, int G_, int c_, int K_, int wgm_) { nM = M_ / BM; nN = N_ / BM; nwg = nM * nN; G = G_; c = c_; ntk = K_ / BK; WGM = wgm_; }
    __host__ __device__ void tile(int L, int& pm, int& pn) const {
        int wgid = L; if (XCD_REMAP) { const int q = nwg / NXCD, r = nwg % NXCD, xcd = wgid % NXCD, off = wgid / NXCD; wgid = (xcd < r ? xcd * (q + 1) : r * (q + 1) + (xcd - r) * q) + off; }
        if (WGM > 0) { const int nig = WGM * nN, gid = wgid / nig, fm = gid * WGM, gsz = (nM - fm) < WGM ? (nM - fm) : WGM;
            pm = fm + ((wgid % nig) % gsz); pn = (wgid % nig) / gsz;
            if (ROT_COLS) pn = (pn + ROT_COLS * gid) % nN; }
        else { const int W = -WGM, nig = W * nM, gid = wgid / nig, fn = gid * W, gsz = (nN - fn) < W ? (nN - fn) : W;
            pn = fn + ((wgid % nig) % gsz); pm = (wgid % nig) / gsz; }
    }
    __host__ __device__ bool next(int i, Unit& u) const {
        const long L = (long)i * G + c; if (L >= nwg) return false;
        int pm, pn; tile((int)L, pm, pn);
        u.pm = pm; u.pn = pn; u.kb = 0; u.nt = ntk; return true;
    }
};
struct SplitOrder {
    StaticOrder so; int extra_pn;
    __host__ __device__ bool next(int i, Unit& u) const {
        const long L = (long)i * so.G + so.c; const bool normal = L < so.nwg; const int Lq = (int)(L - so.nwg);
        if (!normal && Lq >= 256) return false;
        int pm, pn; so.tile(normal ? (int)L : 0, pm, pn);
        u.pm = normal ? pm : (Lq >> 2); u.pn = normal ? pn : extra_pn; u.kb = normal ? 0 : (Lq & 3) * 1024; u.nt = normal ? so.ntk : 8; return true;
    }
};
struct PairOrder {
    StaticOrder so; int dpm, dpn;
    __host__ __device__ bool next(int i, Unit& u) const { if (!so.next(i >> 1, u)) return false; if (i & 1) { u.pm += dpm; u.pn += dpn; } return true; }
};

template <class Epi, class Sched, bool ALIGN_EPI = false, bool SP2 = false>
__device__ __forceinline__ void gemm_phase(LAS unsigned char* lds, const Gemm g, const Sched& S, const Epi& E) {
    const int tid = threadIdx.x, wid = __builtin_amdgcn_readfirstlane(tid >> 6), lane = tid & 63, wr = wid >> 2, wc = wid & 3, fr = lane & 15, fq = lane >> 4;
    const int K = g.K;
    unsigned voffA[2], voffB[2];
#pragma unroll
    for (int i = 0; i < 2; ++i) { int R, C; stage_rc(tid * 16 + i * 8192, R, C); const int Rb = Epi::PERM ? ((R & ~31) + perm32(R & 31)) : R;
        voffA[i] = (unsigned)(R * K + C) * 2u; voffB[i] = (unsigned)(Rb * K + C) * 2u; }
    const size_t kstep = (size_t)(BK * 2);
    const size_t hstep = (size_t)HALF * K * 2;
    const size_t tstep = 2 * hstep;
    const unsigned ldsw = (unsigned)wid * 1024u;
    const int aoff = lds_byte(wr * 64 + fr, fq * 8), boff = lds_byte(wc * 32 + fr, fq * 8);
#define PG8_SA(b, h) (((b) * 2 + (h)) * HTB)
#define PG8_SB(b, h) ((4 + (b) * 2 + (h)) * HTB)
#define PG8_STAGE(bufoff, gbase, voff) do { _Pragma("unroll") for (int _i = 0; _i < 2; ++_i) \
        __builtin_amdgcn_global_load_lds((const unsigned*)((const char*)(gbase) + (voff)[_i]), (LAS unsigned*)(lds + (bufoff) + ldsw + _i * 8192), 16, 0, 0); } while (0)
#define PG8_LDA(dst, b, h) do { _Pragma("unroll") for (int m = 0; m < 4; ++m) _Pragma("unroll") for (int k = 0; k < 2; ++k) dst[m][k] = *(const LAS bf16x8*)(lds + PG8_SA(b, h) + aoff + m * 2048 + k * 1024); } while (0)
#define PG8_LDB(dst, b, h) do { _Pragma("unroll") for (int n = 0; n < 2; ++n) _Pragma("unroll") for (int k = 0; k < 2; ++k) dst[n][k] = *(const LAS bf16x8*)(lds + PG8_SB(b, h) + boff + n * 2048 + k * 1024); } while (0)
#define PG8_MMA(ai, bj, At, Bt) do { __builtin_amdgcn_s_setprio(1); _Pragma("unroll") for (int m = 0; m < 4; ++m) _Pragma("unroll") for (int n = 0; n < 2; ++n) _Pragma("unroll") for (int k = 0; k < 2; ++k) \
        acc[ai][bj][m][n] = __builtin_amdgcn_mfma_f32_16x16x32_bf16(Bt[n][k], At[m][k], acc[ai][bj][m][n], 0, 0, 0); __builtin_amdgcn_s_setprio(0); } while (0)
#define PG8_WAIT_V(n) asm volatile("s_waitcnt vmcnt(" #n ")" ::: "memory")
#define PG8_WAIT_L(n) asm volatile("s_waitcnt lgkmcnt(" #n ")" ::: "memory")
#define PG8_BAR __builtin_amdgcn_s_barrier()
#define PG8_SCHED __builtin_amdgcn_sched_barrier(0)
    Unit cur, nxt; int ui = 0;
    if (!S.next(0, cur)) return;
    f32x4 acc[2][2][4][2];
#pragma unroll
    for (int a = 0; a < 2; ++a)
#pragma unroll
        for (int b = 0; b < 2; ++b)
#pragma unroll
            for (int m = 0; m < 4; ++m)
#pragma unroll
                for (int n = 0; n < 2; ++n) acc[a][b][m][n] = (f32x4){0.f, 0.f, 0.f, 0.f};
    bf16x8 At[4][2], B0[2][2], B1[2][2];
    const char* cA = (const char*)g.A + (size_t)cur.pm * tstep + cur.kb; const char* cB = (const char*)g.Bt + (size_t)cur.pn * tstep + cur.kb;
    if constexpr (SP2) {
        PG8_STAGE(PG8_SB(0, 0), cB, voffB); PG8_STAGE(PG8_SB(0, 1), cB + hstep, voffB); PG8_STAGE(PG8_SA(0, 0), cA, voffA); PG8_STAGE(PG8_SA(0, 1), cA + hstep, voffA);
        if (wr == 1) PG8_BAR;
        PG8_WAIT_V(2); PG8_BAR;
        PG8_STAGE(PG8_SB(1, 0), cB + kstep, voffB); PG8_STAGE(PG8_SA(1, 0), cA + kstep, voffA); PG8_STAGE(PG8_SB(1, 1), cB + hstep + kstep, voffB);
        PG8_WAIT_V(6); PG8_BAR;
    } else {
        PG8_STAGE(PG8_SB(0, 0), cB, voffB); PG8_STAGE(PG8_SA(0, 0), cA, voffA); PG8_STAGE(PG8_SB(0, 1), cB + hstep, voffB); PG8_STAGE(PG8_SA(0, 1), cA + hstep, voffA);
        if (wr == 1) PG8_BAR;
        PG8_WAIT_V(4); PG8_BAR;
        PG8_STAGE(PG8_SB(1, 0), cB + kstep, voffB); PG8_STAGE(PG8_SA(1, 0), cA + kstep, voffA); PG8_STAGE(PG8_SB(1, 1), cB + hstep + kstep, voffB);
        PG8_WAIT_V(6); PG8_BAR;
    }
    for (;;) {
        const bool has_next = S.next(ui + 1, nxt);
        const char* nA = has_next ? (const char*)g.A + (size_t)nxt.pm * tstep + nxt.kb : cA; const char* nB = has_next ? (const char*)g.Bt + (size_t)nxt.pn * tstep + nxt.kb : cB;
        const int nt = cur.nt;
        for (int t = 0; t < nt; t += 2) {
            const bool last = (t == nt - 2);
            const char* a1 = cA + (size_t)(t + 1) * kstep;
            const char* a2 = last ? nA : cA + (size_t)(t + 2) * kstep; const char* b2 = last ? nB : cB + (size_t)(t + 2) * kstep;
            const char* a3 = a2 + kstep; const char* b3 = b2 + kstep;
            if constexpr (SP2) {
            PG8_LDB(B0, 0, 0); PG8_LDB(B1, 0, 1); PG8_SCHED; PG8_LDA(At, 0, 0); PG8_STAGE(PG8_SA(1, 1), a1 + hstep, voffA);
            PG8_WAIT_V(8); PG8_WAIT_L(0); PG8_BAR; PG8_MMA(0, 0, At, B0); PG8_MMA(0, 1, At, B1); PG8_BAR; PG8_SCHED;
            PG8_LDA(At, 0, 1); PG8_STAGE(PG8_SB(0, 0), b2, voffB); PG8_STAGE(PG8_SB(0, 1), b2 + hstep, voffB); PG8_STAGE(PG8_SA(0, 0), a2, voffA);
            PG8_WAIT_V(8); PG8_WAIT_L(0); PG8_BAR; PG8_MMA(1, 0, At, B0); PG8_MMA(1, 1, At, B1); PG8_BAR; PG8_SCHED;
            PG8_LDB(B0, 1, 0); PG8_LDB(B1, 1, 1); PG8_SCHED; PG8_LDA(At, 1, 0); PG8_STAGE(PG8_SA(0, 1), a2 + hstep, voffA);
            PG8_WAIT_V(8); PG8_WAIT_L(0); PG8_BAR; PG8_MMA(0, 0, At, B0); PG8_MMA(0, 1, At, B1); PG8_BAR; PG8_SCHED;
            PG8_LDA(At, 1, 1); PG8_STAGE(PG8_SB(1, 0), b3, voffB); PG8_STAGE(PG8_SB(1, 1), b3 + hstep, voffB); PG8_STAGE(PG8_SA(1, 0), a3, voffA);
            PG8_WAIT_V(8); PG8_WAIT_L(0); PG8_BAR; PG8_MMA(1, 0, At, B0); PG8_MMA(1, 1, At, B1); PG8_BAR; PG8_SCHED;
            } else {
            PG8_LDB(B0, 0, 0); PG8_SCHED; PG8_LDA(At, 0, 0); PG8_STAGE(PG8_SA(1, 1), a1 + hstep, voffA);
            PG8_WAIT_L(8); PG8_BAR; PG8_WAIT_L(0); PG8_MMA(0, 0, At, B0); PG8_BAR; PG8_SCHED;
            PG8_LDB(B1, 0, 1); PG8_STAGE(PG8_SB(0, 0), b2, voffB);
            PG8_BAR; PG8_WAIT_L(0); PG8_MMA(0, 1, At, B1); PG8_BAR;
            PG8_LDA(At, 0, 1); PG8_STAGE(PG8_SA(0, 0), a2, voffA);
            PG8_BAR; PG8_WAIT_L(0); PG8_MMA(1, 0, At, B0); PG8_BAR; PG8_SCHED;
            PG8_STAGE(PG8_SB(0, 1), b2 + hstep, voffB);
            PG8_WAIT_V(6); PG8_BAR; PG8_MMA(1, 1, At, B1); PG8_BAR;
            PG8_LDB(B0, 1, 0); PG8_SCHED; PG8_LDA(At, 1, 0); PG8_STAGE(PG8_SA(0, 1), a2 + hstep, voffA);
            PG8_WAIT_L(8); PG8_BAR; PG8_WAIT_L(0); PG8_MMA(0, 0, At, B0); PG8_BAR; PG8_SCHED;
            PG8_LDB(B1, 1, 1); PG8_STAGE(PG8_SB(1, 0), b3, voffB);
            PG8_BAR; PG8_WAIT_L(0); PG8_MMA(0, 1, At, B1); PG8_BAR;
            PG8_LDA(At, 1, 1); PG8_STAGE(PG8_SA(1, 0), a3, voffA);
            PG8_BAR; PG8_WAIT_L(0); PG8_MMA(1, 0, At, B0); PG8_BAR; PG8_SCHED;
            PG8_STAGE(PG8_SB(1, 1), b3 + hstep, voffB);
            PG8_WAIT_V(6); PG8_BAR; PG8_MMA(1, 1, At, B1); PG8_BAR;
            }
        }
        if constexpr (ALIGN_EPI) { if (wr == 0) PG8_BAR; }
        const bool zero_acc = E(acc, cur, wr, wc, fr, fq);
        if (!has_next) break;
        if (zero_acc) {
#pragma unroll
        for (int a = 0; a < 2; ++a)
#pragma unroll
            for (int b = 0; b < 2; ++b)
#pragma unroll
                for (int m = 0; m < 4; ++m)
#pragma unroll
                    for (int n = 0; n < 2; ++n) acc[a][b][m][n] = (f32x4){0.f, 0.f, 0.f, 0.f};
        }
        cur = nxt; cA = nA; cB = nB; ++ui;
        if constexpr (ALIGN_EPI) { if (wr == 1) PG8_BAR; }
    }
    PG8_WAIT_V(0);
    if constexpr (!ALIGN_EPI) { if (wr == 0) PG8_BAR; }
    PG8_BAR;
#undef PG8_SA
#undef PG8_SB
#undef PG8_STAGE
#undef PG8_LDA
#undef PG8_LDB
#undef PG8_MMA
#undef PG8_WAIT_V
#undef PG8_WAIT_L
#undef PG8_BAR
#undef PG8_SCHED
}
}

struct EpiIn {
    static constexpr bool PERM = true;
    bf16_t* PA; bf16_t* PG; bf16_t* PL; const LAS float* bmerge;
    __device__ __forceinline__ bool operator()(f32x4 (&acc)[2][2][4][2], const pg8::Unit& u, int wr, int wc, int fr, int fq) const {
        const int row0 = u.pm * 256 + wr * 64 + fr; const int colb = u.pn * 256 + wc * 32 + 8 * fq;
        if (u.pn < 32) {
            const float sc = (u.pn >= 16 && u.pn < 20) ? 0.125f : 1.0f;
#pragma unroll
            for (int ai = 0; ai < 2; ++ai)
#pragma unroll
                for (int m = 0; m < 4; ++m) { bf16_t* rowp = PA + (size_t)(row0 + ai * 128 + m * 16) * NPA + colb;
#pragma unroll
                    for (int bj = 0; bj < 2; ++bj) { const f32x4 v0 = acc[ai][bj][m][0] * sc, v1 = acc[ai][bj][m][1] * sc;
                        u32x4 w; w.x = pk2(v0[0], v0[1]); w.y = pk2(v0[2], v0[3]); w.z = pk2(v1[0], v1[1]); w.w = pk2(v1[2], v1[3]);
                        *(u32x4*)(rowp + bj * 128) = w; } }
        } else if (u.pn < 48) {
            const int j0 = (u.pn - 32) * 128 + wc * 32 + 8 * fq;
            f32x4 bv[2][2];
#pragma unroll
            for (int bj = 0; bj < 2; ++bj)
#pragma unroll
                for (int n = 0; n < 2; ++n) bv[bj][n] = *(const LAS f32x4*)(bmerge + bj * 2048 + j0 + 4 * n);
#pragma unroll
            for (int ai = 0; ai < 2; ++ai)
#pragma unroll
                for (int m = 0; m < 4; ++m) { bf16_t* rowp = PG + (size_t)(row0 + ai * 128 + m * 16) * NPG + j0;
                    float rat[8], ga[8];
#pragma unroll
                    for (int n = 0; n < 2; ++n)
#pragma unroll
                        for (int e = 0; e < 4; ++e) { const float xr = acc[ai][0][m][n][e] + bv[0][n][e], xa = acc[ai][1][m][n][e] + bv[1][n][e];
                            const float dr = 1.0f + __expf(-xr), da = 1.0f + __expf(-xa);
                            ga[4 * n + e] = __builtin_amdgcn_rcpf(da); rat[4 * n + e] = da * __builtin_amdgcn_rcpf(dr); }
                    *(u32x4*)rowp = pack8(rat); *(u32x4*)(rowp + 2048) = pack8(ga); }
        } else {
            const int cl = colb - NPA - NPG;
#pragma unroll
            for (int ai = 0; ai < 2; ++ai)
#pragma unroll
                for (int m = 0; m < 4; ++m) { bf16_t* rowp = PL + (size_t)(u.kb >> 10) * ((size_t)M * NPL) + (size_t)(row0 + ai * 128 + m * 16) * NPL + cl;
#pragma unroll
                    for (int bj = 0; bj < 2; ++bj) { const f32x4 v0 = acc[ai][bj][m][0], v1 = acc[ai][bj][m][1];
                        u32x4 w; w.x = pk2(v0[0], v0[1]); w.y = pk2(v0[2], v0[3]); w.z = pk2(v1[0], v1[1]); w.w = pk2(v1[2], v1[3]);
                        *(u32x4*)(rowp + bj * 128) = w; } }
        }
        return true;
    }
};
struct EpiBranch {
    static constexpr bool PERM = true;
    const bf16_t* PG; bf16_t* MG;
    __device__ __forceinline__ bool operator()(f32x4 (&acc)[2][2][4][2], const pg8::Unit& u, int wr, int wc, int fr, int fq) const {
        const bool first = u.pm < 64;
        const int pm = first ? u.pm : u.pm - 64, pn = first ? u.pn : u.pn - 8;
        const int row0 = pm * 256 + wr * 64 + fr; const int colb = pn * 256 + wc * 32 + 8 * fq;
        const bf16_t* gbase = PG + (first ? 0 : 2048) + colb;
#pragma unroll
        for (int ai = 0; ai < 2; ++ai) {
            u32x4 g_[4][2];
#pragma unroll
            for (int m = 0; m < 4; ++m)
#pragma unroll
                for (int bj = 0; bj < 2; ++bj) g_[m][bj] = *(const u32x4*)(gbase + (size_t)(row0 + ai * 128 + m * 16) * NPG + bj * 128);
#pragma unroll
            for (int m = 0; m < 4; ++m) { const size_t row = (size_t)(row0 + ai * 128 + m * 16);
#pragma unroll
                for (int bj = 0; bj < 2; ++bj) { float g[8]; unpack8(g_[m][bj], g);
#pragma unroll
                    for (int e = 0; e < 4; ++e) { acc[ai][bj][m][0][e] *= g[e]; acc[ai][bj][m][1][e] *= g[4 + e]; }
                    if (!first) { const f32x4 v0 = acc[ai][bj][m][0], v1 = acc[ai][bj][m][1];
                        u32x4 w; w.x = pk2(v0[0], v0[1]); w.y = pk2(v0[2], v0[3]); w.z = pk2(v1[0], v1[1]); w.w = pk2(v1[2], v1[3]);
                        *(u32x4*)(MG + row * DM + colb + bj * 128) = w; } } }
            asm volatile("" ::: "memory");
        }
        return !first;
    }
};
struct EpiOut {
    static constexpr bool PERM = true;
    bf16_t* O; float* SSP;
    __device__ __forceinline__ bool operator()(f32x4 (&acc)[2][2][4][2], const pg8::Unit& u, int wr, int wc, int fr, int fq) const {
        const int row0 = u.pm * 256 + wr * 64 + fr; const int colb = u.pn * 256 + wc * 32 + 8 * fq;
#pragma unroll
        for (int ai = 0; ai < 2; ++ai)
#pragma unroll
            for (int m = 0; m < 4; ++m) { const size_t row = (size_t)(row0 + ai * 128 + m * 16); float ss = 0.f;
#pragma unroll
                for (int bj = 0; bj < 2; ++bj) { const f32x4 v0 = acc[ai][bj][m][0], v1 = acc[ai][bj][m][1];
                    ss += (v0[0] * v0[0] + v0[1] * v0[1]) + (v0[2] * v0[2] + v0[3] * v0[3]) + (v1[0] * v1[0] + v1[1] * v1[1]) + (v1[2] * v1[2] + v1[3] * v1[3]);
                    u32x4 w; w.x = pk2(v0[0], v0[1]); w.y = pk2(v0[2], v0[3]); w.z = pk2(v1[0], v1[1]); w.w = pk2(v1[2], v1[3]);
                    *(u32x4*)(O + row * DM + colb + bj * 128) = w; }
                ss += __shfl_xor(ss, 16); ss += __shfl_xor(ss, 32);
                if (fq == 0) SSP[row * 32 + u.pn * 4 + wc] = ss; }
        return true;
    }
};

#define XB_TMO      128
#define XB_XCNT(j)  (256  + 64 * (j))
#define XB_XSUB(j)  (1280 + 64 * (j))
#define XB_XGEN(j)  (2304 + 64 * (j))
#define XB_TOP      3328
#define XB_TOPGEN   3392
#define XCD_BAR_WORDS 3456
#define XB_SPIN_CAP (1u << 18)
__device__ __forceinline__ unsigned xb_ld(unsigned* p)              { return __hip_atomic_load(p, __ATOMIC_RELAXED, __HIP_MEMORY_SCOPE_AGENT); }
__device__ __forceinline__ unsigned xb_add(unsigned* p, unsigned v) { return __hip_atomic_fetch_add(p, v, __ATOMIC_RELAXED, __HIP_MEMORY_SCOPE_AGENT); }
__device__ __forceinline__ unsigned xb_xcc_id() { return (unsigned)__builtin_amdgcn_s_getreg((3 << 11) | 20) & 0xFu; }
#define XB_SPIN(cond, bar) do { unsigned _sp = 0; while (cond) { __builtin_amdgcn_s_sleep(1); \
    if ((++_sp & 255u) == 0u) { if (xb_ld(&(bar)[XB_TMO])) break; if (_sp > XB_SPIN_CAP) { atomicAdd(&(bar)[XB_TMO], 1u); break; } } } } while (0)
struct XcdBarrier { unsigned* bar; unsigned x; volatile LAS unsigned* st; };
__device__ __forceinline__ XcdBarrier xcd_barrier_post(unsigned* bar, volatile LAS unsigned* st) {
    XcdBarrier b; b.bar = bar; b.x = xb_xcc_id(); b.st = st;
    if (threadIdx.x == 0) (void)xb_add(&bar[XB_XCNT(b.x)], 1u);
    return b;
}
__device__ __forceinline__ void xcd_barrier_complete(unsigned* bar, unsigned x, unsigned& nloc, unsigned& nx) {
    const unsigned G = gridDim.x * gridDim.y * gridDim.z;
    unsigned sum, cnt, mine, sp = 0u;
    for (;;) {
        sum = 0u; cnt = 0u; mine = 0u;
#pragma unroll
        for (unsigned j = 0; j < 16; ++j) { const unsigned c = xb_ld(&bar[XB_XCNT(j)]); sum += c; cnt += (c > 0u) ? 1u : 0u; mine = (j == x) ? c : mine; }
        if (sum == G) break;
        __builtin_amdgcn_s_sleep(1);
        if ((++sp & 255u) == 0u) { if (xb_ld(&bar[XB_TMO])) break; if (sp > XB_SPIN_CAP) { atomicAdd(&bar[XB_TMO], 1u); break; } }
    }
    nloc = mine > 0u ? mine : 1u; nx = cnt > 0u ? cnt : 1u;
}
__device__ __forceinline__ void xcd_barrier(const XcdBarrier& b) {
    asm volatile("s_waitcnt vmcnt(0)" ::: "memory");
    __syncthreads();
    if (threadIdx.x == 0) {
        unsigned* bar = b.bar;
        __builtin_amdgcn_s_waitcnt(0);
        unsigned nloc = b.st[0], nx = b.st[1];
        if (nloc == 0u) { xcd_barrier_complete(bar, b.x, nloc, nx); b.st[0] = nloc; b.st[1] = nx; }
        const unsigned old = xb_add(&bar[XB_XSUB(b.x)], 1u);
        const unsigned gen = old / nloc;
        if (old + 1u == (gen + 1u) * nloc) {
            __builtin_amdgcn_fence(__ATOMIC_RELEASE, "agent");
            asm volatile("s_waitcnt vmcnt(0)" ::: "memory");
            const unsigned og = xb_add(&bar[XB_TOP], 1u);
            const unsigned tg = og / nx;
            if (og + 1u == (tg + 1u) * nx) xb_add(&bar[XB_TOPGEN], 1u);
            else XB_SPIN(xb_ld(&bar[XB_TOPGEN]) == tg, bar);
            __builtin_amdgcn_fence(__ATOMIC_ACQUIRE, "agent");
            xb_add(&bar[XB_XGEN(b.x)], 1u);
            asm volatile("s_waitcnt vmcnt(0)" ::: "memory");
        } else {
            XB_SPIN(xb_ld(&bar[XB_XGEN(b.x)]) == gen, bar);
            __builtin_amdgcn_fence(__ATOMIC_ACQUIRE, "agent");
            asm volatile("s_waitcnt vmcnt(0)" ::: "memory");
        }
    }
    __syncthreads();
}

struct Frame {
    LAS unsigned char* lds;
    int tid, lane, wave, G, bid;
    const float *x, *pre_g, *post_g, *w_in, *mu_rkv, *mu_wa, *w0, *w1, *w2, *a0, *a1, *a2, *k_k, *k_a, *r_k, *lnx_g, *lnx_b, *rel_bias, *w_br, *w_ba, *b_merge, *w_out;
    float* out;
    bf16_t *HB, *WIN_T, *WCAT_T, *WOUT_T, *W2T, *A2T, *PA, *PG, *PL, *YCAT, *MERGED, *STATES;
    float *BONUS, *SSP;
    bf16_t* OBF; bf16_t *MD, *ND, *QD; unsigned* queue;
};

__device__ __forceinline__ float wave_sum(float v) {
#pragma unroll
    for (int o = 1; o < 64; o <<= 1) v += __shfl_xor(v, o);
    return v;
}

__device__ __forceinline__ void p0_transpose_item(const float* W, int K, int N, bf16_t* WT, int row_off, LAS float* scr, int item, int lane, const float* mu, float s0, float s1, bool gate_remap = false) {
    const int nblk = N / 32, kb = item / nblk, nb = item % nblk, k0 = 64 * kb, n0 = 32 * nb;
    int d0 = n0; if (gate_remap && n0 >= NPA) { const int g = n0 - NPA, br = g >> 11, j0 = g & 2047; d0 = NPA + 256 * (j0 >> 7) + 128 * br + (j0 & 127); }
    f32x4 v4[8];
#pragma unroll
    for (int i = 0; i < 8; ++i) { const int kk = 8 * i + (lane >> 3); v4[i] = *(const f32x4*)(W + (size_t)(k0 + kk) * N + n0 + (lane & 7) * 4); }
#pragma unroll
    for (int i = 0; i < 8; ++i) { const int kk = 8 * i + (lane >> 3); f32x4 v = v4[i]; if (mu) v = v * (s0 + s1 * mu[k0 + kk]);
        LAS float* d = scr + kk * 33 + (lane & 7) * 4; d[0] = v[0]; d[1] = v[1]; d[2] = v[2]; d[3] = v[3]; }
    LDS_WAIT(); asm volatile("" ::: "memory");
    const int c = lane & 7;
#pragma unroll
    for (int j = 0; j < 4; ++j) { const int n = (lane >> 3) + 8 * j; const LAS float* s = scr + (8 * c) * 33 + n;
        u32x4 o; o.x = pk2(s[0 * 33], s[1 * 33]); o.y = pk2(s[2 * 33], s[3 * 33]); o.z = pk2(s[4 * 33], s[5 * 33]); o.w = pk2(s[6 * 33], s[7 * 33]);
        *(u32x4*)(WT + (size_t)(row_off + d0 + n) * K + k0 + 8 * c) = o; }
    LDS_WAIT(); asm volatile("" ::: "memory");
}
__device__ __forceinline__ void p0_prologue(Frame& F) {
    LAS float* scr = (LAS float*)(F.lds + F.wave * 16384);
    const int gw = F.bid * NWAVES + F.wave, NGW = F.G * NWAVES;
    constexpr int I_IN = (DM / 64) * (NPA + NPG) / 32, I_L = (DM / 64) * (64 / 32), I_BR = (DBR / 64) * (DM / 32), I_OUT = (DM / 64) * (DM / 32), I_W2 = (64 / 64) * (DBR / 32);
    constexpr int NITEMS = I_IN + 4 * I_L + 2 * I_BR + I_OUT + 2 * I_W2;
    for (int it = gw; it < NITEMS; it += NGW) {
        int r = it;
        if (r < I_IN) { p0_transpose_item(F.w_in, DM, NPA + NPG, F.WIN_T, 0, scr, r, F.lane, nullptr, 1.f, 0.f, true); continue; } r -= I_IN;
        if (r < I_L) { p0_transpose_item(F.w1, DM, 64, F.WIN_T, NPA + NPG + 0, scr, r, F.lane, F.mu_wa, 1.f, -1.f); continue; } r -= I_L;
        if (r < I_L) { p0_transpose_item(F.w1, DM, 64, F.WIN_T, NPA + NPG + 64, scr, r, F.lane, F.mu_wa, 0.f, 1.f); continue; } r -= I_L;
        if (r < I_L) { p0_transpose_item(F.a1, DM, 64, F.WIN_T, NPA + NPG + 128, scr, r, F.lane, F.mu_wa + DM, 1.f, -1.f); continue; } r -= I_L;
        if (r < I_L) { p0_transpose_item(F.a1, DM, 64, F.WIN_T, NPA + NPG + 192, scr, r, F.lane, F.mu_wa + DM, 0.f, 1.f); continue; } r -= I_L;
        if (r < I_BR) { p0_transpose_item(F.w_br, DBR, DM, F.WCAT_T, 0, scr, r, F.lane, nullptr, 1.f, 0.f); continue; } r -= I_BR;
        if (r < I_BR) { p0_transpose_item(F.w_ba, DBR, DM, F.WCAT_T, DM, scr, r, F.lane, nullptr, 1.f, 0.f); continue; } r -= I_BR;
        if (r < I_OUT) { p0_transpose_item(F.w_out, DM, DM, F.WOUT_T, 0, scr, r, F.lane, nullptr, 1.f, 0.f); continue; } r -= I_OUT;
        if (r < I_W2) { p0_transpose_item(F.w2, 64, DBR, F.W2T, 0, scr, r, F.lane, nullptr, 1.f, 0.f); continue; } r -= I_W2;
        p0_transpose_item(F.a2, 64, DBR, F.A2T, 0, scr, r, F.lane, nullptr, 1.f, 0.f);
    }
    for (int m = gw; m < M; m += 2 * NGW) {
        const int m2 = (m + NGW < M) ? m + NGW : m;
        const f32x4* xr = (const f32x4*)(F.x + (size_t)m * DM) + F.lane; const f32x4* xr2 = (const f32x4*)(F.x + (size_t)m2 * DM) + F.lane; const f32x4* gr = (const f32x4*)F.pre_g + F.lane;
        f32x4 v[8], w[8]; float s = 0.f, s2 = 0.f;
#pragma unroll
        for (int j = 0; j < 8; ++j) { v[j] = xr[64 * j]; w[j] = xr2[64 * j]; }
#pragma unroll
        for (int j = 0; j < 8; ++j) { s += (v[j].x * v[j].x + v[j].y * v[j].y) + (v[j].z * v[j].z + v[j].w * v[j].w); s2 += (w[j].x * w[j].x + w[j].y * w[j].y) + (w[j].z * w[j].z + w[j].w * w[j].w); }
        const float rstd = 1.0f / sqrtf(wave_sum(s) * (1.f / DM) + NORM_EPS), rstd2 = 1.0f / sqrtf(wave_sum(s2) * (1.f / DM) + NORM_EPS);
        u32x2* o8 = (u32x2*)(F.HB + (size_t)m * DM) + F.lane; u32x2* o82 = (u32x2*)(F.HB + (size_t)m2 * DM) + F.lane;
#pragma unroll
        for (int j = 0; j < 8; ++j) { const f32x4 g = gr[64 * j]; u32x2 a; a.x = pk2(v[j].x * rstd * g.x, v[j].y * rstd * g.y); a.y = pk2(v[j].z * rstd * g.z, v[j].w * rstd * g.w); o8[64 * j] = a;
            u32x2 c; c.x = pk2(w[j].x * rstd2 * g.x, w[j].y * rstd2 * g.y); c.y = pk2(w[j].z * rstd2 * g.z, w[j].w * rstd2 * g.w); o82[64 * j] = c; }
    }
}

constexpr int LSTR = 72;
constexpr int SLOT = 64 * LSTR * 2;
__device__ __forceinline__ f32x4 mm16(const LAS bf16_t* A, int m0, const LAS bf16_t* Bt, int n0, f32x4 acc, int fr, int fq) {
#pragma unroll
    for (int ks = 0; ks < 2; ++ks) {
        const bf16x8 a = *(const LAS bf16x8*)(A + (m0 + fr) * LSTR + ks * 32 + fq * 8);
        const bf16x8 b = *(const LAS bf16x8*)(Bt + (n0 + fr) * LSTR + ks * 32 + fq * 8);
        acc = __builtin_amdgcn_mfma_f32_16x16x32_bf16(a, b, acc, 0, 0, 0);
    }
    return acc;
}

typedef short v4i16_t __attribute__((ext_vector_type(4)));
__device__ __forceinline__ s16x4 tr4(const LAS bf16_t* p) { return __builtin_bit_cast(s16x4, __builtin_amdgcn_ds_read_tr16_b64_v4i16((LAS v4i16_t*)p)); }
__device__ __forceinline__ s16x4 frag_tr16(const LAS bf16_t* X, int k0, int n0, int lane) {
    const int g = lane >> 4, q = (lane & 15) >> 2, p = lane & 3;
    return tr4(X + (k0 + 4 * g + q) * LSTR + n0 + 4 * p);
}
__device__ __forceinline__ bf16x8 frag_tr32(const LAS bf16_t* X, int k0, int n0, int lane) {
    const int g = lane >> 4, q = (lane & 15) >> 2, p = lane & 3;
    const s16x4 lo = tr4(X + (k0 + 8 * g + q) * LSTR + n0 + 4 * p), hi = tr4(X + (k0 + 8 * g + 4 + q) * LSTR + n0 + 4 * p);
    return (bf16x8){lo[0], lo[1], lo[2], lo[3], hi[0], hi[1], hi[2], hi[3]};
}

constexpr int P2_GRP_BYTES = 6 * SLOT + 20 * 64 * 16;
struct KVRegs { u32x4 k0, k1, v0, v1; };
__device__ __forceinline__ void kv_load(KVRegs& R, const bf16_t* p, int key0, int d80, int key1, int d81) {
    R.k0 = *(const u32x4*)(p + (size_t)key0 * NPA + PA_KA + d80); R.k1 = *(const u32x4*)(p + (size_t)key1 * NPA + PA_KA + d81);
    R.v0 = *(const u32x4*)(p + (size_t)key0 * NPA + PA_VA + d80); R.v1 = *(const u32x4*)(p + (size_t)key1 * NPA + PA_VA + d81);
}
__device__ __forceinline__ void kv_store(const KVRegs& R, LAS unsigned char* kvb, int key0, int d80, int key1, int d81) {
    LAS bf16_t* Ks = (LAS bf16_t*)kvb; LAS bf16_t* Vs = (LAS bf16_t*)(kvb + SLOT);
    *(LAS u32x4*)(Ks + key0 * LSTR + d80) = R.k0; *(LAS u32x4*)(Ks + key1 * LSTR + d81) = R.k1; *(LAS u32x4*)(Vs + key0 * LSTR + d80) = R.v0; *(LAS u32x4*)(Vs + key1 * LSTR + d81) = R.v1;
}
constexpr int P2_CPI = 2, P2_NITEMS = BATCH * (NH / 2) * (NCHUNK / P2_CPI);
__device__ __forceinline__ void p2_advance(int cr, int& ci, int& j) { if (j == 8) { ++ci; const int nc = cr * P2_CPI + ci; j = (nc >= 8) ? 0 : 8 - nc; } else ++j; }
__device__ __forceinline__ void p2_attention(Frame& F) {
    const int tid = F.tid, lane = F.lane, wave = F.wave, fr = lane & 15, fq = lane >> 4;
    const int grp = wave >> 2, wq = wave & 3, tg = tid & 255;
    LAS unsigned char* gbase = F.lds + grp * P2_GRP_BYTES;
    LAS f32x4* Tb = (LAS f32x4*)(gbase + 6 * SLOT);
    const int key0 = (tg * 2) >> 3, d80 = ((tg * 2) & 7) * 8, key1 = (tg * 2 + 1) >> 3, d81 = ((tg * 2 + 1) & 7) * 8;
    const float L2E = 1.4426950408889634f;
    volatile LAS int* qslot = (volatile LAS int*)(F.lds + MISC_OFF + 64);
    int hp_prev = -1;
    for (;;) {
        __syncthreads();
        if (tid == 0) *qslot = (int)__hip_atomic_fetch_add(F.queue, 1u, __ATOMIC_RELAXED, __HIP_MEMORY_SCOPE_AGENT);
        __syncthreads();
        const int vb = *qslot;
        if (vb >= P2_NITEMS) break;
        constexpr int NR = NCHUNK / P2_CPI; const int b = vb / (NR * 8), hp = (vb / NR) & 7, cr = vb % NR, h = hp * 2 + grp;
        if (hp != hp_prev) for (int e = tg; e < 20 * 64; e += 256) { const int u = e / 64 - 3, ln = e & 63, lfr = ln & 15, lfq = ln >> 4; f32x4 t4;
#pragma unroll
            for (int r = 0; r < 4; ++r) { int rel = 16 * u + (lfr - 4 * lfq - r); rel = rel < -256 ? -256 : (rel > 256 ? 256 : rel); t4[r] = F.rel_bias[h * 513 + rel + 256]; }
            Tb[e] = t4; }
        hp_prev = hp;
        const float bcst = F.rel_bias[h * 513 + 512];
        const bf16_t* kvbase = F.PA + (size_t)b * SEQ * NPA + h * 64;
        int ci = 0, j = (cr * P2_CPI >= 8) ? 0 : 8 - cr * P2_CPI;
        int lci = ci, lj = j;
        KVRegs RA, RB;
        kv_load(RA, kvbase + (size_t)(cr * P2_CPI + lci - 8 + lj) * 64 * NPA, key0, d80, key1, d81); p2_advance(cr, lci, lj);
        kv_store(RA, gbase, key0, d80, key1, d81);
        kv_load(RA, kvbase + (size_t)(cr * P2_CPI + lci - 8 + lj) * 64 * NPA, key0, d80, key1, d81); p2_advance(cr, lci, lj);
        __syncthreads();
        size_t mrow0 = (size_t)b * SEQ + (size_t)(cr * P2_CPI) * 64;
        bf16x8 qa[2];
#pragma unroll
        for (int ks = 0; ks < 2; ++ks) qa[ks] = *(const bf16x8*)(F.PA + (mrow0 + 16 * wq + fr) * NPA + PA_Q + h * 64 + ks * 32 + fq * 8);
        float mrun = -1e30f, lsum = 0.f; f32x4 o[4];
#pragma unroll
        for (int dt = 0; dt < 4; ++dt) o[dt] = (f32x4){0.f, 0.f, 0.f, 0.f};
        int bufc = 0;
#define P2_STEP(RW, RL) { \
            const bool more1 = (ci < P2_CPI - 1) || (j < 8);                           \
            const bool more2 = lci < P2_CPI;                                           \
            if (more2) { kv_load(RL, kvbase + (size_t)(cr * P2_CPI + lci - 8 + lj) * 64 * NPA, key0, d80, key1, d81); p2_advance(cr, lci, lj); } \
            const LAS bf16_t* Ks = (const LAS bf16_t*)(gbase + bufc * 2 * SLOT); const LAS bf16_t* Vs = (const LAS bf16_t*)(gbase + bufc * 2 * SLOT + SLOT); \
            f32x4 s[4]; \
            _Pragma("unroll") for (int nt = 0; nt < 4; ++nt) { const int u = wq - nt + 4 * (8 - j); \
                s[nt] = (u >= 17) ? (f32x4){bcst, bcst, bcst, bcst} : Tb[(u + 3) * 64 + lane]; \
                _Pragma("unroll") for (int ks = 0; ks < 2; ++ks) { const bf16x8 kb = *(const LAS bf16x8*)(Ks + (16 * nt + fr) * LSTR + ks * 32 + fq * 8); \
                    s[nt] = __builtin_amdgcn_mfma_f32_16x16x32_bf16(kb, qa[ks], s[nt], 0, 0, 0); } } \
            float rmax = fmaxf(fmaxf(s[0][0], s[0][1]), fmaxf(s[0][2], s[0][3])); \
            _Pragma("unroll") for (int nt = 1; nt < 4; ++nt) rmax = fmaxf(rmax, fmaxf(fmaxf(s[nt][0], s[nt][1]), fmaxf(s[nt][2], s[nt][3]))); \
            rmax = fmaxf(rmax, __shfl_xor(rmax, 16)); rmax = fmaxf(rmax, __shfl_xor(rmax, 32)); \
            const float mn = fmaxf(mrun, rmax); const float alpha = __builtin_amdgcn_exp2f((mrun - mn) * L2E); mrun = mn; \
            const float mnl = mn * L2E; float ps = 0.f; \
            _Pragma("unroll") for (int nt = 0; nt < 4; ++nt) _Pragma("unroll") for (int r = 0; r < 4; ++r) { s[nt][r] = __builtin_amdgcn_exp2f(fmaf(s[nt][r], L2E, -mnl)); ps += s[nt][r]; } \
            lsum = lsum * alpha + ps; \
            _Pragma("unroll") for (int dt = 0; dt < 4; ++dt) o[dt] = o[dt] * alpha; \
            bf16x8 pb[2]; \
            _Pragma("unroll") for (int ks = 0; ks < 2; ++ks) { u32x4 w; w.x = pk2(s[2 * ks][0], s[2 * ks][1]); w.y = pk2(s[2 * ks][2], s[2 * ks][3]); w.z = pk2(s[2 * ks + 1][0], s[2 * ks + 1][1]); w.w = pk2(s[2 * ks + 1][2], s[2 * ks + 1][3]); pb[ks] = __builtin_bit_cast(bf16x8, w); } \
            _Pragma("unroll") for (int dt = 0; dt < 4; ++dt) _Pragma("unroll") for (int ks = 0; ks < 2; ++ks) { const s16x4 v0 = frag_tr16(Vs, 32 * ks, 16 * dt, lane), v1 = frag_tr16(Vs, 32 * ks + 16, 16 * dt, lane); \
                    const bf16x8 va = (bf16x8){v0[0], v0[1], v0[2], v0[3], v1[0], v1[1], v1[2], v1[3]}; \
                    o[dt] = __builtin_amdgcn_mfma_f32_16x16x32_bf16(va, pb[ks], o[dt], 0, 0, 0); } \
            if (j == 8) { \
                float l = lsum; l += __shfl_xor(l, 16); l += __shfl_xor(l, 32); \
                const float inv = 1.0f / l; const size_t m = mrow0 + 16 * wq + fr; \
                _Pragma("unroll") for (int dt = 0; dt < 4; ++dt) { const int col = h * 64 + 16 * dt + 4 * fq; \
                    const u32x2 zw = *(const u32x2*)(F.PA + m * NPA + PA_ZA + col); \
                    const float z0 = bflo(zw.x), z1 = bfhi(zw.x), z2 = bflo(zw.y), z3 = bfhi(zw.y); \
                    u32x2 yw; yw.x = pk2(o[dt][0] * inv * z0 * sigmoidf_(z0), o[dt][1] * inv * z1 * sigmoidf_(z1)); yw.y = pk2(o[dt][2] * inv * z2 * sigmoidf_(z2), o[dt][3] * inv * z3 * sigmoidf_(z3)); \
                    *(u32x2*)(F.YCAT + ((size_t)M + m) * DBR + col) = yw; } \
                if (more1) { \
                    mrow0 = (size_t)b * SEQ + (size_t)(cr * P2_CPI + ci + 1) * 64; \
                    _Pragma("unroll") for (int ks = 0; ks < 2; ++ks) qa[ks] = *(const bf16x8*)(F.PA + (mrow0 + 16 * wq + fr) * NPA + PA_Q + h * 64 + ks * 32 + fq * 8); \
                    mrun = -1e30f; lsum = 0.f; \
                    _Pragma("unroll") for (int dt = 0; dt < 4; ++dt) o[dt] = (f32x4){0.f, 0.f, 0.f, 0.f}; \
                } \
            } \
            const int bufn = (bufc == 2) ? 0 : bufc + 1; \
            if (more1) kv_store(RW, gbase + bufn * 2 * SLOT, key0, d80, key1, d81); \
            __syncthreads(); \
            if (!more1) break; \
            p2_advance(cr, ci, j); bufc = bufn; }
        for (;;) {
            P2_STEP(RA, RB)
            P2_STEP(RB, RA)
        }
#undef P2_STEP
    }
}

constexpr int FSTR = 68;
constexpr int DSTR = 24;
__device__ __forceinline__ f32x4 mfma16(s16x4 a, s16x4 b, f32x4 c) {
    const bf16x8 a8 = (bf16x8){a[0], a[1], a[2], a[3], 0, 0, 0, 0}, b8 = (bf16x8){b[0], b[1], b[2], b[3], 0, 0, 0, 0};
    return __builtin_amdgcn_mfma_f32_16x16x32_bf16(a8, b8, c, 0, 0, 0); }
__device__ __forceinline__ s16x4 cvt_hi(const f32x4 v) { u32x2 w; w.x = pk2(v[0], v[1]); w.y = pk2(v[2], v[3]); return __builtin_bit_cast(s16x4, w); }
__device__ __forceinline__ s16x4 cvt_lo(const f32x4 v, const s16x4 hi) { const u32x2 h = __builtin_bit_cast(u32x2, hi);
    u32x2 w; w.x = pk2(v[0] - bflo(h.x), v[1] - bfhi(h.x)); w.y = pk2(v[2] - bflo(h.y), v[3] - bfhi(h.y)); return __builtin_bit_cast(s16x4, w); }
struct P3Loads { u32x4 w2, a2, pr, pk, pv, qr, qk, qv; f32x4 mur[2], muk[2], muv[2], kkp[2], kap[2], rkp[2]; };
__device__ __forceinline__ void p3_load(Frame& F, P3Loads& G, int h, size_t m, int t_e, int c8, bool hasprev) {
    const u32x4 zero4 = (u32x4){0u, 0u, 0u, 0u};
    G.w2 = *(const u32x4*)(F.W2T + (size_t)(h * 64 + t_e) * 64 + c8); G.a2 = *(const u32x4*)(F.A2T + (size_t)(h * 64 + t_e) * 64 + c8);
    const bf16_t* rowp = F.PA + m * NPA + h * 64 + c8;
    G.pr = *(const u32x4*)(rowp + PA_R); G.pk = *(const u32x4*)(rowp + PA_K); G.pv = *(const u32x4*)(rowp + PA_V);
    G.qr = hasprev ? *(const u32x4*)(rowp - NPA + PA_R) : zero4; G.qk = hasprev ? *(const u32x4*)(rowp - NPA + PA_K) : zero4; G.qv = hasprev ? *(const u32x4*)(rowp - NPA + PA_V) : zero4;
    const int ch0 = h * 64 + c8;
#pragma unroll
    for (int q = 0; q < 2; ++q) { G.mur[q] = *(const f32x4*)(F.mu_rkv + ch0 + 4 * q); G.muk[q] = *(const f32x4*)(F.mu_rkv + DBR + ch0 + 4 * q); G.muv[q] = *(const f32x4*)(F.mu_rkv + 2 * DBR + ch0 + 4 * q);
        G.kkp[q] = *(const f32x4*)(F.k_k + ch0 + 4 * q); G.kap[q] = *(const f32x4*)(F.k_a + ch0 + 4 * q); G.rkp[q] = *(const f32x4*)(F.r_k + ch0 + 4 * q); }
}
__device__ __forceinline__ void p3_prep(Frame& F) {
    const int wave = F.wave;
    LAS unsigned char* L = F.lds;
    LAS bf16_t* X_A = (LAS bf16_t*)(L + 0 * SLOT);
    LAS bf16_t* X_B = (LAS bf16_t*)(L + 1 * SLOT);
    LAS bf16_t* X_K = (LAS bf16_t*)(L + 2 * SLOT);
    LAS bf16_t* X_R = (LAS bf16_t*)(L + 3 * SLOT);
    LAS bf16_t* X_V = (LAS bf16_t*)(L + 4 * SLOT);
    LAS bf16_t* S_TW = (LAS bf16_t*)(L + 5 * SLOT);
    LAS bf16_t* S_TA = (LAS bf16_t*)(L + 6 * SLOT);
    LAS bf16_t* A_AB = (LAS bf16_t*)(L + 7 * SLOT);
    LAS bf16_t* A_AK = (LAS bf16_t*)(L + 8 * SLOT);
    LAS bf16_t* A_RB = (LAS bf16_t*)(L + 9 * SLOT);
    LAS bf16_t* A_RK = (LAS bf16_t*)(L + 10 * SLOT);
    LAS bf16_t* DB = (LAS bf16_t*)(L + 11 * SLOT);
    LAS float* CLf = (LAS float*)(L + 12 * SLOT);
    LAS float* Af = CLf + 64 * FSTR;
    LAS float* GL = Af + 64 * FSTR;
    LAS bf16_t* ST_Q = A_AK; LAS bf16_t* ST_Y = X_A; LAS bf16_t* ST_M = X_V; LAS bf16_t* ST_N = (LAS bf16_t*)CLf;
    const int mt = wave >> 1, ntb = (wave & 1) * 2;
    for (int vb = F.bid; vb < 256; vb += F.G) {
        const int b = vb >> 7, c = vb & 127; const size_t mrow0 = (size_t)b * SEQ + (size_t)c * 64;
        {
            const int t_e = F.tid >> 3, c8 = (F.tid & 7) * 8; const size_t m = mrow0 + t_e; const bool hasprev = (c > 0) || (t_e > 0);
            const u32x4 zero4 = (u32x4){0u, 0u, 0u, 0u};
            float sw[8], sa[8];
#pragma unroll
            for (int e = 0; e < 8; ++e) { sw[e] = 0.f; sa[e] = 0.f; }
#pragma unroll
            for (int q = 0; q < 4; ++q) { const bf16_t* slab = F.PL + (size_t)q * ((size_t)M * NPL);
                const u32x4 g_law = *(const u32x4*)(slab + m * NPL + 0 + c8), g_laa = *(const u32x4*)(slab + m * NPL + 128 + c8);
                const u32x4 g_lbw = hasprev ? *(const u32x4*)(slab + (m - 1) * NPL + 64 + c8) : zero4, g_lba = hasprev ? *(const u32x4*)(slab + (m - 1) * NPL + 192 + c8) : zero4;
                float law[8], laa[8], lbw[8], lba[8];
                unpack8(g_law, law); unpack8(g_laa, laa); unpack8(g_lbw, lbw); unpack8(g_lba, lba);
#pragma unroll
                for (int e = 0; e < 8; ++e) { sw[e] += law[e] + lbw[e]; sa[e] += laa[e] + lba[e]; } }
            float tw[8], ta[8];
#pragma unroll
            for (int e = 0; e < 8; ++e) { tw[e] = tanhf_(sw[e]); ta[e] = sa[e]; }
            __syncthreads();
            *(LAS u32x4*)(S_TW + t_e * LSTR + c8) = pack8(tw); *(LAS u32x4*)(S_TA + t_e * LSTR + c8) = pack8(ta);
        }
        P3Loads G; p3_load(F, G, 0, mrow0 + (F.tid >> 3), F.tid >> 3, (F.tid & 7) * 8, (c > 0) || ((F.tid >> 3) > 0));
        for (int h = 0; h < NH; ++h) {
            int tid = F.tid; asm volatile("" : "+v"(tid));
            const int lane = tid & 63, fr = lane & 15, fq = lane >> 4;
            const int t_e = tid >> 3, c8 = (tid & 7) * 8;
            const size_t m = mrow0 + t_e; const bool hasprev = (c > 0) || (t_e > 0);
            const u32x4 g_w2 = G.w2, g_a2 = G.a2, g_pr = G.pr, g_pk = G.pk, g_pv = G.pv, g_qr = G.qr, g_qk = G.qk, g_qv = G.qv;
            float mur[8], muk[8], muv[8], kkp[8], kap[8], rkp[8];
#pragma unroll
            for (int e = 0; e < 8; ++e) { mur[e] = G.mur[e >> 2][e & 3]; muk[e] = G.muk[e >> 2][e & 3]; muv[e] = G.muv[e >> 2][e & 3]; kkp[e] = G.kkp[e >> 2][e & 3]; kap[e] = G.kap[e >> 2][e & 3]; rkp[e] = G.rkp[e >> 2][e & 3]; }
            __syncthreads();
            *(LAS u32x4*)(A_AB + t_e * LSTR + c8) = g_w2; *(LAS u32x4*)(A_AK + t_e * LSTR + c8) = g_a2;
            __syncthreads();
#pragma unroll
            for (int q = 0; q < 2; ++q) { const int nt = ntb + q; const int ch = 16 * nt + fr;
                f32x4 dw = (f32x4){0.f, 0.f, 0.f, 0.f}, da = (f32x4){0.f, 0.f, 0.f, 0.f};
#pragma unroll
                for (int ks = 0; ks < 2; ++ks) {
                    const bf16x8 aw = *(const LAS bf16x8*)(S_TW + (16 * mt + fr) * LSTR + ks * 32 + fq * 8), aa = *(const LAS bf16x8*)(S_TA + (16 * mt + fr) * LSTR + ks * 32 + fq * 8);
                    const bf16x8 bw = *(const LAS bf16x8*)(A_AB + ch * LSTR + ks * 32 + fq * 8), ba = *(const LAS bf16x8*)(A_AK + ch * LSTR + ks * 32 + fq * 8);
                    dw = __builtin_amdgcn_mfma_f32_16x16x32_bf16(aw, bw, dw, 0, 0, 0); da = __builtin_amdgcn_mfma_f32_16x16x32_bf16(aa, ba, da, 0, 0, 0); }
                const float w0v = F.w0[h * 64 + ch], a0v = F.a0[h * 64 + ch];
#pragma unroll
                for (int r = 0; r < 4; ++r) { const int t = 16 * mt + 4 * fq + r;
                    CLf[t * FSTR + ch] = -DECAY_SCALE * sigmoidf_(w0v + dw[r]); Af[t * FSTR + ch] = sigmoidf_(a0v + da[r]); } }
            __syncthreads();
#pragma unroll
            for (int q = 0; q < 8; ++q) { const int ch = wave * 8 + q; float xv = CLf[lane * FSTR + ch];
#pragma unroll
                for (int off = 1; off < 64; off <<= 1) { const float y = __shfl_up(xv, off); if (lane >= off) xv += y; }
                CLf[lane * FSTR + ch] = xv; }
            __syncthreads();
            {
                float pr[8], pk[8], pv[8], qr[8], qk[8], qv[8];
                unpack8(g_pr, pr); unpack8(g_pk, pk); unpack8(g_pv, pv); unpack8(g_qr, qr); unpack8(g_qk, qk); unpack8(g_qv, qv);
                float rr[8], kk[8], vv[8], kn[8], av[8], cl[8], clp[8]; float nrm = 0.f;
#pragma unroll
                for (int e = 0; e < 8; ++e) {
                    rr[e] = pr[e] + (qr[e] - pr[e]) * mur[e]; kk[e] = pk[e] + (qk[e] - pk[e]) * muk[e]; vv[e] = pv[e] + (qv[e] - pv[e]) * muv[e];
                    kn[e] = kk[e] * kkp[e]; nrm += kn[e] * kn[e];
                    av[e] = Af[t_e * FSTR + c8 + e]; cl[e] = CLf[t_e * FSTR + c8 + e]; clp[e] = (t_e > 0) ? CLf[(t_e - 1) * FSTR + c8 + e] : 0.f; }
                nrm += __shfl_xor(nrm, 1); nrm += __shfl_xor(nrm, 2); nrm += __shfl_xor(nrm, 4);
                const float inrm = 1.0f / fmaxf(sqrtf(nrm), 1e-12f);
                float at_[8], bt_[8], kt_[8], rt_[8]; float bon = 0.f;
#pragma unroll
                for (int e = 0; e < 8; ++e) {
                    const float kkn = kn[e] * inrm; const float kmod = kk[e] * (1.0f + (av[e] - 1.0f) * kap[e]);
                    const float gin = __expf(cl[e]), gex = __expf(clp[e]), ginv = __expf(-cl[e]);
                    at_[e] = -kkn * gex; bt_[e] = kkn * av[e] * ginv; kt_[e] = kmod * ginv; rt_[e] = rr[e] * gin;
                    bon += rr[e] * kmod * rkp[e]; }
                bon += __shfl_xor(bon, 1); bon += __shfl_xor(bon, 2); bon += __shfl_xor(bon, 4);
                if ((tid & 7) == 0) F.BONUS[m * NH + h] = bon;
                if (t_e == 63) {
#pragma unroll
                    for (int e = 0; e < 8; ++e) GL[c8 + e] = __expf(cl[e]); }
                *(LAS u32x4*)(X_A + t_e * LSTR + c8) = pack8(at_); *(LAS u32x4*)(X_B + t_e * LSTR + c8) = pack8(bt_);
                *(LAS u32x4*)(X_K + t_e * LSTR + c8) = pack8(kt_); *(LAS u32x4*)(X_R + t_e * LSTR + c8) = pack8(rt_);
                *(LAS u32x4*)(X_V + t_e * LSTR + c8) = pack8(vv);
            }
            __syncthreads();
            if (h + 1 < NH) p3_load(F, G, h + 1, m, t_e, c8, hasprev);
#pragma unroll
            for (int q = 0; q < 2; ++q) { const int it = mt, tt = ntb + q; const int t = 16 * tt + fr, i0 = 16 * it + 4 * fq;
                const f32x4 z4 = (f32x4){0.f, 0.f, 0.f, 0.f};
                const f32x4 d_ab = mm16(X_B, 16 * it, X_A, 16 * tt, z4, fr, fq), d_ak = mm16(X_K, 16 * it, X_A, 16 * tt, z4, fr, fq);
                const f32x4 d_rb = mm16(X_B, 16 * it, X_R, 16 * tt, z4, fr, fq), d_rk = mm16(X_K, 16 * it, X_R, 16 * tt, z4, fr, fq);
                f32x4 e_ab, e_ak, e_rb, e_rk;
#pragma unroll
                for (int r = 0; r < 4; ++r) { const int i = i0 + r; e_ab[r] = (i < t) ? d_ab[r] : 0.f; e_ak[r] = (i < t) ? d_ak[r] : 0.f; e_rb[r] = (i <= t) ? d_rb[r] : 0.f; e_rk[r] = (i <= t) ? d_rk[r] : 0.f; }
                *(LAS s16x4*)(A_AB + t * LSTR + i0) = cvt_hi(e_ab); *(LAS s16x4*)(A_AK + t * LSTR + i0) = cvt_hi(e_ak);
                *(LAS s16x4*)(A_RB + t * LSTR + i0) = cvt_hi(e_rb); *(LAS s16x4*)(A_RK + t * LSTR + i0) = cvt_hi(e_rk); }
            __syncthreads();
            f32x4 rhs[4]; bf16x8 vf[2];
            const int ct = wave & 3;
            if (wave < 4) {
                const s16x4 a_t = *(const LAS s16x4*)(A_AB + (16 * wave + fr) * LSTR + 16 * wave + 4 * fq);
                const s16x4 a_c = frag_tr16(A_AB, 16 * wave, 16 * wave, lane);
                const f32x4 z4 = (f32x4){0.f, 0.f, 0.f, 0.f};
                f32x4 iden;
#pragma unroll
                for (int r = 0; r < 4; ++r) iden[r] = (4 * fq + r == fr) ? 1.0f : 0.0f;
                const u32x2 atw = __builtin_bit_cast(u32x2, a_t), acw = __builtin_bit_cast(u32x2, a_c);
                f32x4 Sc = iden + (f32x4){bflo(acw.x), bfhi(acw.x), bflo(acw.y), bfhi(acw.y)}, St = iden + (f32x4){bflo(atw.x), bfhi(atw.x), bflo(atw.y), bfhi(atw.y)};
                f32x4 Pc = mfma16(a_t, a_c, z4), Pt = mfma16(a_c, a_t, z4);
#pragma unroll
                for (int lvl = 0; lvl < 3; ++lvl) {
                    const s16x4 pt = cvt_hi(Pt), pc = cvt_hi(Pc);
                    const s16x4 sh = cvt_hi(Sc), sl = cvt_lo(Sc, sh);
                    const f32x4 Sc2 = mfma16(pt, sl, mfma16(pt, sh, Sc)), St2 = mfma16(sl, pt, mfma16(sh, pt, St));
                    Sc = Sc2; St = St2;
                    if (lvl < 2) { const f32x4 Pc2 = mfma16(pt, pc, z4), Pt2 = mfma16(pc, pt, z4); Pc = Pc2; Pt = Pt2; }
                }
                *(LAS s16x4*)(DB + (16 * wave + fr) * DSTR + 4 * fq) = cvt_hi(St);
#pragma unroll
                for (int bi = 0; bi < 4; ++bi)
#pragma unroll
                    for (int r = 0; r < 4; ++r) rhs[bi][r] = bf2f(X_A[(16 * bi + 4 * fq + r) * LSTR + 16 * ct + fr]);
                vf[0] = (bf16x8){0, 0, 0, 0, 0, 0, 0, 0}; vf[1] = vf[0];
            } else {
#pragma unroll
                for (int ks = 0; ks < 2; ++ks) vf[ks] = frag_tr32(X_V, ks * 32, 16 * ct, lane);
#pragma unroll
                for (int bi = 0; bi < 4; ++bi) { rhs[bi] = (f32x4){0.f, 0.f, 0.f, 0.f};
#pragma unroll
                    for (int ks = 0; ks < 2; ++ks) rhs[bi] = __builtin_amdgcn_mfma_f32_16x16x32_bf16(*(const LAS bf16x8*)(A_AK + (16 * bi + fr) * LSTR + ks * 32 + fq * 8), vf[ks], rhs[bi], 0, 0, 0); }
            }
            __syncthreads();
            s16x4 xb[4];
#pragma unroll
            for (int bi = 0; bi < 4; ++bi) {
                f32x4 acc = rhs[bi];
#pragma unroll
                for (int bj = 0; bj < 4; ++bj) if (bj < bi) acc = mfma16(*(const LAS s16x4*)(A_AB + (16 * bi + fr) * LSTR + 16 * bj + 4 * fq), xb[bj], acc);
                const s16x4 hi = cvt_hi(acc), lo = cvt_lo(acc, hi); const s16x4 df = *(const LAS s16x4*)(DB + (16 * bi + fr) * DSTR + 4 * fq);
                f32x4 x = mfma16(df, hi, (f32x4){0.f, 0.f, 0.f, 0.f}); x = mfma16(df, lo, x);
                xb[bi] = cvt_hi(x);
            }
            const int col = 16 * ct + fr; const int c4 = 16 * ct + 4 * fq;
#pragma unroll
            for (int bi = 0; bi < 4; ++bi) {
                f32x4 acc; const int t = 16 * bi + fr;
                if (wave < 4) { const u32x2 rw = *(const LAS u32x2*)(X_R + t * LSTR + c4); acc[0] = bflo(rw.x); acc[1] = bfhi(rw.x); acc[2] = bflo(rw.y); acc[3] = bfhi(rw.y); }
                else {
                    acc = (f32x4){0.f, 0.f, 0.f, 0.f};
#pragma unroll
                    for (int ks = 0; ks < 2; ++ks) acc = __builtin_amdgcn_mfma_f32_16x16x32_bf16(vf[ks], *(const LAS bf16x8*)(A_RK + t * LSTR + ks * 32 + fq * 8), acc, 0, 0, 0);
                }
#pragma unroll
                for (int bj = 0; bj < 4; ++bj) if (bj <= bi) acc = mfma16(xb[bj], *(const LAS s16x4*)(A_RB + t * LSTR + 16 * bj + 4 * fq), acc);
                const s16x4 o4 = cvt_hi(acc);
                if (wave < 4) *(LAS s16x4*)(ST_Q + t * LSTR + c4) = o4; else *(LAS s16x4*)(ST_Y + t * LSTR + c4) = o4;
            }
#pragma unroll
            for (int mk = 0; mk < 4; ++mk) {
                f32x4 acc = (f32x4){0.f, 0.f, 0.f, 0.f};
                if (wave < 4) {
#pragma unroll
                    for (int bj = 0; bj < 4; ++bj) acc = mfma16(xb[bj], frag_tr16(X_B, 16 * bj, 16 * mk, lane), acc);
                    const int k = 16 * mk + fr; const float gl = GL[k];
#pragma unroll
                    for (int r = 0; r < 4; ++r) acc[r] = gl * (acc[r] + ((k == c4 + r) ? 1.0f : 0.0f));
                    *(LAS s16x4*)(ST_M + k * LSTR + 32 * (ct >> 1) + 8 * fq + 4 * (ct & 1)) = cvt_hi(acc);
                } else {
#pragma unroll
                    for (int ks = 0; ks < 2; ++ks) acc = __builtin_amdgcn_mfma_f32_16x16x32_bf16(frag_tr32(X_K, ks * 32, 16 * mk, lane), vf[ks], acc, 0, 0, 0);
#pragma unroll
                    for (int bj = 0; bj < 4; ++bj) acc = mfma16(frag_tr16(X_B, 16 * bj, 16 * mk, lane), xb[bj], acc);
                    const f32x4 gl4 = *(const LAS f32x4*)(GL + 16 * mk + 4 * fq);
                    acc = acc * gl4;
                    *(LAS s16x4*)(ST_N + col * LSTR + 16 * mk + 4 * fq) = cvt_hi(acc);
                }
            }
            __syncthreads();
            { const size_t mr = mrow0 + t_e;
              const size_t ub = (size_t)((b * NH + h) * NCHUNK + c) * 4096 + t_e * 64 + c8;
              *(u32x4*)(F.QD + ub) = *(const LAS u32x4*)(ST_Q + t_e * LSTR + c8);
              *(u32x4*)(F.YCAT + mr * DBR + h * 64 + c8) = *(const LAS u32x4*)(ST_Y + t_e * LSTR + c8);
              *(u32x4*)(F.MD + ub) = *(const LAS u32x4*)(ST_M + t_e * LSTR + c8);
              *(u32x4*)(F.ND + ub) = *(const LAS u32x4*)(ST_N + t_e * LSTR + c8); }
        }
    }
}

struct ScanBuf { u32x4 m[4][2]; u32x2 nn[4]; };
__device__ __forceinline__ void scan_load(ScanBuf& B, const bf16_t* PA, size_t mrow0, int h, int v, int fr, int fq) {
#pragma unroll
    for (int i = 0; i < 4; ++i) { const bf16_t* mrowp = PA + (mrow0 + 16 * i + fr) * NPA + PA_KA + h * 64;
#pragma unroll
        for (int ks = 0; ks < 2; ++ks) B.m[i][ks] = *(const u32x4*)(mrowp + 32 * ks + 8 * fq);
        B.nn[i] = *(const u32x2*)(PA + (mrow0 + v) * NPA + PA_VA + h * 64 + 16 * i + 4 * fq); }
}
__device__ __forceinline__ void scan_step(f32x4 (&st)[4], const ScanBuf& B, bf16_t* sp, int fq) {
    u32x2 pk[4];
#pragma unroll
    for (int i = 0; i < 4; ++i) { pk[i].x = pk2(st[i][0], st[i][1]); pk[i].y = pk2(st[i][2], st[i][3]); *(u32x2*)(sp + 16 * i + 4 * fq) = pk[i]; }
    bf16x8 bfr[2];
#pragma unroll
    for (int ks = 0; ks < 2; ++ks) { u32x4 w; w.x = pk[2 * ks].x; w.y = pk[2 * ks].y; w.z = pk[2 * ks + 1].x; w.w = pk[2 * ks + 1].y; bfr[ks] = __builtin_bit_cast(bf16x8, w); }
#pragma unroll
    for (int i = 0; i < 4; ++i) { f32x4 n; n[0] = bflo(B.nn[i].x); n[1] = bfhi(B.nn[i].x); n[2] = bflo(B.nn[i].y); n[3] = bfhi(B.nn[i].y);
#pragma unroll
        for (int ks = 0; ks < 2; ++ks) n = __builtin_amdgcn_mfma_f32_16x16x32_bf16(__builtin_bit_cast(bf16x8, B.m[i][ks]), bfr[ks], n, 0, 0, 0);
        st[i] = n; }
}
constexpr int SC_NST = 2;
constexpr int SC_STEP_BYTES = 8192 + 2048, SC_SLOT_BYTES = SC_NST * SC_STEP_BYTES, SC_NSLOT = 6;
constexpr int SC_SO_OFF = SC_NSLOT * SC_SLOT_BYTES, SC_SO_STEP = 16 * LSTR * 2, SC_SO_SLOT = SC_NST * SC_SO_STEP;
__device__ __forceinline__ void scan_dma(Frame& F, int wave, int lane, int it, LAS unsigned char* slot, size_t row0, int h, int vt) {
    const int r8 = lane >> 3, cg = ((lane & 7) ^ r8) * 8;
#pragma unroll
    for (int q = 0; q < 4; ++q) { const int j = (wave - 1) + 5 * q;
        { const int st = j / 10, w10 = j % 10; const size_t ubase = row0;
            const bf16_t* g = (w10 < 8) ? F.MD + ubase + (size_t)(SC_NST * it + st) * 4096 + (8 * w10 + r8) * 64 + cg : F.ND + ubase + (size_t)(SC_NST * it + st) * 4096 + (16 * vt + 8 * (w10 - 8) + r8) * 64 + cg;
            __builtin_amdgcn_global_load_lds((const unsigned*)g, (LAS unsigned*)(slot + st * SC_STEP_BYTES + w10 * 1024), 16, 0, 0); } }
}
__device__ __forceinline__ void scan_flush(int L2, int it, const LAS unsigned char* so, bf16_t* sp0v0) {
#pragma unroll
    for (int st = 0; st < SC_NST; ++st) { const int rr = (L2 >> 3) & 15, ch = L2 & 7;
        *(u32x4*)(sp0v0 + (size_t)(SC_NST * it + st) * 4096 + rr * 64 + ch * 8) = *(const LAS u32x4*)(so + st * SC_SO_STEP + rr * (LSTR * 2) + ch * 16); }
}
__device__ __forceinline__ void p4_scan(Frame& F) {
    const int lane = F.lane, wave = F.wave, fr = lane & 15, fq = lane >> 4;
    constexpr int NIT = NCHUNK / SC_NST;
    for (int vb = F.bid; vb < 128; vb += F.G) {
        const int b = vb >> 6, h = (vb >> 2) & 15, vt = vb & 3;
        const size_t row0 = (size_t)((b * NH + h) * NCHUNK) * 4096;
        const int L = (wave - 1) * 64 + lane;
        bf16_t* sp0v0 = F.STATES + ((size_t)((b * NH + h) * NCHUNK)) * 4096 + (16 * vt) * 64;
        __syncthreads();
        if (wave >= 1 && wave <= 5) {
#pragma unroll
            for (int p = 0; p < 5; ++p) scan_dma(F, wave, lane, p, F.lds + p * SC_SLOT_BYTES, row0, h, vt);
        }
        asm volatile("s_waitcnt vmcnt(0)\n\ts_barrier" ::: "memory");
        f32x4 st[4];
#pragma unroll
        for (int i = 0; i < 4; ++i) st[i] = (f32x4){0.f, 0.f, 0.f, 0.f};
        int cur = 0, cur3 = 0;
        for (int it = 0; it < NIT; ++it) {
            if (wave >= 6) {
                if (it >= 1) scan_flush(L - 320, it - 1, F.lds + SC_SO_OFF + ((cur3 == 0) ? 2 : cur3 - 1) * SC_SO_SLOT, sp0v0);
            } else if (wave >= 1) {
                const int s5 = (cur == 0) ? 5 : cur - 1;
                if (it + 5 < NIT) scan_dma(F, wave, lane, it + 5, F.lds + s5 * SC_SLOT_BYTES, row0, h, vt);
                asm volatile("s_waitcnt vmcnt(16)" ::: "memory");
            } else {
                const LAS unsigned char* slot = F.lds + cur * SC_SLOT_BYTES; LAS unsigned char* so = F.lds + SC_SO_OFF + cur3 * SC_SO_SLOT;
#pragma unroll
                for (int s4 = 0; s4 < SC_NST; ++s4) {
                    u32x2 pk[4];
#pragma unroll
                    for (int i = 0; i < 4; ++i) { pk[i].x = pk2(st[i][0], st[i][1]); pk[i].y = pk2(st[i][2], st[i][3]); *(LAS u32x2*)(so + s4 * SC_SO_STEP + fr * (LSTR * 2) + (16 * i + 4 * fq) * 2) = pk[i]; }
                    bf16x8 bfr[2];
#pragma unroll
                    for (int ks = 0; ks < 2; ++ks) { u32x4 w; w.x = pk[2 * ks].x; w.y = pk[2 * ks].y; w.z = pk[2 * ks + 1].x; w.w = pk[2 * ks + 1].y; bfr[ks] = __builtin_bit_cast(bf16x8, w); }
#pragma unroll
                    for (int i = 0; i < 4; ++i) {
                        const u32x2 nn = *(const LAS u32x2*)(slot + s4 * SC_STEP_BYTES + 8192 + fr * 128 + (((2 * i + (fq >> 1)) ^ (fr & 7)) * 16) + (fq & 1) * 8);
                        f32x4 n; n[0] = bflo(nn.x); n[1] = bfhi(nn.x); n[2] = bflo(nn.y); n[3] = bfhi(nn.y);
#pragma unroll
                        for (int ks = 0; ks < 2; ++ks) { const u32x4 mf = *(const LAS u32x4*)(slot + s4 * SC_STEP_BYTES + (16 * i + fr) * 128 + (((4 * ks + fq) ^ (fr & 7)) * 16));
                            n = __builtin_amdgcn_mfma_f32_16x16x32_bf16(__builtin_bit_cast(bf16x8, mf), bfr[ks], n, 0, 0, 0); }
                        st[i] = n; }
                }
            }
            asm volatile("s_waitcnt lgkmcnt(0)\n\ts_barrier" ::: "memory");
            cur = (cur == 5) ? 0 : cur + 1; cur3 = (cur3 == 2) ? 0 : cur3 + 1;
        }
        if (wave >= 6) scan_flush(L - 320, NIT - 1, F.lds + SC_SO_OFF + ((cur3 == 0) ? 2 : cur3 - 1) * SC_SO_SLOT, sp0v0);
    }
}

struct P5LoadsA { bf16x8 qa[2], sb[4][2]; u32x2 yl[4]; };
struct P5LoadsB { u32x2 pv[4], qv[4], zw[4]; f32x4 mu4[4], g4[4], b4[4]; float bon; };
__device__ __forceinline__ void p5_load_a(Frame& F, P5LoadsA& G, int u, int wq, int fr, int fq) {
    const int c = u & 127, h = (u >> 7) & 15, b = u >> 11; const size_t m = (size_t)b * SEQ + (size_t)c * 64 + 16 * wq + fr;
    const bf16_t* sp = F.STATES + (size_t)u * 4096;
#pragma unroll
    for (int ks = 0; ks < 2; ++ks) G.qa[ks] = *(const bf16x8*)(F.QD + (size_t)u * 4096 + (16 * wq + fr) * 64 + ks * 32 + fq * 8);
#pragma unroll
    for (int nt = 0; nt < 4; ++nt) {
#pragma unroll
        for (int ks = 0; ks < 2; ++ks) G.sb[nt][ks] = *(const bf16x8*)(sp + (16 * nt + fr) * 64 + ks * 32 + fq * 8);
        G.yl[nt] = *(const u32x2*)(F.YCAT + m * DBR + h * 64 + 16 * nt + 4 * fq); }
}
__device__ __forceinline__ void p5_load_b(Frame& F, P5LoadsB& G, int u, int wq, int fr, int fq) {
    const int c = u & 127, h = (u >> 7) & 15, b = u >> 11; const int t = 16 * wq + fr; const size_t m = (size_t)b * SEQ + (size_t)c * 64 + t; const bool hasprev = (c > 0) || (t > 0);
#pragma unroll
    for (int nt = 0; nt < 4; ++nt) { const int ch = h * 64 + 16 * nt + 4 * fq;
        G.pv[nt] = *(const u32x2*)(F.PA + m * NPA + PA_V + ch); G.qv[nt] = hasprev ? *(const u32x2*)(F.PA + (m - 1) * NPA + PA_V + ch) : (u32x2){0u, 0u};
        G.zw[nt] = *(const u32x2*)(F.PA + m * NPA + PA_ZR + ch);
        G.mu4[nt] = *(const f32x4*)(F.mu_rkv + 2 * DBR + ch); G.g4[nt] = *(const f32x4*)(F.lnx_g + ch); G.b4[nt] = *(const f32x4*)(F.lnx_b + ch); }
    G.bon = F.BONUS[m * NH + h];
}
__device__ __forceinline__ void p5_out(Frame& F) {
    const int lane = F.lane, wave = F.wave, fr = lane & 15, fq = lane >> 4, grp = wave >> 2, wq = wave & 3;
    constexpr int NU = BATCH * NH * NCHUNK;
    int u = F.bid * 2 + grp; const int ustep = F.G * 2;
    if (u >= NU) return;
    P5LoadsA GA; p5_load_a(F, GA, u, wq, fr, fq);
    for (; u < NU; u += ustep) {
        const int c = u & 127, h = (u >> 7) & 15, b = u >> 11; const size_t m = (size_t)b * SEQ + (size_t)c * 64 + 16 * wq + fr;
        P5LoadsB GB; p5_load_b(F, GB, u, wq, fr, fq);
        f32x4 y[4];
#pragma unroll
        for (int nt = 0; nt < 4; ++nt) { y[nt] = (f32x4){bflo(GA.yl[nt].x), bfhi(GA.yl[nt].x), bflo(GA.yl[nt].y), bfhi(GA.yl[nt].y)};
#pragma unroll
            for (int ks = 0; ks < 2; ++ks) y[nt] = __builtin_amdgcn_mfma_f32_16x16x32_bf16(GA.sb[nt][ks], GA.qa[ks], y[nt], 0, 0, 0); }
        if (u + ustep < NU) p5_load_a(F, GA, u + ustep, wq, fr, fq);
        float s = 0.f;
#pragma unroll
        for (int nt = 0; nt < 4; ++nt) s += (y[nt][0] + y[nt][1]) + (y[nt][2] + y[nt][3]);
        s += __shfl_xor(s, 16); s += __shfl_xor(s, 32);
        const float mean = s * (1.0f / 64.0f);
        float q = 0.f;
#pragma unroll
        for (int nt = 0; nt < 4; ++nt)
#pragma unroll
            for (int r = 0; r < 4; ++r) { const float d = y[nt][r] - mean; q += d * d; }
        q += __shfl_xor(q, 16); q += __shfl_xor(q, 32);
        const float rstd = 1.0f / sqrtf(q * (1.0f / 64.0f) + GN_EPS);
#pragma unroll
        for (int nt = 0; nt < 4; ++nt) { const int ch = h * 64 + 16 * nt + 4 * fq;
            const f32x4 pv = (f32x4){bflo(GB.pv[nt].x), bfhi(GB.pv[nt].x), bflo(GB.pv[nt].y), bfhi(GB.pv[nt].y)}, qv = (f32x4){bflo(GB.qv[nt].x), bfhi(GB.qv[nt].x), bflo(GB.qv[nt].y), bfhi(GB.qv[nt].y)};
            const f32x4 z = (f32x4){bflo(GB.zw[nt].x), bfhi(GB.zw[nt].x), bflo(GB.zw[nt].y), bfhi(GB.zw[nt].y)};
            const f32x4 vv = pv + (qv - pv) * GB.mu4[nt];
            f32x4 o4;
#pragma unroll
            for (int r = 0; r < 4; ++r) o4[r] = ((y[nt][r] - mean) * rstd * GB.g4[nt][r] + GB.b4[nt][r] + GB.bon * vv[r]) * (z[r] * sigmoidf_(z[r]));
            u32x2 ow; ow.x = pk2(o4[0], o4[1]); ow.y = pk2(o4[2], o4[3]);
            *(u32x2*)(F.YCAT + m * DBR + ch) = ow; }
    }
}

__device__ __forceinline__ void p8_final(Frame& F) {
    const int gw = F.bid * NWAVES + F.wave, NGW = F.G * NWAVES;
    for (int m0 = gw; m0 < M; m0 += 2 * NGW) {
#pragma unroll
        for (int q = 0; q < 2; ++q) { const int m = (m0 + q * NGW < M) ? m0 + q * NGW : m0;
            const f32x4* xr = (const f32x4*)(F.x + (size_t)m * DM) + 2 * F.lane; const f32x4* gr = (const f32x4*)F.post_g + 2 * F.lane;
            const u32x4* orow = (const u32x4*)(F.OBF + (size_t)m * DM) + F.lane;
            f32x4* outr = (f32x4*)(F.out + (size_t)m * DM) + 2 * F.lane;
            u32x4 ow[4]; f32x4 x0[4], x1[4];
#pragma unroll
            for (int jj = 0; jj < 4; ++jj) { ow[jj] = orow[64 * jj]; x0[jj] = xr[128 * jj]; x1[jj] = xr[128 * jj + 1]; }
            float ss = (F.lane < 32) ? F.SSP[(size_t)m * 32 + F.lane] : 0.f;
            ss = wave_sum(ss);
            const float rstd = 1.0f / sqrtf(ss * (1.f / DM) + NORM_EPS);
#pragma unroll
            for (int jj = 0; jj < 4; ++jj) { float ov[8]; unpack8(ow[jj], ov);
                const f32x4 g0 = gr[128 * jj], g1 = gr[128 * jj + 1];
                outr[128 * jj] = x0[jj] + (f32x4){ov[0], ov[1], ov[2], ov[3]} * rstd * g0; outr[128 * jj + 1] = x1[jj] + (f32x4){ov[4], ov[5], ov[6], ov[7]} * rstd * g1; }
        }
    }
}

struct Args { const float* in[22]; float* out; unsigned char* ws; int ph_lo, ph_hi, li, pad; };
constexpr int N_PHASES = 9;
__global__ void __launch_bounds__(NTHREADS, 2) mk_fwd(Args args) {
    extern __shared__ __attribute__((aligned(16))) unsigned char lds[];
    Frame F;
    F.lds = (LAS unsigned char*)lds;
    F.tid = threadIdx.x; F.lane = F.tid & 63; F.wave = __builtin_amdgcn_readfirstlane(F.tid >> 6);
    F.G = gridDim.x; F.bid = blockIdx.x;
    unsigned char* ws = args.ws;
    F.x = args.in[0]; F.pre_g = args.in[1]; F.post_g = args.in[2]; F.w_in = args.in[3]; F.mu_rkv = args.in[4]; F.mu_wa = args.in[5]; F.w0 = args.in[6]; F.w1 = args.in[7]; F.w2 = args.in[8];
    F.a0 = args.in[9]; F.a1 = args.in[10]; F.a2 = args.in[11]; F.k_k = args.in[12]; F.k_a = args.in[13]; F.r_k = args.in[14]; F.lnx_g = args.in[15]; F.lnx_b = args.in[16]; F.rel_bias = args.in[17];
    F.w_br = args.in[18]; F.w_ba = args.in[19]; F.b_merge = args.in[20]; F.w_out = args.in[21]; F.out = args.out;
    F.HB = (bf16_t*)((unsigned char*)args.out + DO_HB); F.WIN_T = (bf16_t*)((unsigned char*)args.out + DO_WIN); F.STATES = (bf16_t*)((unsigned char*)args.out + DO_STATES);
    F.MD = (bf16_t*)((unsigned char*)args.out + DO_MD); F.ND = (bf16_t*)((unsigned char*)args.out + DO_ND); F.QD = (bf16_t*)((unsigned char*)args.out + DO_QD);
    F.WCAT_T = (bf16_t*)(ws + WS_WCAT); F.WOUT_T = (bf16_t*)(ws + WS_WOUT); F.W2T = (bf16_t*)(ws + WS_W2T); F.A2T = F.W2T + DBR * 64;
    F.BONUS = (float*)(ws + WS_BONUS); F.SSP = (float*)(ws + WS_SSP); F.PL = (bf16_t*)(ws + WS_PLS); F.PG = (bf16_t*)(ws + WS_PG); F.PA = (bf16_t*)(ws + WS_PA);
    F.MERGED = (bf16_t*)(ws + WS_MERGED); F.YCAT = (bf16_t*)(ws + WS_YCAT); F.OBF = (bf16_t*)(ws + WS_OBF); F.queue = (unsigned*)(ws + WS_CTL) + 65536;
    for (int u = F.tid; u < (LDS_BYTES - LDSCTL_OFF) / 4; u += NTHREADS) ((LAS unsigned*)(F.lds + LDSCTL_OFF))[u] = 0u;
    __syncthreads();
    const int lo = args.ph_lo, hi = args.ph_hi;
    XcdBarrier bar; bar.bar = (unsigned*)(ws + WS_CTL) + CW_BAR; bar.x = 0; bar.st = nullptr;
    if (hi - lo > 1) bar = xcd_barrier_post((unsigned*)(ws + WS_CTL) + CW_BAR, (volatile LAS unsigned*)(F.lds + MISC_OFF) + 8);
#define IN(k) (lo <= (k) && (k) < hi)
#define SEAM(k) do { if (IN(k) && IN((k) + 1)) xcd_barrier(bar); } while (0)
#define PHASE(k, ...) do { if (IN(k)) { __VA_ARGS__; SEAM(k); if (PROBE_REP == (k)) { __VA_ARGS__; xcd_barrier(bar); } } } while (0)
    PHASE(0, p0_prologue(F));
    PHASE(1, {
        pg8::Gemm g{F.HB, F.WIN_T, M, NIN, DM}; pg8::SplitOrder S; S.so.init(M, NPA + NPG, F.G, F.bid, DM, WGM_P1); S.extra_pn = (NPA + NPG) / 256;
        LAS float* bml = (LAS float*)(F.lds + RING_BYTES);
        for (int i = F.tid; i < 2 * DM / 4; i += NTHREADS) ((LAS f32x4*)bml)[i] = ((const f32x4*)F.b_merge)[i];
        __syncthreads();
        EpiIn E{F.PA, F.PG, F.PL, bml};
        pg8::gemm_phase<EpiIn, pg8::SplitOrder, P1_ALIGN, P1_SP2>(F.lds, g, S, E);
    });
    PHASE(3, p3_prep(F));
    PHASE(4, { p4_scan(F); p2_attention(F); });
    PHASE(5, p5_out(F));
    PHASE(6, {
        pg8::Gemm g{F.YCAT, F.WCAT_T, 2 * M, 2 * DM, DBR}; pg8::PairOrder S; S.so.init(M, DM, F.G, F.bid, DBR, WGM_P6); S.dpm = M / 256; S.dpn = DM / 256;
        EpiBranch E{F.PG, F.MERGED};
        pg8::gemm_phase<EpiBranch, pg8::PairOrder, true, true>(F.lds, g, S, E);
    });
    PHASE(7, {
        pg8::Gemm g{F.MERGED, F.WOUT_T, M, DM, DM}; pg8::StaticOrder S; S.init(M, DM, F.G, F.bid, DM, WGM_P7);
        EpiOut E{F.OBF, F.SSP};
        pg8::gemm_phase<EpiOut, pg8::StaticOrder, true, true>(F.lds, g, S, E);
    });
    if (IN(8)) { p8_final(F); }
#undef PHASE
#undef IN
#undef SEAM
}

extern "C" void kernel_launch(void* const* d_in, const int* in_sizes, int n_in, void* d_out, int out_size, void* d_ws, size_t ws_size, hipStream_t stream) {
    static int grid = 0;
    if (grid == 0) {
        if (n_in != 22 || in_sizes[0] != M * DM || out_size != M * DM || ws_size < WS_END) { fprintf(stderr, "kernel_launch: unexpected shapes (n_in %d in0 %d out %d ws %zu); nothing launched\n", n_in, n_in > 0 ? in_sizes[0] : -1, out_size, ws_size); grid = -1; return; }
        int dev = 0, cus = 0;
        if (hipGetDevice(&dev) != hipSuccess || hipDeviceGetAttribute(&cus, hipDeviceAttributeMultiprocessorCount, dev) != hipSuccess) { fprintf(stderr, "kernel_launch: device query failed\n"); grid = -1; return; }
        if (hipFuncSetAttribute((const void*)mk_fwd, hipFuncAttributeMaxDynamicSharedMemorySize, LDS_BYTES) != hipSuccess) { fprintf(stderr, "kernel_launch: hipFuncSetAttribute failed\n"); grid = -1; return; }
        int per_cu = 0;
        if (hipOccupancyMaxActiveBlocksPerMultiprocessor(&per_cu, (const void*)mk_fwd, NTHREADS, LDS_BYTES) != hipSuccess || per_cu < 1) fprintf(stderr, "kernel_launch: note: occupancy query reports %d blocks per CU\n", per_cu);
        (void)hipGetLastError();
        grid = cus > 256 ? 256 : cus;
        if (grid != 256) { fprintf(stderr, "kernel_launch: this build needs a 256-CU device (got %d); nothing launched\n", cus); grid = -1; return; }
    }
    if (grid < 0) return;
    (void)hipMemsetAsync((char*)d_ws + WS_CTL, 0, CTL_ZERO_BYTES, stream);
    Args a{};
    for (int i = 0; i < 22; ++i) a.in[i] = (const float*)d_in[i];
    a.out = (float*)d_out; a.ws = (unsigned char*)d_ws;
#if MK_N_LAUNCHES == 1
    a.ph_lo = 0; a.ph_hi = N_PHASES; a.li = 0;
    hipLaunchKernelGGL(mk_fwd, dim3(grid), dim3(NTHREADS), LDS_BYTES, stream, a);
#else
    for (int li = 0; li < N_PHASES; ++li) { a.ph_lo = li; a.ph_hi = li + 1; a.li = li; hipLaunchKernelGGL(mk_fwd, dim3(grid), dim3(NTHREADS), LDS_BYTES, stream, a); }
#endif
}
```

```cpp
#include <hip/hip_runtime.h>
#include <cstdio>
#include <cstdint>

#ifndef MK_N_LAUNCHES
#define MK_N_LAUNCHES 1
#endif
#ifndef WGM_P1
#define WGM_P1 6
#endif
#ifndef WGM_P6
#define WGM_P6 2
#endif
#ifndef WGM_P7
#define WGM_P7 2
#endif
#ifndef P1_ALIGN
#define P1_ALIGN true
#endif
#ifndef P1_SP2
#define P1_SP2 true
#endif
#ifndef XCD_REMAP
#define XCD_REMAP 1
#endif
#ifndef ROT_COLS
#define ROT_COLS 0
#endif
#ifndef PROBE_REP
#define PROBE_REP -1
#endif

#define LAS __attribute__((address_space(3)))
#define GAS __attribute__((address_space(1)))
typedef unsigned short bf16_t;
typedef short bf16x8 __attribute__((ext_vector_type(8)));
typedef short s16x4 __attribute__((ext_vector_type(4)));
typedef float f32x4 __attribute__((ext_vector_type(4)));
typedef float f32x2 __attribute__((ext_vector_type(2)));
typedef unsigned u32x4 __attribute__((ext_vector_type(4)));
typedef unsigned u32x2 __attribute__((ext_vector_type(2)));
typedef __bf16 bf16x2_t __attribute__((ext_vector_type(2)));

constexpr int BATCH = 2, SEQ = 8192, DM = 2048, DBR = 1024, NH = 16, HD = 64, CHUNK = 64, NCHUNK = SEQ / CHUNK, M = BATCH * SEQ;
constexpr int NPA = 8192, NPG = 4096, NPL = 256, NIN = NPA + NPG + NPL;
constexpr int PA_R = 0, PA_K = 1024, PA_V = 2048, PA_ZR = 3072, PA_Q = 4096, PA_KA = 5120, PA_VA = 6144, PA_ZA = 7168;
constexpr float NORM_EPS = 1e-6f, GN_EPS = 64e-5f, DECAY_SCALE = 0.606531f;
constexpr int NWAVES = 8, NTHREADS = 512;

constexpr size_t MiB = 1u << 20;
constexpr size_t WS_CTL = 0, CTL_ZERO_BYTES = 1 * MiB;
constexpr size_t WS_WCAT = 1 * MiB;
constexpr size_t WS_WOUT = 9 * MiB;
constexpr size_t WS_W2T = 17 * MiB;
constexpr size_t WS_BONUS = 18 * MiB;
constexpr size_t WS_SSP = 19 * MiB;
constexpr size_t WS_PL = 22 * MiB;
constexpr size_t WS_PG = 30 * MiB;
constexpr size_t WS_PA = 158 * MiB;
constexpr size_t WS_MERGED = WS_PA;
constexpr size_t WS_OBF = WS_PA + 64 * MiB;
constexpr size_t WS_YCAT = 414 * MiB;
constexpr size_t WS_PLS = 478 * MiB;
constexpr size_t WS_END = 510 * MiB;
constexpr size_t DO_HB = 0, DO_WIN = 64 * MiB, DO_STATES = 0;
constexpr size_t DO_MD = 32 * MiB, DO_ND = 64 * MiB, DO_QD = 96 * MiB;
constexpr int CW_BAR = 4096;

constexpr int RING_BYTES = 131072;
constexpr int LDSCTL_OFF = 152576, MISC_OFF = LDSCTL_OFF + 320;
constexpr int LDS_BYTES = 153600;

typedef GAS unsigned gu32;
#define RLX_AGENT __ATOMIC_RELAXED, __HIP_MEMORY_SCOPE_AGENT
#define LDS_WAIT() asm volatile("s_waitcnt lgkmcnt(0)" ::: "memory")
#define VM_WAIT() asm volatile("s_waitcnt vmcnt(0)" ::: "memory")
__device__ __forceinline__ unsigned pk2(float lo, float hi) { f32x2 v = {lo, hi}; bf16x2_t b = __builtin_convertvector(v, bf16x2_t); return __builtin_bit_cast(unsigned, b); }
__device__ __forceinline__ bf16_t f2bf(float f) { return (bf16_t)(pk2(f, 0.f) & 0xffffu); }
__device__ __forceinline__ float bflo(unsigned w) { return __uint_as_float(w << 16); }
__device__ __forceinline__ float bfhi(unsigned w) { return __uint_as_float(w & 0xffff0000u); }
__device__ __forceinline__ float bf2f(bf16_t h) { return __uint_as_float(((unsigned)h) << 16); }
__device__ __forceinline__ void unpack8(const u32x4 w, float (&f)[8]) { f[0] = bflo(w.x); f[1] = bfhi(w.x); f[2] = bflo(w.y); f[3] = bfhi(w.y); f[4] = bflo(w.z); f[5] = bfhi(w.z); f[6] = bflo(w.w); f[7] = bfhi(w.w); }
__device__ __forceinline__ u32x4 pack8(const float (&f)[8]) { u32x4 w; w.x = pk2(f[0], f[1]); w.y = pk2(f[2], f[3]); w.z = pk2(f[4], f[5]); w.w = pk2(f[6], f[7]); return w; }
__device__ __forceinline__ void load8(const float* p, float (&f)[8]) { const f32x4 a = *(const f32x4*)p, b = *(const f32x4*)(p + 4); f[0] = a.x; f[1] = a.y; f[2] = a.z; f[3] = a.w; f[4] = b.x; f[5] = b.y; f[6] = b.z; f[7] = b.w; }
__device__ __forceinline__ float sigmoidf_(float x) { return 1.f / (1.f + __expf(-x)); }
__device__ __forceinline__ float tanhf_(float x) { return 1.f - 2.f / (1.f + __expf(2.f * x)); }

namespace pg8 {
constexpr int BM = 256, BK = 64, HALF = 128, HTB = HALF * BK * 2  , STAGE_BYTES = 8 * HTB, NXCD = 8;
__host__ __device__ __forceinline__ int lds_byte(int r, int c) { const int st = (r >> 4) * 2 + (c >> 5), rr = r & 15, cc = c & 31, ob = rr * 64 + cc * 2; return st * 1024 + (ob ^ (((ob >> 9) & 1) << 5)); }
__host__ __device__ __forceinline__ void stage_rc(int b, int& R, int& C) { const int st = b / 1024, sb = b % 1024, swz = sb ^ (((sb >> 9) & 1) << 5); R = (st >> 1) * 16 + swz / 64; C = (st & 1) * 32 + (swz % 64) / 2; }
__host__ __device__ __forceinline__ int perm32(int rho) { const int n = rho >> 4, i = rho & 15; return 8 * (i >> 2) + 4 * n + (i & 3); }

struct Unit { int pm, pn, kb, nt; };
struct Gemm { const bf16_t* A; const bf16_t* Bt; int M, N, K; };

struct StaticOrder {
    int nM, nN, nwg, G, c, ntk, WGM;
    __host__ __device__ void init(int M_, int N_, int G_, int c_, int K_, int wgm_) { nM = M_ / BM; nN = N_ / BM; nwg = nM * nN; G = G_; c = c_; ntk = K_ / BK; WGM = wgm_; }
    __host__ __device__ void tile(int L, int& pm, int& pn) const {
        int wgid = L; if (XCD_REMAP) { const int q = nwg / NXCD, r = nwg % NXCD, xcd = wgid % NXCD, off = wgid / NXCD; wgid = (xcd < r ? xcd * (q + 1) : r * (q + 1) + (xcd - r) * q) + off; }
        if (WGM > 0) { const int nig = WGM * nN, gid = wgid / nig, fm = gid * WGM, gsz = (nM - fm) < WGM ? (nM - fm) : WGM;
            pm = fm + ((wgid % nig) % gsz); pn = (wgid % nig) / gsz;
            if (ROT_COLS) pn = (pn + ROT_COLS * gid) % nN; }
        else { const int W = -WGM, nig = W * nM, gid = wgid / nig, fn = gid * W, gsz = (nN - fn) < W ? (nN - fn) : W;
            pn = fn + ((wgid % nig) % gsz); pm = (wgid % nig) / gsz; }
    }
    __host__ __device__ bool next(int i, Unit& u) const {
        const long L = (long)i * G + c; if (L >= nwg) return false;
        int pm, pn; tile((int)L, pm, pn);
        u.pm = pm; u.pn = pn; u.kb = 0; u.nt = ntk; return true;
    }
};
struct SplitOrder {
    StaticOrder so; int extra_pn;
    __host__ __device__ bool next(int i, Unit& u) const {
        const long L = (long)i * so.G + so.c; const bool normal = L < so.nwg; const int Lq = (int)(L - so.nwg);
        if (!normal && Lq >= 256) return false;
        int pm, pn; so.tile(normal ? (int)L : 0, pm, pn);
        u.pm = normal ? pm : (Lq >> 2); u.pn = normal ? pn : extra_pn; u.kb = normal ? 0 : (Lq & 3) * 1024; u.nt = normal ? so.ntk : 8; return true;
    }
};
struct PairOrder {
    StaticOrder so; int dpm, dpn;
    __host__ __device__ bool next(int i, Unit& u) const { if (!so.next(i >> 1, u)) return false; if (i & 1) { u.pm += dpm; u.pn += dpn; } return true; }
};

template <class Epi, class Sched, bool ALIGN_EPI = false, bool SP2 = false>
__device__ __forceinline__ void gemm_phase(LAS unsigned char* lds, const Gemm g, const Sched& S, const Epi& E) {
    const int tid = threadIdx.x, wid = __builtin_amdgcn_readfirstlane(tid >> 6), lane = tid & 63, wr = wid >> 2, wc = wid & 3, fr = lane & 15, fq = lane >> 4;
    const int K = g.K;
    unsigned voffA[2], voffB[2];
#pragma unroll
    for (int i = 0; i < 2; ++i) { int R, C; stage_rc(tid * 16 + i * 8192, R, C); const int Rb = Epi::PERM ? ((R & ~31) + perm32(R & 31)) : R;
        voffA[i] = (unsigned)(R * K + C) * 2u; voffB[i] = (unsigned)(Rb * K + C) * 2u; }
    const size_t kstep = (size_t)(BK * 2);
    const size_t hstep = (size_t)HALF * K * 2;
    const size_t tstep = 2 * hstep;
    const unsigned ldsw = (unsigned)wid * 1024u;
    const int aoff = lds_byte(wr * 64 + fr, fq * 8), boff = lds_byte(wc * 32 + fr, fq * 8);
#define PG8_SA(b, h) (((b) * 2 + (h)) * HTB)
#define PG8_SB(b, h) ((4 + (b) * 2 + (h)) * HTB)
#define PG8_STAGE(bufoff, gbase, voff) do { _Pragma("unroll") for (int _i = 0; _i < 2; ++_i) \
        __builtin_amdgcn_global_load_lds((const unsigned*)((const char*)(gbase) + (voff)[_i]), (LAS unsigned*)(lds + (bufoff) + ldsw + _i * 8192), 16, 0, 0); } while (0)
#define PG8_LDA(dst, b, h) do { _Pragma("unroll") for (int m = 0; m < 4; ++m) _Pragma("unroll") for (int k = 0; k < 2; ++k) dst[m][k] = *(const LAS bf16x8*)(lds + PG8_SA(b, h) + aoff + m * 2048 + k * 1024); } while (0)
#define PG8_LDB(dst, b, h) do { _Pragma("unroll") for (int n = 0; n < 2; ++n) _Pragma("unroll") for (int k = 0; k < 2; ++k) dst[n][k] = *(const LAS bf16x8*)(lds + PG8_SB(b, h) + boff + n * 2048 + k * 1024); } while (0)
#define PG8_MMA(ai, bj, At, Bt) do { __builtin_amdgcn_s_setprio(1); _Pragma("unroll") for (int m = 0; m < 4; ++m) _Pragma("unroll") for (int n = 0; n < 2; ++n) _Pragma("unroll") for (int k = 0; k < 2; ++k) \
        acc[ai][bj][m][n] = __builtin_amdgcn_mfma_f32_16x16x32_bf16(Bt[n][k], At[m][k], acc[ai][bj][m][n], 0, 0, 0); __builtin_amdgcn_s_setprio(0); } while (0)
#define PG8_WAIT_V(n) asm volatile("s_waitcnt vmcnt(" #n ")" ::: "memory")
#define PG8_WAIT_L(n) asm volatile("s_waitcnt lgkmcnt(" #n ")" ::: "memory")
#define PG8_BAR __builtin_amdgcn_s_barrier()
#define PG8_SCHED __builtin_amdgcn_sched_barrier(0)
    Unit cur, nxt; int ui = 0;
    if (!S.next(0, cur)) return;
    f32x4 acc[2][2][4][2];
#pragma unroll
    for (int a = 0; a < 2; ++a)
#pragma unroll
        for (int b = 0; b < 2; ++b)
#pragma unroll
            for (int m = 0; m < 4; ++m)
#pragma unroll
                for (int n = 0; n < 2; ++n) acc[a][b][m][n] = (f32x4){0.f, 0.f, 0.f, 0.f};
    bf16x8 At[4][2], B0[2][2], B1[2][2];
    const char* cA = (const char*)g.A + (size_t)cur.pm * tstep + cur.kb; const char* cB = (const char*)g.Bt + (size_t)cur.pn * tstep + cur.kb;
    if constexpr (SP2) {
        PG8_STAGE(PG8_SB(0, 0), cB, voffB); PG8_STAGE(PG8_SB(0, 1), cB + hstep, voffB); PG8_STAGE(PG8_SA(0, 0), cA, voffA); PG8_STAGE(PG8_SA(0, 1), cA + hstep, voffA);
        if (wr == 1) PG8_BAR;
        PG8_WAIT_V(2); PG8_BAR;
        PG8_STAGE(PG8_SB(1, 0), cB + kstep, voffB); PG8_STAGE(PG8_SA(1, 0), cA + kstep, voffA); PG8_STAGE(PG8_SB(1, 1), cB + hstep + kstep, voffB);
        PG8_WAIT_V(6); PG8_BAR;
    } else {
        PG8_STAGE(PG8_SB(0, 0), cB, voffB); PG8_STAGE(PG8_SA(0, 0), cA, voffA); PG8_STAGE(PG8_SB(0, 1), cB + hstep, voffB); PG8_STAGE(PG8_SA(0, 1), cA + hstep, voffA);
        if (wr == 1) PG8_BAR;
        PG8_WAIT_V(4); PG8_BAR;
        PG8_STAGE(PG8_SB(1, 0), cB + kstep, voffB); PG8_STAGE(PG8_SA(1, 0), cA + kstep, voffA); PG8_STAGE(PG8_SB(1, 1), cB + hstep + kstep, voffB);
        PG8_WAIT_V(6); PG8_BAR;
    }
    for (;;) {
        const bool has_next = S.next(ui + 1, nxt);
        const char* nA = has_next ? (const char*)g.A + (size_t)nxt.pm * tstep + nxt.kb : cA; const char* nB = has_next ? (const char*)g.Bt + (size_t)nxt.pn * tstep + nxt.kb : cB;
        const int nt = cur.nt;
        for (int t = 0; t < nt; t += 2) {
            const bool last = (t == nt - 2);
            const char* a1 = cA + (size_t)(t + 1) * kstep;
            const char* a2 = last ? nA : cA + (size_t)(t + 2) * kstep; const char* b2 = last ? nB : cB + (size_t)(t + 2) * kstep;
            const char* a3 = a2 + kstep; const char* b3 = b2 + kstep;
            if constexpr (SP2) {
            PG8_LDB(B0, 0, 0); PG8_LDB(B1, 0, 1); PG8_SCHED; PG8_LDA(At, 0, 0); PG8_STAGE(PG8_SA(1, 1), a1 + hstep, voffA);
            PG8_WAIT_V(8); PG8_WAIT_L(0); PG8_BAR; PG8_MMA(0, 0, At, B0); PG8_MMA(0, 1, At, B1); PG8_BAR; PG8_SCHED;
            PG8_LDA(At, 0, 1); PG8_STAGE(PG8_SB(0, 0), b2, voffB); PG8_STAGE(PG8_SB(0, 1), b2 + hstep, voffB); PG8_STAGE(PG8_SA(0, 0), a2, voffA);
            PG8_WAIT_V(8); PG8_WAIT_L(0); PG8_BAR; PG8_MMA(1, 0, At, B0); PG8_MMA(1, 1, At, B1); PG8_BAR; PG8_SCHED;
            PG8_LDB(B0, 1, 0); PG8_LDB(B1, 1, 1); PG8_SCHED; PG8_LDA(At, 1, 0); PG8_STAGE(PG8_SA(0, 1), a2 + hstep, voffA);
            PG8_WAIT_V(8); PG8_WAIT_L(0); PG8_BAR; PG8_MMA(0, 0, At, B0); PG8_MMA(0, 1, At, B1); PG8_BAR; PG8_SCHED;
            PG8_LDA(At, 1, 1); PG8_STAGE(PG8_SB(1, 0), b3, voffB); PG8_STAGE(PG8_SB(1, 1), b3 + hstep, voffB); PG8_STAGE(PG8_SA(1, 0), a3, voffA);
            PG8_WAIT_V(8); PG8_WAIT_L(0); PG8_BAR; PG8_MMA(1, 0, At, B0); PG8_MMA(1, 1, At, B1); PG8_BAR; PG8_SCHED;
            } else {
            PG8_LDB(B0, 0, 0); PG8_SCHED; PG8_LDA(At, 0, 0); PG8_STAGE(PG8_SA(1, 1), a1 + hstep, voffA);
            PG8_WAIT_L(8); PG8_BAR; PG8_WAIT_L(0); PG8_MMA(0, 0, At, B0); PG8_BAR; PG8_SCHED;
            PG8_LDB(B1, 0, 1); PG8_STAGE(PG8_SB(0, 0), b2, voffB);
            PG8_BAR; PG8_WAIT_L(0); PG8_MMA(0, 1, At, B1); PG8_BAR;
            PG8_LDA(At, 0, 1); PG8_STAGE(PG8_SA(0, 0), a2, voffA);
            PG8_BAR; PG8_WAIT_L(0); PG8_MMA(1, 0, At, B0); PG8_BAR; PG8_SCHED;
            PG8_STAGE(PG8_SB(0, 1), b2 + hstep, voffB);
            PG8_WAIT_V(6); PG8_BAR; PG8_MMA(1, 1, At, B1); PG8_BAR;
            PG8_LDB(B0, 1, 0); PG8_SCHED; PG8_LDA(At, 1, 0); PG8_STAGE(PG8_SA(0, 1), a2 + hstep, voffA);
            PG8_WAIT_L(8); PG8_BAR; PG8_WAIT_L(0); PG8_MMA(0, 0, At, B0); PG8_BAR; PG8_SCHED;
            PG8_LDB(B1, 1, 1); PG8_STAGE(PG8_SB(1, 0), b3, voffB);
            PG8_BAR; PG8_WAIT_L(0); PG8_MMA(0, 1, At, B1); PG8_BAR;
            PG8_LDA(At, 1, 1); PG8_STAGE(PG8_SA(1, 0), a3, voffA);
            PG8_BAR; PG8_WAIT_L(0); PG8_MMA(1, 0, At, B0); PG8_BAR; PG8_SCHED;
            PG8_STAGE(PG8_SB(1, 1), b3 + hstep, voffB);
            PG8_WAIT_V(6); PG8_BAR; PG8_MMA(1, 1, At, B1); PG8_BAR;
            }
        }
        if constexpr (ALIGN_EPI) { if (wr == 0) PG8_BAR; }
        const bool zero_acc = E(acc, cur, wr, wc, fr, fq);
        if (!has_next) break;
        if (zero_acc) {
#pragma unroll
        for (int a = 0; a < 2; ++a)
#pragma unroll
            for (int b = 0; b < 2; ++b)
#pragma unroll
                for (int m = 0; m < 4; ++m)
#pragma unroll
                    for (int n = 0; n < 2; ++n) acc[a][b][m][n] = (f32x4){0.f, 0.f, 0.f, 0.f};
        }
        cur = nxt; cA = nA; cB = nB; ++ui;
        if constexpr (ALIGN_EPI) { if (wr == 1) PG8_BAR; }
    }
    PG8_WAIT_V(0);
    if constexpr (!ALIGN_EPI) { if (wr == 0) PG8_BAR; }
    PG8_BAR;
#undef PG8_SA
#undef PG8_SB
#undef PG8_STAGE
#undef PG8_LDA
#undef PG8_LDB
#undef PG8_MMA
#undef PG8_WAIT_V
#undef PG8_WAIT_L
#undef PG8_BAR
#undef PG8_SCHED
}
}

struct EpiIn {
    static constexpr bool PERM = true;
    bf16_t* PA; bf16_t* PG; bf16_t* PL; const LAS float* bmerge;
    __device__ __forceinline__ bool operator()(f32x4 (&acc)[2][2][4][2], const pg8::Unit& u, int wr, int wc, int fr, int fq) const {
        const int row0 = u.pm * 256 + wr * 64 + fr; const int colb = u.pn * 256 + wc * 32 + 8 * fq;
        if (u.pn < 32) {
            const float sc = (u.pn >= 16 && u.pn < 20) ? 0.125f : 1.0f;
#pragma unroll
            for (int ai = 0; ai < 2; ++ai)
#pragma unroll
                for (int m = 0; m < 4; ++m) { bf16_t* rowp = PA + (size_t)(row0 + ai * 128 + m * 16) * NPA + colb;
#pragma unroll
                    for (int bj = 0; bj < 2; ++bj) { const f32x4 v0 = acc[ai][bj][m][0] * sc, v1 = acc[ai][bj][m][1] * sc;
                        u32x4 w; w.x = pk2(v0[0], v0[1]); w.y = pk2(v0[2], v0[3]); w.z = pk2(v1[0], v1[1]); w.w = pk2(v1[2], v1[3]);
                        *(u32x4*)(rowp + bj * 128) = w; } }
        } else if (u.pn < 48) {
            const int j0 = (u.pn - 32) * 128 + wc * 32 + 8 * fq;
            f32x4 bv[2][2];
#pragma unroll
            for (int bj = 0; bj < 2; ++bj)
#pragma unroll
                for (int n = 0; n < 2; ++n) bv[bj][n] = *(const LAS f32x4*)(bmerge + bj * 2048 + j0 + 4 * n);
#pragma unroll
            for (int ai = 0; ai < 2; ++ai)
#pragma unroll
                for (int m = 0; m < 4; ++m) { bf16_t* rowp = PG + (size_t)(row0 + ai * 128 + m * 16) * NPG + j0;
                    float rat[8], ga[8];
#pragma unroll
                    for (int n = 0; n < 2; ++n)
#pragma unroll
                        for (int e = 0; e < 4; ++e) { const float xr = acc[ai][0][m][n][e] + bv[0][n][e], xa = acc[ai][1][m][n][e] + bv[1][n][e];
                            const float dr = 1.0f + __expf(-xr), da = 1.0f + __expf(-xa);
                            ga[4 * n + e] = __builtin_amdgcn_rcpf(da); rat[4 * n + e] = da * __builtin_amdgcn_rcpf(dr); }
                    *(u32x4*)rowp = pack8(rat); *(u32x4*)(rowp + 2048) = pack8(ga); }
        } else {
            const int cl = colb - NPA - NPG;
#pragma unroll
            for (int ai = 0; ai < 2; ++ai)
#pragma unroll
                for (int m = 0; m < 4; ++m) { bf16_t* rowp = PL + (size_t)(u.kb >> 10) * ((size_t)M * NPL) + (size_t)(row0 + ai * 128 + m * 16) * NPL + cl;
#pragma unroll
                    for (int bj = 0; bj < 2; ++bj) { const f32x4 v0 = acc[ai][bj][m][0], v1 = acc[ai][bj][m][1];
                        u32x4 w; w.x = pk2(v0[0], v0[1]); w.y = pk2(v0[2], v0[3]); w.z = pk2(v1[0], v1[1]); w.w = pk2(v1[2], v1[3]);
                        *(u32x4*)(rowp + bj * 128) = w; } }
        }
        return true;
    }
};
struct EpiBranch {
    static constexpr bool PERM = true;
    const bf16_t* PG; bf16_t* MG;
    __device__ __forceinline__ bool operator()(f32x4 (&acc)[2][2][4][2], const pg8::Unit& u, int wr, int wc, int fr, int fq) const {
        const bool first = u.pm < 64;
        const int pm = first ? u.pm : u.pm - 64, pn = first ? u.pn : u.pn - 8;
        const int row0 = pm * 256 + wr * 64 + fr; const int colb = pn * 256 + wc * 32 + 8 * fq;
        const bf16_t* gbase = PG + (first ? 0 : 2048) + colb;
#pragma unroll
        for (int ai = 0; ai < 2; ++ai) {
            u32x4 g_[4][2];
#pragma unroll
            for (int m = 0; m < 4; ++m)
#pragma unroll
                for (int bj = 0; bj < 2; ++bj) g_[m][bj] = *(const u32x4*)(gbase + (size_t)(row0 + ai * 128 + m * 16) * NPG + bj * 128);
#pragma unroll
            for (int m = 0; m < 4; ++m) { const size_t row = (size_t)(row0 + ai * 128 + m * 16);
#pragma unroll
                for (int bj = 0; bj < 2; ++bj) { float g[8]; unpack8(g_[m][bj], g);
#pragma unroll
                    for (int e = 0; e < 4; ++e) { acc[ai][bj][m][0][e] *= g[e]; acc[ai][bj][m][1][e] *= g[4 + e]; }
                    if (!first) { const f32x4 v0 = acc[ai][bj][m][0], v1 = acc[ai][bj][m][1];
                        u32x4 w; w.x = pk2(v0[0], v0[1]); w.y = pk2(v0[2], v0[3]); w.z = pk2(v1[0], v1[1]); w.w = pk2(v1[2], v1[3]);
                        *(u32x4*)(MG + row * DM + colb + bj * 128) = w; } } }
            asm volatile("" ::: "memory");
        }
        return !first;
    }
};
struct EpiOut {
    static constexpr bool PERM = true;
    bf16_t* O; float* SSP;
    __device__ __forceinline__ bool operator()(f32x4 (&acc)[2][2][4][2], const pg8::Unit& u, int wr, int wc, int fr, int fq) const {
        const int row0 = u.pm * 256 + wr * 64 + fr; const int colb = u.pn * 256 + wc * 32 + 8 * fq;
#pragma unroll
        for (int ai = 0; ai < 2; ++ai)
#pragma unroll
            for (int m = 0; m < 4; ++m) { const size_t row = (size_t)(row0 + ai * 128 + m * 16); float ss = 0.f;
#pragma unroll
                for (int bj = 0; bj < 2; ++bj) { const f32x4 v0 = acc[ai][bj][m][0], v1 = acc[ai][bj][m][1];
                    ss += (v0[0] * v0[0] + v0[1] * v0[1]) + (v0[2] * v0[2] + v0[3] * v0[3]) + (v1[0] * v1[0] + v1[1] * v1[1]) + (v1[2] * v1[2] + v1[3] * v1[3]);
                    u32x4 w; w.x = pk2(v0[0], v0[1]); w.y = pk2(v0[2], v0[3]); w.z = pk2(v1[0], v1[1]); w.w = pk2(v1[2], v1[3]);
                    *(u32x4*)(O + row * DM + colb + bj * 128) = w; }
                ss += __shfl_xor(ss, 16); ss += __shfl_xor(ss, 32);
                if (fq == 0) SSP[row * 32 + u.pn * 4 + wc] = ss; }
        return true;
    }
};

#define XB_TMO      128
#define XB_XCNT(j)  (256  + 64 * (j))
#define XB_XSUB(j)  (1280 + 64 * (j))
#define XB_XGEN(j)  (2304 + 64 * (j))
#define XB_TOP      3328
#define XB_TOPGEN   3392
#define XCD_BAR_WORDS 3456
#define XB_SPIN_CAP (1u << 18)
__device__ __forceinline__ unsigned xb_ld(unsigned* p)              { return __hip_atomic_load(p, __ATOMIC_RELAXED, __HIP_MEMORY_SCOPE_AGENT); }
__device__ __forceinline__ unsigned xb_add(unsigned* p, unsigned v) { return __hip_atomic_fetch_add(p, v, __ATOMIC_RELAXED, __HIP_MEMORY_SCOPE_AGENT); }
__device__ __forceinline__ unsigned xb_xcc_id() { return (unsigned)__builtin_amdgcn_s_getreg((3 << 11) | 20) & 0xFu; }
#define XB_SPIN(cond, bar) do { unsigned _sp = 0; while (cond) { __builtin_amdgcn_s_sleep(1); \
    if ((++_sp & 255u) == 0u) { if (xb_ld(&(bar)[XB_TMO])) break; if (_sp > XB_SPIN_CAP) { atomicAdd(&(bar)[XB_TMO], 1u); break; } } } } while (0)
struct XcdBarrier { unsigned* bar; unsigned x; volatile LAS unsigned* st; };
__device__ __forceinline__ XcdBarrier xcd_barrier_post(unsigned* bar, volatile LAS unsigned* st) {
    XcdBarrier b; b.bar = bar; b.x = xb_xcc_id(); b.st = st;
    if (threadIdx.x == 0) (void)xb_add(&bar[XB_XCNT(b.x)], 1u);
    return b;
}
__device__ __forceinline__ void xcd_barrier_complete(unsigned* bar, unsigned x, unsigned& nloc, unsigned& nx) {
    const unsigned G = gridDim.x * gridDim.y * gridDim.z;
    unsigned sum, cnt, mine, sp = 0u;
    for (;;) {
        sum = 0u; cnt = 0u; mine = 0u;
#pragma unroll
        for (unsigned j = 0; j < 16; ++j) { const unsigned c = xb_ld(&bar[XB_XCNT(j)]); sum += c; cnt += (c > 0u) ? 1u : 0u; mine = (j == x) ? c : mine; }
        if (sum == G) break;
        __builtin_amdgcn_s_sleep(1);
        if ((++sp & 255u) == 0u) { if (xb_ld(&bar[XB_TMO])) break; if (sp > XB_SPIN_CAP) { atomicAdd(&bar[XB_TMO], 1u); break; } }
    }
    nloc = mine > 0u ? mine : 1u; nx = cnt > 0u ? cnt : 1u;
}
__device__ __forceinline__ void xcd_barrier(const XcdBarrier& b) {
    asm volatile("s_waitcnt vmcnt(0)" ::: "memory");
    __syncthreads();
    if (threadIdx.x == 0) {
        unsigned* bar = b.bar;
        __builtin_amdgcn_s_waitcnt(0);
        unsigned nloc = b.st[0], nx = b.st[1];
        if (nloc == 0u) { xcd_barrier_complete(bar, b.x, nloc, nx); b.st[0] = nloc; b.st[1] = nx; }
        const unsigned old = xb_add(&bar[XB_XSUB(b.x)], 1u);
        const unsigned gen = old / nloc;
        if (old + 1u == (gen + 1u) * nloc) {
            __builtin_amdgcn_fence(__ATOMIC_RELEASE, "agent");
            asm volatile("s_waitcnt vmcnt(0)" ::: "memory");
            const unsigned og = xb_add(&bar[XB_TOP], 1u);
            const unsigned tg = og / nx;
            if (og + 1u == (tg + 1u) * nx) xb_add(&bar[XB_TOPGEN], 1u);
            else XB_SPIN(xb_ld(&bar[XB_TOPGEN]) == tg, bar);
            __builtin_amdgcn_fence(__ATOMIC_ACQUIRE, "agent");
            xb_add(&bar[XB_XGEN(b.x)], 1u);
            asm volatile("s_waitcnt vmcnt(0)" ::: "memory");
        } else {
            XB_SPIN(xb_ld(&bar[XB_XGEN(b.x)]) == gen, bar);
            __builtin_amdgcn_fence(__ATOMIC_ACQUIRE, "agent");
            asm volatile("s_waitcnt vmcnt(0)" ::: "memory");
        }
    }
    __syncthreads();
}

struct Frame {
    LAS unsigned char* lds;
    int tid, lane, wave, G, bid;
    const float *x, *pre_g, *post_g, *w_in, *mu_rkv, *mu_wa, *w0, *w1, *w2, *a0, *a1, *a2, *k_k, *k_a, *r_k, *lnx_g, *lnx_b, *rel_bias, *w_br, *w_ba, *b_merge, *w_out;
    float* out;
    bf16_t *HB, *WIN_T, *WCAT_T, *WOUT_T, *W2T, *A2T, *PA, *PG, *PL, *YCAT, *MERGED, *STATES;
    float *BONUS, *SSP;
    bf16_t* OBF; bf16_t *MD, *ND, *QD; unsigned* queue;
};

__device__ __forceinline__ float wave_sum(float v) {
#pragma unroll
    for (int o = 1; o < 64; o <<= 1) v += __shfl_xor(v, o);
    return v;
}

__device__ __forceinline__ void p0_transpose_item(const float* W, int K, int N, bf16_t* WT, int row_off, LAS float* scr, int item, int lane, const float* mu, float s0, float s1, bool gate_remap = false) {
    const int nblk = N / 32, kb = item / nblk, nb = item % nblk, k0 = 64 * kb, n0 = 32 * nb;
    int d0 = n0; if (gate_remap && n0 >= NPA) { const int g = n0 - NPA, br = g >> 11, j0 = g & 2047; d0 = NPA + 256 * (j0 >> 7) + 128 * br + (j0 & 127); }
    f32x4 v4[8];
#pragma unroll
    for (int i = 0; i < 8; ++i) { const int kk = 8 * i + (lane >> 3); v4[i] = *(const f32x4*)(W + (size_t)(k0 + kk) * N + n0 + (lane & 7) * 4); }
#pragma unroll
    for (int i = 0; i < 8; ++i) { const int kk = 8 * i + (lane >> 3); f32x4 v = v4[i]; if (mu) v = v * (s0 + s1 * mu[k0 + kk]);
        LAS float* d = scr + kk * 33 + (lane & 7) * 4; d[0] = v[0]; d[1] = v[1]; d[2] = v[2]; d[3] = v[3]; }
    LDS_WAIT(); asm volatile("" ::: "memory");
    const int c = lane & 7;
#pragma unroll
    for (int j = 0; j < 4; ++j) { const int n = (lane >> 3) + 8 * j; const LAS float* s = scr + (8 * c) * 33 + n;
        u32x4 o; o.x = pk2(s[0 * 33], s[1 * 33]); o.y = pk2(s[2 * 33], s[3 * 33]); o.z = pk2(s[4 * 33], s[5 * 33]); o.w = pk2(s[6 * 33], s[7 * 33]);
        *(u32x4*)(WT + (size_t)(row_off + d0 + n) * K + k0 + 8 * c) = o; }
    LDS_WAIT(); asm volatile("" ::: "memory");
}
__device__ __forceinline__ void p0_prologue(Frame& F) {
    LAS float* scr = (LAS float*)(F.lds + F.wave * 16384);
    const int gw = F.bid * NWAVES + F.wave, NGW = F.G * NWAVES;
    constexpr int I_IN = (DM / 64) * (NPA + NPG) / 32, I_L = (DM / 64) * (64 / 32), I_BR = (DBR / 64) * (DM / 32), I_OUT = (DM / 64) * (DM / 32), I_W2 = (64 / 64) * (DBR / 32);
    constexpr int NITEMS = I_IN + 4 * I_L + 2 * I_BR + I_OUT + 2 * I_W2;
    for (int it = gw; it < NITEMS; it += NGW) {
        int r = it;
        if (r < I_IN) { p0_transpose_item(F.w_in, DM, NPA + NPG, F.WIN_T, 0, scr, r, F.lane, nullptr, 1.f, 0.f, true); continue; } r -= I_IN;
        if (r < I_L) { p0_transpose_item(F.w1, DM, 64, F.WIN_T, NPA + NPG + 0, scr, r, F.lane, F.mu_wa, 1.f, -1.f); continue; } r -= I_L;
        if (r < I_L) { p0_transpose_item(F.w1, DM, 64, F.WIN_T, NPA + NPG + 64, scr, r, F.lane, F.mu_wa, 0.f, 1.f); continue; } r -= I_L;
        if (r < I_L) { p0_transpose_item(F.a1, DM, 64, F.WIN_T, NPA + NPG + 128, scr, r, F.lane, F.mu_wa + DM, 1.f, -1.f); continue; } r -= I_L;
        if (r < I_L) { p0_transpose_item(F.a1, DM, 64, F.WIN_T, NPA + NPG + 192, scr, r, F.lane, F.mu_wa + DM, 0.f, 1.f); continue; } r -= I_L;
        if (r < I_BR) { p0_transpose_item(F.w_br, DBR, DM, F.WCAT_T, 0, scr, r, F.lane, nullptr, 1.f, 0.f); continue; } r -= I_BR;
        if (r < I_BR) { p0_transpose_item(F.w_ba, DBR, DM, F.WCAT_T, DM, scr, r, F.lane, nullptr, 1.f, 0.f); continue; } r -= I_BR;
        if (r < I_OUT) { p0_transpose_item(F.w_out, DM, DM, F.WOUT_T, 0, scr, r, F.lane, nullptr, 1.f, 0.f); continue; } r -= I_OUT;
        if (r < I_W2) { p0_transpose_item(F.w2, 64, DBR, F.W2T, 0, scr, r, F.lane, nullptr, 1.f, 0.f); continue; } r -= I_W2;
        p0_transpose_item(F.a2, 64, DBR, F.A2T, 0, scr, r, F.lane, nullptr, 1.f, 0.f);
    }
    for (int m = gw; m < M; m += 2 * NGW) {
        const int m2 = (m + NGW < M) ? m + NGW : m;
        const f32x4* xr = (const f32x4*)(F.x + (size_t)m * DM) + F.lane; const f32x4* xr2 = (const f32x4*)(F.x + (size_t)m2 * DM) + F.lane; const f32x4* gr = (const f32x4*)F.pre_g + F.lane;
        f32x4 v[8], w[8]; float s = 0.f, s2 = 0.f;
#pragma unroll
        for (int j = 0; j < 8; ++j) { v[j] = xr[64 * j]; w[j] = xr2[64 * j]; }
#pragma unroll
        for (int j = 0; j < 8; ++j) { s += (v[j].x * v[j].x + v[j].y * v[j].y) + (v[j].z * v[j].z + v[j].w * v[j].w); s2 += (w[j].x * w[j].x + w[j].y * w[j].y) + (w[j].z * w[j].z + w[j].w * w[j].w); }
        const float rstd = 1.0f / sqrtf(wave_sum(s) * (1.f / DM) + NORM_EPS), rstd2 = 1.0f / sqrtf(wave_sum(s2) * (1.f / DM) + NORM_EPS);
        u32x2* o8 = (u32x2*)(F.HB + (size_t)m * DM) + F.lane; u32x2* o82 = (u32x2*)(F.HB + (size_t)m2 * DM) + F.lane;
#pragma unroll
        for (int j = 0; j < 8; ++j) { const f32x4 g = gr[64 * j]; u32x2 a; a.x = pk2(v[j].x * rstd * g.x, v[j].y * rstd * g.y); a.y = pk2(v[j].z * rstd * g.z, v[j].w * rstd * g.w); o8[64 * j] = a;
            u32x2 c; c.x = pk2(w[j].x * rstd2 * g.x, w[j].y * rstd2 * g.y); c.y = pk2(w[j].z * rstd2 * g.z, w[j].w * rstd2 * g.w); o82[64 * j] = c; }
    }
}

constexpr int LSTR = 72;
constexpr int SLOT = 64 * LSTR * 2;
__device__ __forceinline__ f32x4 mm16(const LAS bf16_t* A, int m0, const LAS bf16_t* Bt, int n0, f32x4 acc, int fr, int fq) {
#pragma unroll
    for (int ks = 0; ks < 2; ++ks) {
        const bf16x8 a = *(const LAS bf16x8*)(A + (m0 + fr) * LSTR + ks * 32 + fq * 8);
        const bf16x8 b = *(const LAS bf16x8*)(Bt + (n0 + fr) * LSTR + ks * 32 + fq * 8);
        acc = __builtin_amdgcn_mfma_f32_16x16x32_bf16(a, b, acc, 0, 0, 0);
    }
    return acc;
}

typedef short v4i16_t __attribute__((ext_vector_type(4)));
__device__ __forceinline__ s16x4 tr4(const LAS bf16_t* p) { return __builtin_bit_cast(s16x4, __builtin_amdgcn_ds_read_tr16_b64_v4i16((LAS v4i16_t*)p)); }
__device__ __forceinline__ s16x4 frag_tr16(const LAS bf16_t* X, int k0, int n0, int lane) {
    const int g = lane >> 4, q = (lane & 15) >> 2, p = lane & 3;
    return tr4(X + (k0 + 4 * g + q) * LSTR + n0 + 4 * p);
}
__device__ __forceinline__ bf16x8 frag_tr32(const LAS bf16_t* X, int k0, int n0, int lane) {
    const int g = lane >> 4, q = (lane & 15) >> 2, p = lane & 3;
    const s16x4 lo = tr4(X + (k0 + 8 * g + q) * LSTR + n0 + 4 * p), hi = tr4(X + (k0 + 8 * g + 4 + q) * LSTR + n0 + 4 * p);
    return (bf16x8){lo[0], lo[1], lo[2], lo[3], hi[0], hi[1], hi[2], hi[3]};
}

constexpr int P2_GRP_BYTES = 6 * SLOT + 20 * 64 * 16;
struct KVRegs { u32x4 k0, k1, v0, v1; };
__device__ __forceinline__ void kv_load(KVRegs& R, const bf16_t* p, int key0, int d80, int key1, int d81) {
    R.k0 = *(const u32x4*)(p + (size_t)key0 * NPA + PA_KA + d80); R.k1 = *(const u32x4*)(p + (size_t)key1 * NPA + PA_KA + d81);
    R.v0 = *(const u32x4*)(p + (size_t)key0 * NPA + PA_VA + d80); R.v1 = *(const u32x4*)(p + (size_t)key1 * NPA + PA_VA + d81);
}
__device__ __forceinline__ void kv_store(const KVRegs& R, LAS unsigned char* kvb, int key0, int d80, int key1, int d81) {
    LAS bf16_t* Ks = (LAS bf16_t*)kvb; LAS bf16_t* Vs = (LAS bf16_t*)(kvb + SLOT);
    *(LAS u32x4*)(Ks + key0 * LSTR + d80) = R.k0; *(LAS u32x4*)(Ks + key1 * LSTR + d81) = R.k1; *(LAS u32x4*)(Vs + key0 * LSTR + d80) = R.v0; *(LAS u32x4*)(Vs + key1 * LSTR + d81) = R.v1;
}
constexpr int P2_CPI = 2, P2_NITEMS = BATCH * (NH / 2) * (NCHUNK / P2_CPI);
__device__ __forceinline__ void p2_advance(int cr, int& ci, int& j) { if (j == 8) { ++ci; const int nc = cr * P2_CPI + ci; j = (nc >= 8) ? 0 : 8 - nc; } else ++j; }
__device__ __forceinline__ void p2_attention(Frame& F) {
    const int tid = F.tid, lane = F.lane, wave = F.wave, fr = lane & 15, fq = lane >> 4;
    const int grp = wave >> 2, wq = wave & 3, tg = tid & 255;
    LAS unsigned char* gbase = F.lds + grp * P2_GRP_BYTES;
    LAS f32x4* Tb = (LAS f32x4*)(gbase + 6 * SLOT);
    const int key0 = (tg * 2) >> 3, d80 = ((tg * 2) & 7) * 8, key1 = (tg * 2 + 1) >> 3, d81 = ((tg * 2 + 1) & 7) * 8;
    const float L2E = 1.4426950408889634f;
    volatile LAS int* qslot = (volatile LAS int*)(F.lds + MISC_OFF + 64);
    int hp_prev = -1;
    for (;;) {
        __syncthreads();
        if (tid == 0) *qslot = (int)__hip_atomic_fetch_add(F.queue, 1u, __ATOMIC_RELAXED, __HIP_MEMORY_SCOPE_AGENT);
        __syncthreads();
        const int vb = *qslot;
        if (vb >= P2_NITEMS) break;
        constexpr int NR = NCHUNK / P2_CPI; const int b = vb / (NR * 8), hp = (vb / NR) & 7, cr = vb % NR, h = hp * 2 + grp;
        if (hp != hp_prev) for (int e = tg; e < 20 * 64; e += 256) { const int u = e / 64 - 3, ln = e & 63, lfr = ln & 15, lfq = ln >> 4; f32x4 t4;
#pragma unroll
            for (int r = 0; r < 4; ++r) { int rel = 16 * u + (lfr - 4 * lfq - r); rel = rel < -256 ? -256 : (rel > 256 ? 256 : rel); t4[r] = F.rel_bias[h * 513 + rel + 256]; }
            Tb[e] = t4; }
        hp_prev = hp;
        const float bcst = F.rel_bias[h * 513 + 512];
        const bf16_t* kvbase = F.PA + (size_t)b * SEQ * NPA + h * 64;
        int ci = 0, j = (cr * P2_CPI >= 8) ? 0 : 8 - cr * P2_CPI;
        int lci = ci, lj = j;
        KVRegs RA, RB;
        kv_load(RA, kvbase + (size_t)(cr * P2_CPI + lci - 8 + lj) * 64 * NPA, key0, d80, key1, d81); p2_advance(cr, lci, lj);
        kv_store(RA, gbase, key0, d80, key1, d81);
        kv_load(RA, kvbase + (size_t)(cr * P2_CPI + lci - 8 + lj) * 64 * NPA, key0, d80, key1, d81); p2_advance(cr, lci, lj);
        __syncthreads();
        size_t mrow0 = (size_t)b * SEQ + (size_t)(cr * P2_CPI) * 64;
        bf16x8 qa[2];
#pragma unroll
        for (int ks = 0; ks < 2; ++ks) qa[ks] = *(const bf16x8*)(F.PA + (mrow0 + 16 * wq + fr) * NPA + PA_Q + h * 64 + ks * 32 + fq * 8);
        float mrun = -1e30f, lsum = 0.f; f32x4 o[4];
#pragma unroll
        for (int dt = 0; dt < 4; ++dt) o[dt] = (f32x4){0.f, 0.f, 0.f, 0.f};
        int bufc = 0;
#define P2_STEP(RW, RL) { \
            const bool more1 = (ci < P2_CPI - 1) || (j < 8);                           \
            const bool more2 = lci < P2_CPI;                                           \
            if (more2) { kv_load(RL, kvbase + (size_t)(cr * P2_CPI + lci - 8 + lj) * 64 * NPA, key0, d80, key1, d81); p2_advance(cr, lci, lj); } \
            const LAS bf16_t* Ks = (const LAS bf16_t*)(gbase + bufc * 2 * SLOT); const LAS bf16_t* Vs = (const LAS bf16_t*)(gbase + bufc * 2 * SLOT + SLOT); \
            f32x4 s[4]; \
            _Pragma("unroll") for (int nt = 0; nt < 4; ++nt) { const int u = wq - nt + 4 * (8 - j); \
                s[nt] = (u >= 17) ? (f32x4){bcst, bcst, bcst, bcst} : Tb[(u + 3) * 64 + lane]; } \
            _Pragma("unroll") for (int ks = 0; ks < 2; ++ks) _Pragma("unroll") for (int nt = 0; nt < 4; ++nt) { const bf16x8 kb = *(const LAS bf16x8*)(Ks + (16 * nt + fr) * LSTR + ks * 32 + fq * 8); \
                    s[nt] = __builtin_amdgcn_mfma_f32_16x16x32_bf16(kb, qa[ks], s[nt], 0, 0, 0); }     \
            float rmax = fmaxf(fmaxf(s[0][0], s[0][1]), fmaxf(s[0][2], s[0][3])); \
            _Pragma("unroll") for (int nt = 1; nt < 4; ++nt) rmax = fmaxf(rmax, fmaxf(fmaxf(s[nt][0], s[nt][1]), fmaxf(s[nt][2], s[nt][3]))); \
            rmax = fmaxf(rmax, __shfl_xor(rmax, 16)); rmax = fmaxf(rmax, __shfl_xor(rmax, 32)); \
            const float mn = fmaxf(mrun, rmax); const float alpha = __builtin_amdgcn_exp2f((mrun - mn) * L2E); mrun = mn; \
            const float mnl = mn * L2E; float ps = 0.f; \
            _Pragma("unroll") for (int nt = 0; nt < 4; ++nt) _Pragma("unroll") for (int r = 0; r < 4; ++r) { s[nt][r] = __builtin_amdgcn_exp2f(fmaf(s[nt][r], L2E, -mnl)); ps += s[nt][r]; } \
            lsum = lsum * alpha + ps; \
            _Pragma("unroll") for (int dt = 0; dt < 4; ++dt) o[dt] = o[dt] * alpha; \
            bf16x8 pb[2]; \
            _Pragma("unroll") for (int ks = 0; ks < 2; ++ks) { u32x4 w; w.x = pk2(s[2 * ks][0], s[2 * ks][1]); w.y = pk2(s[2 * ks][2], s[2 * ks][3]); w.z = pk2(s[2 * ks + 1][0], s[2 * ks + 1][1]); w.w = pk2(s[2 * ks + 1][2], s[2 * ks + 1][3]); pb[ks] = __builtin_bit_cast(bf16x8, w); } \
            _Pragma("unroll") for (int ks = 0; ks < 2; ++ks) _Pragma("unroll") for (int dt = 0; dt < 4; ++dt) { const s16x4 v0 = frag_tr16(Vs, 32 * ks, 16 * dt, lane), v1 = frag_tr16(Vs, 32 * ks + 16, 16 * dt, lane); \
                    const bf16x8 va = (bf16x8){v0[0], v0[1], v0[2], v0[3], v1[0], v1[1], v1[2], v1[3]}; \
                    o[dt] = __builtin_amdgcn_mfma_f32_16x16x32_bf16(va, pb[ks], o[dt], 0, 0, 0); } \
            if (j == 8) { \
                float l = lsum; l += __shfl_xor(l, 16); l += __shfl_xor(l, 32); \
                const float inv = 1.0f / l; const size_t m = mrow0 + 16 * wq + fr; \
                _Pragma("unroll") for (int dt = 0; dt < 4; ++dt) { const int col = h * 64 + 16 * dt + 4 * fq; \
                    const u32x2 zw = *(const u32x2*)(F.PA + m * NPA + PA_ZA + col); \
                    const float z0 = bflo(zw.x), z1 = bfhi(zw.x), z2 = bflo(zw.y), z3 = bfhi(zw.y); \
                    u32x2 yw; yw.x = pk2(o[dt][0] * inv * z0 * sigmoidf_(z0), o[dt][1] * inv * z1 * sigmoidf_(z1)); yw.y = pk2(o[dt][2] * inv * z2 * sigmoidf_(z2), o[dt][3] * inv * z3 * sigmoidf_(z3)); \
                    *(u32x2*)(F.YCAT + ((size_t)M + m) * DBR + col) = yw; } \
                if (more1) { \
                    mrow0 = (size_t)b * SEQ + (size_t)(cr * P2_CPI + ci + 1) * 64; \
                    _Pragma("unroll") for (int ks = 0; ks < 2; ++ks) qa[ks] = *(const bf16x8*)(F.PA + (mrow0 + 16 * wq + fr) * NPA + PA_Q + h * 64 + ks * 32 + fq * 8); \
                    mrun = -1e30f; lsum = 0.f; \
                    _Pragma("unroll") for (int dt = 0; dt < 4; ++dt) o[dt] = (f32x4){0.f, 0.f, 0.f, 0.f}; \
                } \
            } \
            const int bufn = (bufc == 2) ? 0 : bufc + 1; \
            if (more1) kv_store(RW, gbase + bufn * 2 * SLOT, key0, d80, key1, d81); \
            __syncthreads(); \
            if (!more1) break; \
            p2_advance(cr, ci, j); bufc = bufn; }
        for (;;) {
            P2_STEP(RA, RB)
            P2_STEP(RB, RA)
        }
#undef P2_STEP
    }
}

constexpr int FSTR = 68;
constexpr int DSTR = 24;
__device__ __forceinline__ f32x4 mfma16(s16x4 a, s16x4 b, f32x4 c) {
    const bf16x8 a8 = (bf16x8){a[0], a[1], a[2], a[3], 0, 0, 0, 0}, b8 = (bf16x8){b[0], b[1], b[2], b[3], 0, 0, 0, 0};
    return __builtin_amdgcn_mfma_f32_16x16x32_bf16(a8, b8, c, 0, 0, 0); }
__device__ __forceinline__ s16x4 cvt_hi(const f32x4 v) { u32x2 w; w.x = pk2(v[0], v[1]); w.y = pk2(v[2], v[3]); return __builtin_bit_cast(s16x4, w); }
__device__ __forceinline__ s16x4 cvt_lo(const f32x4 v, const s16x4 hi) { const u32x2 h = __builtin_bit_cast(u32x2, hi);
    u32x2 w; w.x = pk2(v[0] - bflo(h.x), v[1] - bfhi(h.x)); w.y = pk2(v[2] - bflo(h.y), v[3] - bfhi(h.y)); return __builtin_bit_cast(s16x4, w); }
struct P3Loads { u32x4 w2, a2, pr, pk, pv, qr, qk, qv; f32x4 mur[2], muk[2], muv[2], kkp[2], kap[2], rkp[2]; };
__device__ __forceinline__ void p3_load(Frame& F, P3Loads& G, int h, size_t m, int t_e, int c8, bool hasprev) {
    const u32x4 zero4 = (u32x4){0u, 0u, 0u, 0u};
    G.w2 = *(const u32x4*)(F.W2T + (size_t)(h * 64 + t_e) * 64 + c8); G.a2 = *(const u32x4*)(F.A2T + (size_t)(h * 64 + t_e) * 64 + c8);
    const bf16_t* rowp = F.PA + m * NPA + h * 64 + c8;
    G.pr = *(const u32x4*)(rowp + PA_R); G.pk = *(const u32x4*)(rowp + PA_K); G.pv = *(const u32x4*)(rowp + PA_V);
    G.qr = hasprev ? *(const u32x4*)(rowp - NPA + PA_R) : zero4; G.qk = hasprev ? *(const u32x4*)(rowp - NPA + PA_K) : zero4; G.qv = hasprev ? *(const u32x4*)(rowp - NPA + PA_V) : zero4;
    const int ch0 = h * 64 + c8;
#pragma unroll
    for (int q = 0; q < 2; ++q) { G.mur[q] = *(const f32x4*)(F.mu_rkv + ch0 + 4 * q); G.muk[q] = *(const f32x4*)(F.mu_rkv + DBR + ch0 + 4 * q); G.muv[q] = *(const f32x4*)(F.mu_rkv + 2 * DBR + ch0 + 4 * q);
        G.kkp[q] = *(const f32x4*)(F.k_k + ch0 + 4 * q); G.kap[q] = *(const f32x4*)(F.k_a + ch0 + 4 * q); G.rkp[q] = *(const f32x4*)(F.r_k + ch0 + 4 * q); }
}
__device__ __forceinline__ void p3_prep(Frame& F) {
    const int wave = F.wave;
    LAS unsigned char* L = F.lds;
    LAS bf16_t* X_A = (LAS bf16_t*)(L + 0 * SLOT);
    LAS bf16_t* X_B = (LAS bf16_t*)(L + 1 * SLOT);
    LAS bf16_t* X_K = (LAS bf16_t*)(L + 2 * SLOT);
    LAS bf16_t* X_R = (LAS bf16_t*)(L + 3 * SLOT);
    LAS bf16_t* X_V = (LAS bf16_t*)(L + 4 * SLOT);
    LAS bf16_t* S_TW = (LAS bf16_t*)(L + 5 * SLOT);
    LAS bf16_t* S_TA = (LAS bf16_t*)(L + 6 * SLOT);
    LAS bf16_t* A_AB = (LAS bf16_t*)(L + 7 * SLOT);
    LAS bf16_t* A_AK = (LAS bf16_t*)(L + 8 * SLOT);
    LAS bf16_t* A_RB = (LAS bf16_t*)(L + 9 * SLOT);
    LAS bf16_t* A_RK = (LAS bf16_t*)(L + 10 * SLOT);
    LAS bf16_t* DB = (LAS bf16_t*)(L + 11 * SLOT);
    LAS float* CLf = (LAS float*)(L + 12 * SLOT);
    LAS float* Af = CLf + 64 * FSTR;
    LAS float* GL = Af + 64 * FSTR;
    LAS bf16_t* ST_Q = A_AK; LAS bf16_t* ST_Y = X_A; LAS bf16_t* ST_M = X_V; LAS bf16_t* ST_N = (LAS bf16_t*)CLf;
    const int mt = wave >> 1, ntb = (wave & 1) * 2;
    for (int vb = F.bid; vb < 256; vb += F.G) {
        const int b = vb >> 7, c = vb & 127; const size_t mrow0 = (size_t)b * SEQ + (size_t)c * 64;
        {
            const int t_e = F.tid >> 3, c8 = (F.tid & 7) * 8; const size_t m = mrow0 + t_e; const bool hasprev = (c > 0) || (t_e > 0);
            const u32x4 zero4 = (u32x4){0u, 0u, 0u, 0u};
            float sw[8], sa[8];
#pragma unroll
            for (int e = 0; e < 8; ++e) { sw[e] = 0.f; sa[e] = 0.f; }
#pragma unroll
            for (int q = 0; q < 4; ++q) { const bf16_t* slab = F.PL + (size_t)q * ((size_t)M * NPL);
                const u32x4 g_law = *(const u32x4*)(slab + m * NPL + 0 + c8), g_laa = *(const u32x4*)(slab + m * NPL + 128 + c8);
                const u32x4 g_lbw = hasprev ? *(const u32x4*)(slab + (m - 1) * NPL + 64 + c8) : zero4, g_lba = hasprev ? *(const u32x4*)(slab + (m - 1) * NPL + 192 + c8) : zero4;
                float law[8], laa[8], lbw[8], lba[8];
                unpack8(g_law, law); unpack8(g_laa, laa); unpack8(g_lbw, lbw); unpack8(g_lba, lba);
#pragma unroll
                for (int e = 0; e < 8; ++e) { sw[e] += law[e] + lbw[e]; sa[e] += laa[e] + lba[e]; } }
            float tw[8], ta[8];
#pragma unroll
            for (int e = 0; e < 8; ++e) { tw[e] = tanhf_(sw[e]); ta[e] = sa[e]; }
            __syncthreads();
            *(LAS u32x4*)(S_TW + t_e * LSTR + c8) = pack8(tw); *(LAS u32x4*)(S_TA + t_e * LSTR + c8) = pack8(ta);
        }
        P3Loads G; p3_load(F, G, 0, mrow0 + (F.tid >> 3), F.tid >> 3, (F.tid & 7) * 8, (c > 0) || ((F.tid >> 3) > 0));
        for (int h = 0; h < NH; ++h) {
            int tid = F.tid; asm volatile("" : "+v"(tid));
            const int lane = tid & 63, fr = lane & 15, fq = lane >> 4;
            const int t_e = tid >> 3, c8 = (tid & 7) * 8;
            const size_t m = mrow0 + t_e; const bool hasprev = (c > 0) || (t_e > 0);
            const u32x4 g_w2 = G.w2, g_a2 = G.a2, g_pr = G.pr, g_pk = G.pk, g_pv = G.pv, g_qr = G.qr, g_qk = G.qk, g_qv = G.qv;
            float mur[8], muk[8], muv[8], kkp[8], kap[8], rkp[8];
#pragma unroll
            for (int e = 0; e < 8; ++e) { mur[e] = G.mur[e >> 2][e & 3]; muk[e] = G.muk[e >> 2][e & 3]; muv[e] = G.muv[e >> 2][e & 3]; kkp[e] = G.kkp[e >> 2][e & 3]; kap[e] = G.kap[e >> 2][e & 3]; rkp[e] = G.rkp[e >> 2][e & 3]; }
            __syncthreads();
            *(LAS u32x4*)(A_AB + t_e * LSTR + c8) = g_w2; *(LAS u32x4*)(A_AK + t_e * LSTR + c8) = g_a2;
            __syncthreads();
            {
                const int ctile = wave & 3, ch = 16 * ctile + fr; const bool isw = wave < 4;
                const LAS bf16_t* Asrc = isw ? S_TW : S_TA; const LAS bf16_t* Bsrc = isw ? A_AB : A_AK;
                bf16x8 bw[2];
#pragma unroll
                for (int ks = 0; ks < 2; ++ks) bw[ks] = *(const LAS bf16x8*)(Bsrc + ch * LSTR + ks * 32 + fq * 8);
                f32x4 d[4];
#pragma unroll
                for (int mt4 = 0; mt4 < 4; ++mt4) d[mt4] = (f32x4){0.f, 0.f, 0.f, 0.f};
#pragma unroll
                for (int ks = 0; ks < 2; ++ks)
#pragma unroll
                    for (int mt4 = 0; mt4 < 4; ++mt4) d[mt4] = __builtin_amdgcn_mfma_f32_16x16x32_bf16(*(const LAS bf16x8*)(Asrc + (16 * mt4 + fr) * LSTR + ks * 32 + fq * 8), bw[ks], d[mt4], 0, 0, 0);
                const float b0v = isw ? F.w0[h * 64 + ch] : F.a0[h * 64 + ch];
                if (isw) {
                    float base = 0.f;
#pragma unroll
                    for (int mt4 = 0; mt4 < 4; ++mt4) {
                        f32x4 p;
#pragma unroll
                        for (int r = 0; r < 4; ++r) p[r] = -DECAY_SCALE * sigmoidf_(b0v + d[mt4][r]);
                        p[1] += p[0]; p[2] += p[1]; p[3] += p[2];
                        const float T = p[3];
                        const float x1 = __shfl_up(T, 16), x2 = __shfl_up(T, 32), x3 = __shfl_up(T, 48);
                        const float pf = ((fq >= 1) ? x1 : 0.f) + ((fq >= 2) ? x2 : 0.f) + ((fq >= 3) ? x3 : 0.f);
                        const float S = __shfl(pf + T, fr + 48);
#pragma unroll
                        for (int r = 0; r < 4; ++r) CLf[(16 * mt4 + 4 * fq + r) * FSTR + ch] = base + pf + p[r];
                        base += S;
                    }
                } else {
#pragma unroll
                    for (int mt4 = 0; mt4 < 4; ++mt4)
#pragma unroll
                        for (int r = 0; r < 4; ++r) Af[(16 * mt4 + 4 * fq + r) * FSTR + ch] = sigmoidf_(b0v + d[mt4][r]);
                }
            }
            __syncthreads();
            {
                float pr[8], pk[8], pv[8], qr[8], qk[8], qv[8];
                unpack8(g_pr, pr); unpack8(g_pk, pk); unpack8(g_pv, pv); unpack8(g_qr, qr); unpack8(g_qk, qk); unpack8(g_qv, qv);
                float rr[8], kk[8], vv[8], kn[8], av[8], cl[8], clp[8]; float nrm = 0.f;
#pragma unroll
                for (int e = 0; e < 8; ++e) {
                    rr[e] = pr[e] + (qr[e] - pr[e]) * mur[e]; kk[e] = pk[e] + (qk[e] - pk[e]) * muk[e]; vv[e] = pv[e] + (qv[e] - pv[e]) * muv[e];
                    kn[e] = kk[e] * kkp[e]; nrm += kn[e] * kn[e];
                    av[e] = Af[t_e * FSTR + c8 + e]; cl[e] = CLf[t_e * FSTR + c8 + e]; clp[e] = (t_e > 0) ? CLf[(t_e - 1) * FSTR + c8 + e] : 0.f; }
                nrm += __shfl_xor(nrm, 1); nrm += __shfl_xor(nrm, 2); nrm += __shfl_xor(nrm, 4);
                const float inrm = 1.0f / fmaxf(sqrtf(nrm), 1e-12f);
                float at_[8], bt_[8], kt_[8], rt_[8]; float bon = 0.f;
#pragma unroll
                for (int e = 0; e < 8; ++e) {
                    const float kkn = kn[e] * inrm; const float kmod = kk[e] * (1.0f + (av[e] - 1.0f) * kap[e]);
                    const float gin = __expf(cl[e]), gex = __expf(clp[e]), ginv = __expf(-cl[e]);
                    at_[e] = -kkn * gex; bt_[e] = kkn * av[e] * ginv; kt_[e] = kmod * ginv; rt_[e] = rr[e] * gin;
                    bon += rr[e] * kmod * rkp[e]; }
                bon += __shfl_xor(bon, 1); bon += __shfl_xor(bon, 2); bon += __shfl_xor(bon, 4);
                if ((tid & 7) == 0) F.BONUS[m * NH + h] = bon;
                if (t_e == 63) {
#pragma unroll
                    for (int e = 0; e < 8; ++e) GL[c8 + e] = __expf(cl[e]); }
                *(LAS u32x4*)(X_A + t_e * LSTR + c8) = pack8(at_); *(LAS u32x4*)(X_B + t_e * LSTR + c8) = pack8(bt_);
                *(LAS u32x4*)(X_K + t_e * LSTR + c8) = pack8(kt_); *(LAS u32x4*)(X_R + t_e * LSTR + c8) = pack8(rt_);
                *(LAS u32x4*)(X_V + t_e * LSTR + c8) = pack8(vv);
            }
            __syncthreads();
            if (h + 1 < NH) p3_load(F, G, h + 1, m, t_e, c8, hasprev);
#pragma unroll
            for (int q = 0; q < 2; ++q) { const int it = mt, tt = ntb + q; const int t = 16 * tt + fr, i0 = 16 * it + 4 * fq;
                const f32x4 z4 = (f32x4){0.f, 0.f, 0.f, 0.f};
                const f32x4 d_ab = mm16(X_B, 16 * it, X_A, 16 * tt, z4, fr, fq), d_ak = mm16(X_K, 16 * it, X_A, 16 * tt, z4, fr, fq);
                const f32x4 d_rb = mm16(X_B, 16 * it, X_R, 16 * tt, z4, fr, fq), d_rk = mm16(X_K, 16 * it, X_R, 16 * tt, z4, fr, fq);
                f32x4 e_ab, e_ak, e_rb, e_rk;
#pragma unroll
                for (int r = 0; r < 4; ++r) { const int i = i0 + r; e_ab[r] = (i < t) ? d_ab[r] : 0.f; e_ak[r] = (i < t) ? d_ak[r] : 0.f; e_rb[r] = (i <= t) ? d_rb[r] : 0.f; e_rk[r] = (i <= t) ? d_rk[r] : 0.f; }
                *(LAS s16x4*)(A_AB + t * LSTR + i0) = cvt_hi(e_ab); *(LAS s16x4*)(A_AK + t * LSTR + i0) = cvt_hi(e_ak);
                *(LAS s16x4*)(A_RB + t * LSTR + i0) = cvt_hi(e_rb); *(LAS s16x4*)(A_RK + t * LSTR + i0) = cvt_hi(e_rk); }
            __syncthreads();
            f32x4 rhs[4]; bf16x8 vf[2];
            const int ct = wave & 3;
            if (wave < 4) {
                const s16x4 a_t = *(const LAS s16x4*)(A_AB + (16 * wave + fr) * LSTR + 16 * wave + 4 * fq);
                const s16x4 a_c = frag_tr16(A_AB, 16 * wave, 16 * wave, lane);
                const f32x4 z4 = (f32x4){0.f, 0.f, 0.f, 0.f};
                f32x4 iden;
#pragma unroll
                for (int r = 0; r < 4; ++r) iden[r] = (4 * fq + r == fr) ? 1.0f : 0.0f;
                const u32x2 atw = __builtin_bit_cast(u32x2, a_t), acw = __builtin_bit_cast(u32x2, a_c);
                f32x4 Sc = iden + (f32x4){bflo(acw.x), bfhi(acw.x), bflo(acw.y), bfhi(acw.y)}, St = iden + (f32x4){bflo(atw.x), bfhi(atw.x), bflo(atw.y), bfhi(atw.y)};
                f32x4 Pc = mfma16(a_t, a_c, z4), Pt = mfma16(a_c, a_t, z4);
#pragma unroll
                for (int lvl = 0; lvl < 3; ++lvl) {
                    const s16x4 pt = cvt_hi(Pt), pc = cvt_hi(Pc);
                    const s16x4 sh = cvt_hi(Sc), sl = cvt_lo(Sc, sh);
                    const f32x4 Sc2 = mfma16(pt, sl, mfma16(pt, sh, Sc)), St2 = mfma16(sl, pt, mfma16(sh, pt, St));
                    Sc = Sc2; St = St2;
                    if (lvl < 2) { const f32x4 Pc2 = mfma16(pt, pc, z4), Pt2 = mfma16(pc, pt, z4); Pc = Pc2; Pt = Pt2; }
                }
                *(LAS s16x4*)(DB + (16 * wave + fr) * DSTR + 4 * fq) = cvt_hi(St);
#pragma unroll
                for (int bi = 0; bi < 4; ++bi)
#pragma unroll
                    for (int r = 0; r < 4; ++r) rhs[bi][r] = bf2f(X_A[(16 * bi + 4 * fq + r) * LSTR + 16 * ct + fr]);
                vf[0] = (bf16x8){0, 0, 0, 0, 0, 0, 0, 0}; vf[1] = vf[0];
            } else {
#pragma unroll
                for (int ks = 0; ks < 2; ++ks) vf[ks] = frag_tr32(X_V, ks * 32, 16 * ct, lane);
#pragma unroll
                for (int bi = 0; bi < 4; ++bi) rhs[bi] = (f32x4){0.f, 0.f, 0.f, 0.f};
#pragma unroll
                for (int ks = 0; ks < 2; ++ks)
#pragma unroll
                    for (int bi = 0; bi < 4; ++bi) rhs[bi] = __builtin_amdgcn_mfma_f32_16x16x32_bf16(*(const LAS bf16x8*)(A_AK + (16 * bi + fr) * LSTR + ks * 32 + fq * 8), vf[ks], rhs[bi], 0, 0, 0);
            }
            __syncthreads();
            s16x4 xb[4];
#pragma unroll
            for (int bi = 0; bi < 4; ++bi) {
                f32x4 acc = rhs[bi];
#pragma unroll
                for (int bj = 0; bj < 4; ++bj) if (bj < bi) acc = mfma16(*(const LAS s16x4*)(A_AB + (16 * bi + fr) * LSTR + 16 * bj + 4 * fq), xb[bj], acc);
                const s16x4 hi = cvt_hi(acc), lo = cvt_lo(acc, hi); const s16x4 df = *(const LAS s16x4*)(DB + (16 * bi + fr) * DSTR + 4 * fq);
                f32x4 x = mfma16(df, hi, (f32x4){0.f, 0.f, 0.f, 0.f}); x = mfma16(df, lo, x);
                xb[bi] = cvt_hi(x);
            }
            const int col = 16 * ct + fr; const int c4 = 16 * ct + 4 * fq;
            {
                f32x4 acc[4];
#pragma unroll
                for (int bi = 0; bi < 4; ++bi) { const int t = 16 * bi + fr;
                    if (wave < 4) { const u32x2 rw = *(const LAS u32x2*)(X_R + t * LSTR + c4); acc[bi] = (f32x4){bflo(rw.x), bfhi(rw.x), bflo(rw.y), bfhi(rw.y)}; }
                    else acc[bi] = (f32x4){0.f, 0.f, 0.f, 0.f}; }
                if (wave >= 4) {
#pragma unroll
                    for (int ks = 0; ks < 2; ++ks)
#pragma unroll
                        for (int bi = 0; bi < 4; ++bi) acc[bi] = __builtin_amdgcn_mfma_f32_16x16x32_bf16(vf[ks], *(const LAS bf16x8*)(A_RK + (16 * bi + fr) * LSTR + ks * 32 + fq * 8), acc[bi], 0, 0, 0);
                }
#pragma unroll
                for (int bj = 0; bj < 4; ++bj)
#pragma unroll
                    for (int bi = 0; bi < 4; ++bi) if (bj <= bi) acc[bi] = mfma16(xb[bj], *(const LAS s16x4*)(A_RB + (16 * bi + fr) * LSTR + 16 * bj + 4 * fq), acc[bi]);
#pragma unroll
                for (int bi = 0; bi < 4; ++bi) { const int t = 16 * bi + fr; const s16x4 o4 = cvt_hi(acc[bi]);
                    if (wave < 4) *(LAS s16x4*)(ST_Q + t * LSTR + c4) = o4; else *(LAS s16x4*)(ST_Y + t * LSTR + c4) = o4; }
            }
            {
                f32x4 acc[4];
#pragma unroll
                for (int mk = 0; mk < 4; ++mk) acc[mk] = (f32x4){0.f, 0.f, 0.f, 0.f};
                if (wave < 4) {
#pragma unroll
                    for (int bj = 0; bj < 4; ++bj)
#pragma unroll
                        for (int mk = 0; mk < 4; ++mk) acc[mk] = mfma16(xb[bj], frag_tr16(X_B, 16 * bj, 16 * mk, lane), acc[mk]);
#pragma unroll
                    for (int mk = 0; mk < 4; ++mk) { const int k = 16 * mk + fr; const float gl = GL[k]; f32x4 v = acc[mk];
#pragma unroll
                        for (int r = 0; r < 4; ++r) v[r] = gl * (v[r] + ((k == c4 + r) ? 1.0f : 0.0f));
                        *(LAS s16x4*)(ST_M + k * LSTR + 32 * (ct >> 1) + 8 * fq + 4 * (ct & 1)) = cvt_hi(v); }
                } else {
#pragma unroll
                    for (int ks = 0; ks < 2; ++ks)
#pragma unroll
                        for (int mk = 0; mk < 4; ++mk) acc[mk] = __builtin_amdgcn_mfma_f32_16x16x32_bf16(frag_tr32(X_K, ks * 32, 16 * mk, lane), vf[ks], acc[mk], 0, 0, 0);
#pragma unroll
                    for (int bj = 0; bj < 4; ++bj)
#pragma unroll
                        for (int mk = 0; mk < 4; ++mk) acc[mk] = mfma16(frag_tr16(X_B, 16 * bj, 16 * mk, lane), xb[bj], acc[mk]);
#pragma unroll
                    for (int mk = 0; mk < 4; ++mk) { const f32x4 gl4 = *(const LAS f32x4*)(GL + 16 * mk + 4 * fq);
                        *(LAS s16x4*)(ST_N + col * LSTR + 16 * mk + 4 * fq) = cvt_hi(acc[mk] * gl4); }
                }
            }
            __syncthreads();
            { const size_t mr = mrow0 + t_e;
              const size_t ub = (size_t)((b * NH + h) * NCHUNK + c) * 4096 + t_e * 64 + c8;
              *(u32x4*)(F.QD + ub) = *(const LAS u32x4*)(ST_Q + t_e * LSTR + c8);
              *(u32x4*)(F.YCAT + mr * DBR + h * 64 + c8) = *(const LAS u32x4*)(ST_Y + t_e * LSTR + c8);
              *(u32x4*)(F.MD + ub) = *(const LAS u32x4*)(ST_M + t_e * LSTR + c8);
              *(u32x4*)(F.ND + ub) = *(const LAS u32x4*)(ST_N + t_e * LSTR + c8); }
        }
    }
}

struct ScanBuf { u32x4 m[4][2]; u32x2 nn[4]; };
__device__ __forceinline__ void scan_load(ScanBuf& B, const bf16_t* PA, size_t mrow0, int h, int v, int fr, int fq) {
#pragma unroll
    for (int i = 0; i < 4; ++i) { const bf16_t* mrowp = PA + (mrow0 + 16 * i + fr) * NPA + PA_KA + h * 64;
#pragma unroll
        for (int ks = 0; ks < 2; ++ks) B.m[i][ks] = *(const u32x4*)(mrowp + 32 * ks + 8 * fq);
        B.nn[i] = *(const u32x2*)(PA + (mrow0 + v) * NPA + PA_VA + h * 64 + 16 * i + 4 * fq); }
}
__device__ __forceinline__ void scan_step(f32x4 (&st)[4], const ScanBuf& B, bf16_t* sp, int fq) {
    u32x2 pk[4];
#pragma unroll
    for (int i = 0; i < 4; ++i) { pk[i].x = pk2(st[i][0], st[i][1]); pk[i].y = pk2(st[i][2], st[i][3]); *(u32x2*)(sp + 16 * i + 4 * fq) = pk[i]; }
    bf16x8 bfr[2];
#pragma unroll
    for (int ks = 0; ks < 2; ++ks) { u32x4 w; w.x = pk[2 * ks].x; w.y = pk[2 * ks].y; w.z = pk[2 * ks + 1].x; w.w = pk[2 * ks + 1].y; bfr[ks] = __builtin_bit_cast(bf16x8, w); }
#pragma unroll
    for (int i = 0; i < 4; ++i) { f32x4 n; n[0] = bflo(B.nn[i].x); n[1] = bfhi(B.nn[i].x); n[2] = bflo(B.nn[i].y); n[3] = bfhi(B.nn[i].y);
#pragma unroll
        for (int ks = 0; ks < 2; ++ks) n = __builtin_amdgcn_mfma_f32_16x16x32_bf16(__builtin_bit_cast(bf16x8, B.m[i][ks]), bfr[ks], n, 0, 0, 0);
        st[i] = n; }
}
constexpr int SC_NST = 2;
constexpr int SC_STEP_BYTES = 8192 + 2048, SC_SLOT_BYTES = SC_NST * SC_STEP_BYTES, SC_NSLOT = 6;
constexpr int SC_SO_OFF = SC_NSLOT * SC_SLOT_BYTES, SC_SO_STEP = 16 * LSTR * 2, SC_SO_SLOT = SC_NST * SC_SO_STEP;
__device__ __forceinline__ void scan_dma(Frame& F, int wave, int lane, int it, LAS unsigned char* slot, size_t row0, int h, int vt) {
    const int r8 = lane >> 3, cg = ((lane & 7) ^ r8) * 8;
#pragma unroll
    for (int q = 0; q < 4; ++q) { const int j = (wave - 1) + 5 * q;
        { const int st = j / 10, w10 = j % 10; const size_t ubase = row0;
            const bf16_t* g = (w10 < 8) ? F.MD + ubase + (size_t)(SC_NST * it + st) * 4096 + (8 * w10 + r8) * 64 + cg : F.ND + ubase + (size_t)(SC_NST * it + st) * 4096 + (16 * vt + 8 * (w10 - 8) + r8) * 64 + cg;
            __builtin_amdgcn_global_load_lds((const unsigned*)g, (LAS unsigned*)(slot + st * SC_STEP_BYTES + w10 * 1024), 16, 0, 0); } }
}
__device__ __forceinline__ void scan_flush(int L2, int it, const LAS unsigned char* so, bf16_t* sp0v0) {
#pragma unroll
    for (int st = 0; st < SC_NST; ++st) { const int rr = (L2 >> 3) & 15, ch = L2 & 7;
        *(u32x4*)(sp0v0 + (size_t)(SC_NST * it + st) * 4096 + rr * 64 + ch * 8) = *(const LAS u32x4*)(so + st * SC_SO_STEP + rr * (LSTR * 2) + ch * 16); }
}
__device__ __forceinline__ void p4_scan(Frame& F) {
    const int lane = F.lane, wave = F.wave, fr = lane & 15, fq = lane >> 4;
    constexpr int NIT = NCHUNK / SC_NST;
    for (int vb = F.bid; vb < 128; vb += F.G) {
        const int b = vb >> 6, h = (vb >> 2) & 15, vt = vb & 3;
        const size_t row0 = (size_t)((b * NH + h) * NCHUNK) * 4096;
        const int L = (wave - 1) * 64 + lane;
        bf16_t* sp0v0 = F.STATES + ((size_t)((b * NH + h) * NCHUNK)) * 4096 + (16 * vt) * 64;
        __syncthreads();
        if (wave >= 1 && wave <= 5) {
#pragma unroll
            for (int p = 0; p < 5; ++p) scan_dma(F, wave, lane, p, F.lds + p * SC_SLOT_BYTES, row0, h, vt);
        }
        asm volatile("s_waitcnt vmcnt(0)\n\ts_barrier" ::: "memory");
        f32x4 st[4];
#pragma unroll
        for (int i = 0; i < 4; ++i) st[i] = (f32x4){0.f, 0.f, 0.f, 0.f};
        int cur = 0, cur3 = 0;
        for (int it = 0; it < NIT; ++it) {
            if (wave >= 6) {
                if (it >= 1) scan_flush(L - 320, it - 1, F.lds + SC_SO_OFF + ((cur3 == 0) ? 2 : cur3 - 1) * SC_SO_SLOT, sp0v0);
            } else if (wave >= 1) {
                const int s5 = (cur == 0) ? 5 : cur - 1;
                if (it + 5 < NIT) scan_dma(F, wave, lane, it + 5, F.lds + s5 * SC_SLOT_BYTES, row0, h, vt);
                asm volatile("s_waitcnt vmcnt(16)" ::: "memory");
            } else {
                const LAS unsigned char* slot = F.lds + cur * SC_SLOT_BYTES; LAS unsigned char* so = F.lds + SC_SO_OFF + cur3 * SC_SO_SLOT;
#pragma unroll
                for (int s4 = 0; s4 < SC_NST; ++s4) {
                    u32x2 pk[4];
#pragma unroll
                    for (int i = 0; i < 4; ++i) { pk[i].x = pk2(st[i][0], st[i][1]); pk[i].y = pk2(st[i][2], st[i][3]); *(LAS u32x2*)(so + s4 * SC_SO_STEP + fr * (LSTR * 2) + (16 * i + 4 * fq) * 2) = pk[i]; }
                    bf16x8 bfr[2];
#pragma unroll
                    for (int ks = 0; ks < 2; ++ks) { u32x4 w; w.x = pk[2 * ks].x; w.y = pk[2 * ks].y; w.z = pk[2 * ks + 1].x; w.w = pk[2 * ks + 1].y; bfr[ks] = __builtin_bit_cast(bf16x8, w); }
                    f32x4 nw[4];
#pragma unroll
                    for (int i = 0; i < 4; ++i) {
                        const u32x2 nn = *(const LAS u32x2*)(slot + s4 * SC_STEP_BYTES + 8192 + fr * 128 + (((2 * i + (fq >> 1)) ^ (fr & 7)) * 16) + (fq & 1) * 8);
                        nw[i] = (f32x4){bflo(nn.x), bfhi(nn.x), bflo(nn.y), bfhi(nn.y)}; }
#pragma unroll
                    for (int ks = 0; ks < 2; ++ks)
#pragma unroll
                        for (int i = 0; i < 4; ++i) { const u32x4 mf = *(const LAS u32x4*)(slot + s4 * SC_STEP_BYTES + (16 * i + fr) * 128 + (((4 * ks + fq) ^ (fr & 7)) * 16));
                            nw[i] = __builtin_amdgcn_mfma_f32_16x16x32_bf16(__builtin_bit_cast(bf16x8, mf), bfr[ks], nw[i], 0, 0, 0); }
#pragma unroll
                    for (int i = 0; i < 4; ++i) st[i] = nw[i];
                }
            }
            asm volatile("s_waitcnt lgkmcnt(0)\n\ts_barrier" ::: "memory");
            cur = (cur == 5) ? 0 : cur + 1; cur3 = (cur3 == 2) ? 0 : cur3 + 1;
        }
        if (wave >= 6) scan_flush(L - 320, NIT - 1, F.lds + SC_SO_OFF + ((cur3 == 0) ? 2 : cur3 - 1) * SC_SO_SLOT, sp0v0);
    }
}

struct P5LoadsA { bf16x8 qa[2], sb[4][2]; u32x2 yl[4]; };
struct P5LoadsB { u32x2 pv[4], qv[4], zw[4]; f32x4 mu4[4], g4[4], b4[4]; float bon; };
__device__ __forceinline__ void p5_load_a(Frame& F, P5LoadsA& G, int u, int wq, int fr, int fq) {
    const int c = u & 127, h = (u >> 7) & 15, b = u >> 11; const size_t m = (size_t)b * SEQ + (size_t)c * 64 + 16 * wq + fr;
    const bf16_t* sp = F.STATES + (size_t)u * 4096;
#pragma unroll
    for (int ks = 0; ks < 2; ++ks) G.qa[ks] = *(const bf16x8*)(F.QD + (size_t)u * 4096 + (16 * wq + fr) * 64 + ks * 32 + fq * 8);
#pragma unroll
    for (int nt = 0; nt < 4; ++nt) {
#pragma unroll
        for (int ks = 0; ks < 2; ++ks) G.sb[nt][ks] = *(const bf16x8*)(sp + (16 * nt + fr) * 64 + ks * 32 + fq * 8);
        G.yl[nt] = *(const u32x2*)(F.YCAT + m * DBR + h * 64 + 16 * nt + 4 * fq); }
}
__device__ __forceinline__ void p5_load_b(Frame& F, P5LoadsB& G, int u, int wq, int fr, int fq) {
    const int c = u & 127, h = (u >> 7) & 15, b = u >> 11; const int t = 16 * wq + fr; const size_t m = (size_t)b * SEQ + (size_t)c * 64 + t; const bool hasprev = (c > 0) || (t > 0);
#pragma unroll
    for (int nt = 0; nt < 4; ++nt) { const int ch = h * 64 + 16 * nt + 4 * fq;
        G.pv[nt] = *(const u32x2*)(F.PA + m * NPA + PA_V + ch); G.qv[nt] = hasprev ? *(const u32x2*)(F.PA + (m - 1) * NPA + PA_V + ch) : (u32x2){0u, 0u};
        G.zw[nt] = *(const u32x2*)(F.PA + m * NPA + PA_ZR + ch);
        G.mu4[nt] = *(const f32x4*)(F.mu_rkv + 2 * DBR + ch); G.g4[nt] = *(const f32x4*)(F.lnx_g + ch); G.b4[nt] = *(const f32x4*)(F.lnx_b + ch); }
    G.bon = F.BONUS[m * NH + h];
}
__device__ __forceinline__ void p5_out(Frame& F) {
    const int lane = F.lane, wave = F.wave, fr = lane & 15, fq = lane >> 4, grp = wave >> 2, wq = wave & 3;
    constexpr int NU = BATCH * NH * NCHUNK;
    int u = F.bid * 2 + grp; const int ustep = F.G * 2;
    if (u >= NU) return;
    P5LoadsA GA; p5_load_a(F, GA, u, wq, fr, fq);
    for (; u < NU; u += ustep) {
        const int c = u & 127, h = (u >> 7) & 15, b = u >> 11; const size_t m = (size_t)b * SEQ + (size_t)c * 64 + 16 * wq + fr;
        P5LoadsB GB; p5_load_b(F, GB, u, wq, fr, fq);
        f32x4 y[4];
#pragma unroll
        for (int nt = 0; nt < 4; ++nt) y[nt] = (f32x4){bflo(GA.yl[nt].x), bfhi(GA.yl[nt].x), bflo(GA.yl[nt].y), bfhi(GA.yl[nt].y)};
#pragma unroll
        for (int ks = 0; ks < 2; ++ks)
#pragma unroll
            for (int nt = 0; nt < 4; ++nt) y[nt] = __builtin_amdgcn_mfma_f32_16x16x32_bf16(GA.sb[nt][ks], GA.qa[ks], y[nt], 0, 0, 0);
        if (u + ustep < NU) p5_load_a(F, GA, u + ustep, wq, fr, fq);
        float s = 0.f;
#pragma unroll
        for (int nt = 0; nt < 4; ++nt) s += (y[nt][0] + y[nt][1]) + (y[nt][2] + y[nt][3]);
        s += __shfl_xor(s, 16); s += __shfl_xor(s, 32);
        const float mean = s * (1.0f / 64.0f);
        float q = 0.f;
#pragma unroll
        for (int nt = 0; nt < 4; ++nt)
#pragma unroll
            for (int r = 0; r < 4; ++r) { const float d = y[nt][r] - mean; q += d * d; }
        q += __shfl_xor(q, 16); q += __shfl_xor(q, 32);
        const float rstd = 1.0f / sqrtf(q * (1.0f / 64.0f) + GN_EPS);
#pragma unroll
        for (int nt = 0; nt < 4; ++nt) { const int ch = h * 64 + 16 * nt + 4 * fq;
            const f32x4 pv = (f32x4){bflo(GB.pv[nt].x), bfhi(GB.pv[nt].x), bflo(GB.pv[nt].y), bfhi(GB.pv[nt].y)}, qv = (f32x4){bflo(GB.qv[nt].x), bfhi(GB.qv[nt].x), bflo(GB.qv[nt].y), bfhi(GB.qv[nt].y)};
            const f32x4 z = (f32x4){bflo(GB.zw[nt].x), bfhi(GB.zw[nt].x), bflo(GB.zw[nt].y), bfhi(GB.zw[nt].y)};
            const f32x4 vv = pv + (qv - pv) * GB.mu4[nt];
            f32x4 o4;
#pragma unroll
            for (int r = 0; r < 4; ++r) o4[r] = ((y[nt][r] - mean) * rstd * GB.g4[nt][r] + GB.b4[nt][r] + GB.bon * vv[r]) * (z[r] * sigmoidf_(z[r]));
            u32x2 ow; ow.x = pk2(o4[0], o4[1]); ow.y = pk2(o4[2], o4[3]);
            *(u32x2*)(F.YCAT + m * DBR + ch) = ow; }
    }
}

__device__ __forceinline__ void p8_final(Frame& F) {
    const int gw = F.bid * NWAVES + F.wave, NGW = F.G * NWAVES;
    for (int m0 = gw; m0 < M; m0 += 2 * NGW) {
#pragma unroll
        for (int q = 0; q < 2; ++q) { const int m = (m0 + q * NGW < M) ? m0 + q * NGW : m0;
            const f32x4* xr = (const f32x4*)(F.x + (size_t)m * DM) + 2 * F.lane; const f32x4* gr = (const f32x4*)F.post_g + 2 * F.lane;
            const u32x4* orow = (const u32x4*)(F.OBF + (size_t)m * DM) + F.lane;
            f32x4* outr = (f32x4*)(F.out + (size_t)m * DM) + 2 * F.lane;
            u32x4 ow[4]; f32x4 x0[4], x1[4];
#pragma unroll
            for (int jj = 0; jj < 4; ++jj) { ow[jj] = orow[64 * jj]; x0[jj] = xr[128 * jj]; x1[jj] = xr[128 * jj + 1]; }
            float ss = (F.lane < 32) ? F.SSP[(size_t)m * 32 + F.lane] : 0.f;
            ss = wave_sum(ss);
            const float rstd = 1.0f / sqrtf(ss * (1.f / DM) + NORM_EPS);
#pragma unroll
            for (int jj = 0; jj < 4; ++jj) { float ov[8]; unpack8(ow[jj], ov);
                const f32x4 g0 = gr[128 * jj], g1 = gr[128 * jj + 1];
                outr[128 * jj] = x0[jj] + (f32x4){ov[0], ov[1], ov[2], ov[3]} * rstd * g0; outr[128 * jj + 1] = x1[jj] + (f32x4){ov[4], ov[5], ov[6], ov[7]} * rstd * g1; }
        }
    }
}

struct Args { const float* in[22]; float* out; unsigned char* ws; int ph_lo, ph_hi, li, pad; };
constexpr int N_PHASES = 9;
__global__ void __launch_bounds__(NTHREADS, 2) mk_fwd(Args args) {
    extern __shared__ __attribute__((aligned(16))) unsigned char lds[];
    Frame F;
    F.lds = (LAS unsigned char*)lds;
    F.tid = threadIdx.x; F.lane = F.tid & 63; F.wave = __builtin_amdgcn_readfirstlane(F.tid >> 6);
    F.G = gridDim.x; F.bid = blockIdx.x;
    unsigned char* ws = args.ws;
    F.x = args.in[0]; F.pre_g = args.in[1]; F.post_g = args.in[2]; F.w_in = args.in[3]; F.mu_rkv = args.in[4]; F.mu_wa = args.in[5]; F.w0 = args.in[6]; F.w1 = args.in[7]; F.w2 = args.in[8];
    F.a0 = args.in[9]; F.a1 = args.in[10]; F.a2 = args.in[11]; F.k_k = args.in[12]; F.k_a = args.in[13]; F.r_k = args.in[14]; F.lnx_g = args.in[15]; F.lnx_b = args.in[16]; F.rel_bias = args.in[17];
    F.w_br = args.in[18]; F.w_ba = args.in[19]; F.b_merge = args.in[20]; F.w_out = args.in[21]; F.out = args.out;
    F.HB = (bf16_t*)((unsigned char*)args.out + DO_HB); F.WIN_T = (bf16_t*)((unsigned char*)args.out + DO_WIN); F.STATES = (bf16_t*)((unsigned char*)args.out + DO_STATES);
    F.MD = (bf16_t*)((unsigned char*)args.out + DO_MD); F.ND = (bf16_t*)((unsigned char*)args.out + DO_ND); F.QD = (bf16_t*)((unsigned char*)args.out + DO_QD);
    F.WCAT_T = (bf16_t*)(ws + WS_WCAT); F.WOUT_T = (bf16_t*)(ws + WS_WOUT); F.W2T = (bf16_t*)(ws + WS_W2T); F.A2T = F.W2T + DBR * 64;
    F.BONUS = (float*)(ws + WS_BONUS); F.SSP = (float*)(ws + WS_SSP); F.PL = (bf16_t*)(ws + WS_PLS); F.PG = (bf16_t*)(ws + WS_PG); F.PA = (bf16_t*)(ws + WS_PA);
    F.MERGED = (bf16_t*)(ws + WS_MERGED); F.YCAT = (bf16_t*)(ws + WS_YCAT); F.OBF = (bf16_t*)(ws + WS_OBF); F.queue = (unsigned*)(ws + WS_CTL) + 65536;
    for (int u = F.tid; u < (LDS_BYTES - LDSCTL_OFF) / 4; u += NTHREADS) ((LAS unsigned*)(F.lds + LDSCTL_OFF))[u] = 0u;
    __syncthreads();
    const int lo = args.ph_lo, hi = args.ph_hi;
    XcdBarrier bar; bar.bar = (unsigned*)(ws + WS_CTL) + CW_BAR; bar.x = 0; bar.st = nullptr;
    if (hi - lo > 1) bar = xcd_barrier_post((unsigned*)(ws + WS_CTL) + CW_BAR, (volatile LAS unsigned*)(F.lds + MISC_OFF) + 8);
#define IN(k) (lo <= (k) && (k) < hi)
#define SEAM(k) do { if (IN(k) && IN((k) + 1)) xcd_barrier(bar); } while (0)
#define PHASE(k, ...) do { if (IN(k)) { __VA_ARGS__; SEAM(k); if (PROBE_REP == (k)) { __VA_ARGS__; xcd_barrier(bar); } } } while (0)
    PHASE(0, p0_prologue(F));
    PHASE(1, {
        pg8::Gemm g{F.HB, F.WIN_T, M, NIN, DM}; pg8::SplitOrder S; S.so.init(M, NPA + NPG, F.G, F.bid, DM, WGM_P1); S.extra_pn = (NPA + NPG) / 256;
        LAS float* bml = (LAS float*)(F.lds + RING_BYTES);
        for (int i = F.tid; i < 2 * DM / 4; i += NTHREADS) ((LAS f32x4*)bml)[i] = ((const f32x4*)F.b_merge)[i];
        __syncthreads();
        EpiIn E{F.PA, F.PG, F.PL, bml};
        pg8::gemm_phase<EpiIn, pg8::SplitOrder, P1_ALIGN, P1_SP2>(F.lds, g, S, E);
    });
    PHASE(3, p3_prep(F));
    PHASE(4, { p4_scan(F); p2_attention(F); });
    PHASE(5, p5_out(F));
    PHASE(6, {
        pg8::Gemm g{F.YCAT, F.WCAT_T, 2 * M, 2 * DM, DBR}; pg8::PairOrder S; S.so.init(M, DM, F.G, F.bid, DBR, WGM_P6); S.dpm = M / 256; S.dpn = DM / 256;
        EpiBranch E{F.PG, F.MERGED};
        pg8::gemm_phase<EpiBranch, pg8::PairOrder, true, true>(F.lds, g, S, E);
    });
    PHASE(7, {
        pg8::Gemm g{F.MERGED, F.WOUT_T, M, DM, DM}; pg8::StaticOrder S; S.init(M, DM, F.G, F.bid, DM, WGM_P7);
        EpiOut E{F.OBF, F.SSP};
        pg8::gemm_phase<EpiOut, pg8::StaticOrder, true, true>(F.lds, g, S, E);
    });
    if (IN(8)) { p8_final(F); }
#undef PHASE
#undef IN
#undef SEAM
}

extern "C" void kernel_launch(void* const* d_in, const int* in_sizes, int n_in, void* d_out, int out_size, void* d_ws, size_t ws_size, hipStream_t stream) {
    static int grid = 0;
    if (grid == 0) {
        if (n_in != 22 || in_sizes[0] != M * DM || out_size != M * DM || ws_size < WS_END) { fprintf(stderr, "kernel_launch: unexpected shapes (n_in %d in0 %d out %d ws %zu); nothing launched\n", n_in, n_in > 0 ? in_sizes[0] : -1, out_size, ws_size); grid = -1; return; }
        int dev = 0, cus = 0;
        if (hipGetDevice(&dev) != hipSuccess || hipDeviceGetAttribute(&cus, hipDeviceAttributeMultiprocessorCount, dev) != hipSuccess) { fprintf(stderr, "kernel_launch: device query failed\n"); grid = -1; return; }
        if (hipFuncSetAttribute((const void*)mk_fwd, hipFuncAttributeMaxDynamicSharedMemorySize, LDS_BYTES) != hipSuccess) { fprintf(stderr, "kernel_launch: hipFuncSetAttribute failed\n"); grid = -1; return; }
        int per_cu = 0;
        if (hipOccupancyMaxActiveBlocksPerMultiprocessor(&per_cu, (const void*)mk_fwd, NTHREADS, LDS_BYTES) != hipSuccess || per_cu < 1) fprintf(stderr, "kernel_launch: note: occupancy query reports %d blocks per CU\n", per_cu);
        (void)hipGetLastError();
        grid = cus > 256 ? 256 : cus;
        if (grid != 256) { fprintf(stderr, "kernel_launch: this build needs a 256-CU device (got %d); nothing launched\n", cus); grid = -1; return; }
    }
    if (grid < 0) return;
    (void)hipMemsetAsync((char*)d_ws + WS_CTL, 0, CTL_ZERO_BYTES, stream);
    Args a{};
    for (int i = 0; i < 22; ++i) a.in[i] = (const float*)d_in[i];
    a.out = (float*)d_out; a.ws = (unsigned char*)d_ws;
#if MK_N_LAUNCHES == 1
    a.ph_lo = 0; a.ph_hi = N_PHASES; a.li = 0;
    hipLaunchKernelGGL(mk_fwd, dim3(grid), dim3(NTHREADS), LDS_BYTES, stream, a);
#else
    for (int li = 0; li < N_PHASES; ++li) { a.ph_lo = li; a.ph_hi = li + 1; a.li = li; hipLaunchKernelGGL(mk_fwd, dim3(grid), dim3(NTHREADS), LDS_BYTES, stream, a); }
#endif
}
```

```cpp
#include <hip/hip_runtime.h>
#include <cstdio>
#include <cstdint>

#ifndef MK_N_LAUNCHES
#define MK_N_LAUNCHES 1
#endif
#ifndef WGM_P1
#define WGM_P1 6
#endif
#ifndef WGM_P6
#define WGM_P6 2
#endif
#ifndef WGM_P7
#define WGM_P7 2
#endif
#ifndef P1_ALIGN
#define P1_ALIGN true
#endif
#ifndef P1_SP2
#define P1_SP2 true
#endif
#ifndef XCD_REMAP
#define XCD_REMAP 1
#endif
#ifndef ROT_COLS
#define ROT_COLS 0
#endif
#ifndef PROBE_REP
#define PROBE_REP -1
#endif

#define LAS __attribute__((address_space(3)))
#define GAS __attribute__((address_space(1)))
typedef unsigned short bf16_t;
typedef short bf16x8 __attribute__((ext_vector_type(8)));
typedef short s16x4 __attribute__((ext_vector_type(4)));
typedef float f32x4 __attribute__((ext_vector_type(4)));
typedef float f32x2 __attribute__((ext_vector_type(2)));
typedef unsigned u32x4 __attribute__((ext_vector_type(4)));
typedef unsigned u32x2 __attribute__((ext_vector_type(2)));
typedef __bf16 bf16x2_t __attribute__((ext_vector_type(2)));

constexpr int BATCH = 2, SEQ = 8192, DM = 2048, DBR = 1024, NH = 16, HD = 64, CHUNK = 64, NCHUNK = SEQ / CHUNK, M = BATCH * SEQ;
constexpr int NPA = 8192, NPG = 4096, NPL = 256, NIN = NPA + NPG + NPL;
constexpr int PA_R = 0, PA_K = 1024, PA_V = 2048, PA_ZR = 3072, PA_Q = 4096, PA_KA = 5120, PA_VA = 6144, PA_ZA = 7168;
constexpr float NORM_EPS = 1e-6f, GN_EPS = 64e-5f, DECAY_SCALE = 0.606531f;
constexpr int NWAVES = 8, NTHREADS = 512;

constexpr size_t MiB = 1u << 20;
constexpr size_t WS_CTL = 0, CTL_ZERO_BYTES = 1 * MiB;
constexpr size_t WS_WCAT = 1 * MiB;
constexpr size_t WS_WOUT = 9 * MiB;
constexpr size_t WS_W2T = 17 * MiB;
constexpr size_t WS_BONUS = 18 * MiB;
constexpr size_t WS_SSP = 19 * MiB;
constexpr size_t WS_PL = 22 * MiB;
constexpr size_t WS_PG = 30 * MiB;
constexpr size_t WS_PA = 158 * MiB;
constexpr size_t WS_MERGED = WS_PA;
constexpr size_t WS_OBF = WS_PA + 64 * MiB;
constexpr size_t WS_YCAT = 414 * MiB;
constexpr size_t WS_PLS = 478 * MiB;
constexpr size_t WS_END = 510 * MiB;
constexpr size_t DO_HB = 0, DO_WIN = 64 * MiB, DO_STATES = 0;
constexpr size_t DO_MD = 32 * MiB, DO_ND = 64 * MiB, DO_QD = 96 * MiB;
constexpr int CW_BAR = 4096;

constexpr int RING_BYTES = 131072;
constexpr int LDSCTL_OFF = 152576, MISC_OFF = LDSCTL_OFF + 320;
constexpr int LDS_BYTES = 153600;

typedef GAS unsigned gu32;
#define RLX_AGENT __ATOMIC_RELAXED, __HIP_MEMORY_SCOPE_AGENT
#define LDS_WAIT() asm volatile("s_waitcnt lgkmcnt(0)" ::: "memory")
#define VM_WAIT() asm volatile("s_waitcnt vmcnt(0)" ::: "memory")
__device__ __forceinline__ unsigned pk2(float lo, float hi) { f32x2 v = {lo, hi}; bf16x2_t b = __builtin_convertvector(v, bf16x2_t); return __builtin_bit_cast(unsigned, b); }
__device__ __forceinline__ bf16_t f2bf(float f) { return (bf16_t)(pk2(f, 0.f) & 0xffffu); }
__device__ __forceinline__ float bflo(unsigned w) { return __uint_as_float(w << 16); }
__device__ __forceinline__ float bfhi(unsigned w) { return __uint_as_float(w & 0xffff0000u); }
__device__ __forceinline__ float bf2f(bf16_t h) { return __uint_as_float(((unsigned)h) << 16); }
__device__ __forceinline__ void unpack8(const u32x4 w, float (&f)[8]) { f[0] = bflo(w.x); f[1] = bfhi(w.x); f[2] = bflo(w.y); f[3] = bfhi(w.y); f[4] = bflo(w.z); f[5] = bfhi(w.z); f[6] = bflo(w.w); f[7] = bfhi(w.w); }
__device__ __forceinline__ u32x4 pack8(const float (&f)[8]) { u32x4 w; w.x = pk2(f[0], f[1]); w.y = pk2(f[2], f[3]); w.z = pk2(f[4], f[5]); w.w = pk2(f[6], f[7]); return w; }
__device__ __forceinline__ void load8(const float* p, float (&f)[8]) { const f32x4 a = *(const f32x4*)p, b = *(const f32x4*)(p + 4); f[0] = a.x; f[1] = a.y; f[2] = a.z; f[3] = a.w; f[4] = b.x; f[5] = b.y; f[6] = b.z; f[7] = b.w; }
__device__ __forceinline__ float sigmoidf_(float x) { return 1.f / (1.f + __expf(-x)); }
__device__ __forceinline__ float tanhf_(float x) { return 1.f - 2.f / (1.f + __expf(2.f * x)); }

namespace pg8 {
constexpr int BM = 256, BK = 64, HALF = 128, HTB = HALF * BK * 2  , STAGE_BYTES = 8 * HTB, NXCD = 8;
__host__ __device__ __forceinline__ int lds_byte(int r, int c) { const int st = (r >> 4) * 2 + (c >> 5), rr = r & 15, cc = c & 31, ob = rr * 64 + cc * 2; return st * 1024 + (ob ^ (((ob >> 9) & 1) << 5)); }
__host__ __device__ __forceinline__ void stage_rc(int b, int& R, int& C) { const int st = b / 1024, sb = b % 1024, swz = sb ^ (((sb >> 9) & 1) << 5); R = (st >> 1) * 16 + swz / 64; C = (st & 1) * 32 + (swz % 64) / 2; }
__host__ __device__ __forceinline__ int perm32(int rho) { const int n = rho >> 4, i = rho & 15; return 8 * (i >> 2) + 4 * n + (i & 3); }

struct Unit { int pm, pn, kb, nt; };
struct Gemm { const bf16_t* A; const bf16_t* Bt; int M, N, K; };

struct StaticOrder {
    int nM, nN, nwg, G, c, ntk, WGM;
    __host__ __device__ void init(int M_, int N_, int G_, int c_, int K_, int wgm_) { nM = M_ / BM; nN = N_ / BM; nwg = nM * nN; G = G_; c = c_; ntk = K_ / BK; WGM = wgm_; }
    __host__ __device__ void tile(int L, int& pm, int& pn) const {
        int wgid = L; if (XCD_REMAP) { const int q = nwg / NXCD, r = nwg % NXCD, xcd = wgid % NXCD, off = wgid / NXCD; wgid = (xcd < r ? xcd * (q + 1) : r * (q + 1) + (xcd - r) * q) + off; }
        if (WGM > 0) { const int nig = WGM * nN, gid = wgid / nig, fm = gid * WGM, gsz = (nM - fm) < WGM ? (nM - fm) : WGM;
            pm = fm + ((wgid % nig) % gsz); pn = (wgid % nig) / gsz;
            if (ROT_COLS) pn = (pn + ROT_COLS * gid) % nN; }
        else { const int W = -WGM, nig = W * nM, gid = wgid / nig, fn = gid * W, gsz = (nN - fn) < W ? (nN - fn) : W;
            pn = fn + ((wgid % nig) % gsz); pm = (wgid % nig) / gsz; }
    }
    __host__ __device__ bool next(int i, Unit& u) const {
        const long L = (long)i * G + c; if (L >= nwg) return false;
        int pm, pn; tile((int)L, pm, pn);
        u.pm = pm; u.pn = pn; u.kb = 0; u.nt = ntk; return true;
    }
};
struct SplitOrder {
    StaticOrder so; int extra_pn;
    __host__ __device__ bool next(int i, Unit& u) const {
        const long L = (long)i * so.G + so.c; const bool normal = L < so.nwg; const int Lq = (int)(L - so.nwg);
        if (!normal && Lq >= 256) return false;
        int pm, pn; so.tile(normal ? (int)L : 0, pm, pn);
        u.pm = normal ? pm : (Lq >> 2); u.pn = normal ? pn : extra_pn; u.kb = normal ? 0 : (Lq & 3) * 1024; u.nt = normal ? so.ntk : 8; return true;
    }
};
struct PairOrder {
    StaticOrder so; int dpm, dpn;
    __host__ __device__ bool next(int i, Unit& u) const { if (!so.next(i >> 1, u)) return false; if (i & 1) { u.pm += dpm; u.pn += dpn; } return true; }
};

template <class Epi, class Sched, bool ALIGN_EPI = false, bool SP2 = false>
__device__ __forceinline__ void gemm_phase(LAS unsigned char* lds, const Gemm g, const Sched& S, const Epi& E) {
    const int tid = threadIdx.x, wid = __builtin_amdgcn_readfirstlane(tid >> 6), lane = tid & 63, wr = wid >> 2, wc = wid & 3, fr = lane & 15, fq = lane >> 4;
    const int K = g.K;
    unsigned voffA[2], voffB[2];
#pragma unroll
    for (int i = 0; i < 2; ++i) { int R, C; stage_rc(tid * 16 + i * 8192, R, C); const int Rb = Epi::PERM ? ((R & ~31) + perm32(R & 31)) : R;
        voffA[i] = (unsigned)(R * K + C) * 2u; voffB[i] = (unsigned)(Rb * K + C) * 2u; }
    const size_t kstep = (size_t)(BK * 2);
    const size_t hstep = (size_t)HALF * K * 2;
    const size_t tstep = 2 * hstep;
    const unsigned ldsw = (unsigned)wid * 1024u;
    const int aoff = lds_byte(wr * 64 + fr, fq * 8), boff = lds_byte(wc * 32 + fr, fq * 8);
#define PG8_SA(b, h) (((b) * 2 + (h)) * HTB)
#define PG8_SB(b, h) ((4 + (b) * 2 + (h)) * HTB)
#define PG8_STAGE(bufoff, gbase, voff) do { _Pragma("unroll") for (int _i = 0; _i < 2; ++_i) \
        __builtin_amdgcn_global_load_lds((const unsigned*)((const char*)(gbase) + (voff)[_i]), (LAS unsigned*)(lds + (bufoff) + ldsw + _i * 8192), 16, 0, 0); } while (0)
#define PG8_LDA(dst, b, h) do { _Pragma("unroll") for (int m = 0; m < 4; ++m) _Pragma("unroll") for (int k = 0; k < 2; ++k) dst[m][k] = *(const LAS bf16x8*)(lds + PG8_SA(b, h) + aoff + m * 2048 + k * 1024); } while (0)
#define PG8_LDB(dst, b, h) do { _Pragma("unroll") for (int n = 0; n < 2; ++n) _Pragma("unroll") for (int k = 0; k < 2; ++k) dst[n][k] = *(const LAS bf16x8*)(lds + PG8_SB(b, h) + boff + n * 2048 + k * 1024); } while (0)
#define PG8_MMA(ai, bj, At, Bt) do { __builtin_amdgcn_s_setprio(1); _Pragma("unroll") for (int m = 0; m < 4; ++m) _Pragma("unroll") for (int n = 0; n < 2; ++n) _Pragma("unroll") for (int k = 0; k < 2; ++k) \
        acc[ai][bj][m][n] = __builtin_amdgcn_mfma_f32_16x16x32_bf16(Bt[n][k], At[m][k], acc[ai][bj][m][n], 0, 0, 0); __builtin_amdgcn_s_setprio(0); } while (0)
#define PG8_WAIT_V(n) asm volatile("s_waitcnt vmcnt(" #n ")" ::: "memory")
#define PG8_WAIT_L(n) asm volatile("s_waitcnt lgkmcnt(" #n ")" ::: "memory")
#define PG8_BAR __builtin_amdgcn_s_barrier()
#define PG8_SCHED __builtin_amdgcn_sched_barrier(0)
    Unit cur, nxt; int ui = 0;
    if (!S.next(0, cur)) return;
    f32x4 acc[2][2][4][2];
#pragma unroll
    for (int a = 0; a < 2; ++a)
#pragma unroll
        for (int b = 0; b < 2; ++b)
#pragma unroll
            for (int m = 0; m < 4; ++m)
#pragma unroll
                for (int n = 0; n < 2; ++n) acc[a][b][m][n] = (f32x4){0.f, 0.f, 0.f, 0.f};
    bf16x8 At[4][2], B0[2][2], B1[2][2];
    const char* cA = (const char*)g.A + (size_t)cur.pm * tstep + cur.kb; const char* cB = (const char*)g.Bt + (size_t)cur.pn * tstep + cur.kb;
    if constexpr (SP2) {
        PG8_STAGE(PG8_SB(0, 0), cB, voffB); PG8_STAGE(PG8_SB(0, 1), cB + hstep, voffB); PG8_STAGE(PG8_SA(0, 0), cA, voffA); PG8_STAGE(PG8_SA(0, 1), cA + hstep, voffA);
        if (wr == 1) PG8_BAR;
        PG8_WAIT_V(2); PG8_BAR;
        PG8_STAGE(PG8_SB(1, 0), cB + kstep, voffB); PG8_STAGE(PG8_SA(1, 0), cA + kstep, voffA); PG8_STAGE(PG8_SB(1, 1), cB + hstep + kstep, voffB);
        PG8_WAIT_V(6); PG8_BAR;
    } else {
        PG8_STAGE(PG8_SB(0, 0), cB, voffB); PG8_STAGE(PG8_SA(0, 0), cA, voffA); PG8_STAGE(PG8_SB(0, 1), cB + hstep, voffB); PG8_STAGE(PG8_SA(0, 1), cA + hstep, voffA);
        if (wr == 1) PG8_BAR;
        PG8_WAIT_V(4); PG8_BAR;
        PG8_STAGE(PG8_SB(1, 0), cB + kstep, voffB); PG8_STAGE(PG8_SA(1, 0), cA + kstep, voffA); PG8_STAGE(PG8_SB(1, 1), cB + hstep + kstep, voffB);
        PG8_WAIT_V(6); PG8_BAR;
    }
    for (;;) {
        const bool has_next = S.next(ui + 1, nxt);
        const char* nA = has_next ? (const char*)g.A + (size_t)nxt.pm * tstep + nxt.kb : cA; const char* nB = has_next ? (const char*)g.Bt + (size_t)nxt.pn * tstep + nxt.kb : cB;
        const int nt = cur.nt;
        for (int t = 0; t < nt; t += 2) {
            const bool last = (t == nt - 2);
            const char* a1 = cA + (size_t)(t + 1) * kstep;
            const char* a2 = last ? nA : cA + (size_t)(t + 2) * kstep; const char* b2 = last ? nB : cB + (size_t)(t + 2) * kstep;
            const char* a3 = a2 + kstep; const char* b3 = b2 + kstep;
            if constexpr (SP2) {
            PG8_LDB(B0, 0, 0); PG8_LDB(B1, 0, 1); PG8_SCHED; PG8_LDA(At, 0, 0); PG8_STAGE(PG8_SA(1, 1), a1 + hstep, voffA);
            PG8_WAIT_V(8); PG8_WAIT_L(0); PG8_BAR; PG8_MMA(0, 0, At, B0); PG8_MMA(0, 1, At, B1); PG8_BAR; PG8_SCHED;
            PG8_LDA(At, 0, 1); PG8_STAGE(PG8_SB(0, 0), b2, voffB); PG8_STAGE(PG8_SB(0, 1), b2 + hstep, voffB); PG8_STAGE(PG8_SA(0, 0), a2, voffA);
            PG8_WAIT_V(8); PG8_WAIT_L(0); PG8_BAR; PG8_MMA(1, 0, At, B0); PG8_MMA(1, 1, At, B1); PG8_BAR; PG8_SCHED;
            PG8_LDB(B0, 1, 0); PG8_LDB(B1, 1, 1); PG8_SCHED; PG8_LDA(At, 1, 0); PG8_STAGE(PG8_SA(0, 1), a2 + hstep, voffA);
            PG8_WAIT_V(8); PG8_WAIT_L(0); PG8_BAR; PG8_MMA(0, 0, At, B0); PG8_MMA(0, 1, At, B1); PG8_BAR; PG8_SCHED;
            PG8_LDA(At, 1, 1); PG8_STAGE(PG8_SB(1, 0), b3, voffB); PG8_STAGE(PG8_SB(1, 1), b3 + hstep, voffB); PG8_STAGE(PG8_SA(1, 0), a3, voffA);
            PG8_WAIT_V(8); PG8_WAIT_L(0); PG8_BAR; PG8_MMA(1, 0, At, B0); PG8_MMA(1, 1, At, B1); PG8_BAR; PG8_SCHED;
            } else {
            PG8_LDB(B0, 0, 0); PG8_SCHED; PG8_LDA(At, 0, 0); PG8_STAGE(PG8_SA(1, 1), a1 + hstep, voffA);
            PG8_WAIT_L(8); PG8_BAR; PG8_WAIT_L(0); PG8_MMA(0, 0, At, B0); PG8_BAR; PG8_SCHED;
            PG8_LDB(B1, 0, 1); PG8_STAGE(PG8_SB(0, 0), b2, voffB);
            PG8_BAR; PG8_WAIT_L(0); PG8_MMA(0, 1, At, B1); PG8_BAR;
            PG8_LDA(At, 0, 1); PG8_STAGE(PG8_SA(0, 0), a2, voffA);
            PG8_BAR; PG8_WAIT_L(0); PG8_MMA(1, 0, At, B0); PG8_BAR; PG8_SCHED;
            PG8_STAGE(PG8_SB(0, 1), b2 + hstep, voffB);
            PG8_WAIT_V(6); PG8_BAR; PG8_MMA(1, 1, At, B1); PG8_BAR;
            PG8_LDB(B0, 1, 0); PG8_SCHED; PG8_LDA(At, 1, 0); PG8_STAGE(PG8_SA(0, 1), a2 + hstep, voffA);
            PG8_WAIT_L(8); PG8_BAR; PG8_WAIT_L(0); PG8_MMA(0, 0, At, B0); PG8_BAR; PG8_SCHED;
            PG8_LDB(B1, 1, 1); PG8_STAGE(PG8_SB(1, 0), b3, voffB);
            PG8_BAR; PG8_WAIT_L(0); PG8_MMA(0, 1, At, B1); PG8_BAR;
            PG8_LDA(At, 1, 1); PG8_STAGE(PG8_SA(1, 0), a3, voffA);
            PG8_BAR; PG8_WAIT_L(0); PG8_MMA(1, 0, At, B0); PG8_BAR; PG8_SCHED;
            PG8_STAGE(PG8_SB(1, 1), b3 + hstep, voffB);
            PG8_WAIT_V(6); PG8_BAR; PG8_MMA(1, 1, At, B1); PG8_BAR;
            }
        }
        if constexpr (ALIGN_EPI) { if (wr == 0) PG8_BAR; }
        const bool zero_acc = E(acc, cur, wr, wc, fr, fq);
        if (!has_next) break;
        if (zero_acc) {
#pragma unroll
        for (int a = 0; a < 2; ++a)
#pragma unroll
            for (int b = 0; b < 2; ++b)
#pragma unroll
                for (int m = 0; m < 4; ++m)
#pragma unroll
                    for (int n = 0; n < 2; ++n) acc[a][b][m][n] = (f32x4){0.f, 0.f, 0.f, 0.f};
        }
        cur = nxt; cA = nA; cB = nB; ++ui;
        if constexpr (ALIGN_EPI) { if (wr == 1) PG8_BAR; }
    }
    PG8_WAIT_V(0);
    if constexpr (!ALIGN_EPI) { if (wr == 0) PG8_BAR; }
    PG8_BAR;
#undef PG8_SA
#undef PG8_SB
#undef PG8_STAGE
#undef PG8_LDA
#undef PG8_LDB
#undef PG8_MMA
#undef PG8_WAIT_V
#undef PG8_WAIT_L
#undef PG8_BAR
#undef PG8_SCHED
}
}

struct EpiIn {
    static constexpr bool PERM = true;
    bf16_t* PA; bf16_t* PG; bf16_t* PL; const LAS float* bmerge;
    __device__ __forceinline__ bool operator()(f32x4 (&acc)[2][2][4][2], const pg8::Unit& u, int wr, int wc, int fr, int fq) const {
        const int row0 = u.pm * 256 + wr * 64 + fr; const int colb = u.pn * 256 + wc * 32 + 8 * fq;
        if (u.pn < 32) {
            const float sc = (u.pn >= 16 && u.pn < 20) ? 0.125f : 1.0f;
#pragma unroll
            for (int ai = 0; ai < 2; ++ai)
#pragma unroll
                for (int m = 0; m < 4; ++m) { bf16_t* rowp = PA + (size_t)(row0 + ai * 128 + m * 16) * NPA + colb;
#pragma unroll
                    for (int bj = 0; bj < 2; ++bj) { const f32x4 v0 = acc[ai][bj][m][0] * sc, v1 = acc[ai][bj][m][1] * sc;
                        u32x4 w; w.x = pk2(v0[0], v0[1]); w.y = pk2(v0[2], v0[3]); w.z = pk2(v1[0], v1[1]); w.w = pk2(v1[2], v1[3]);
                        *(u32x4*)(rowp + bj * 128) = w; } }
        } else if (u.pn < 48) {
            const int j0 = (u.pn - 32) * 128 + wc * 32 + 8 * fq;
            f32x4 bv[2][2];
#pragma unroll
            for (int bj = 0; bj < 2; ++bj)
#pragma unroll
                for (int n = 0; n < 2; ++n) bv[bj][n] = *(const LAS f32x4*)(bmerge + bj * 2048 + j0 + 4 * n);
#pragma unroll
            for (int ai = 0; ai < 2; ++ai)
#pragma unroll
                for (int m = 0; m < 4; ++m) { bf16_t* rowp = PG + (size_t)(row0 + ai * 128 + m * 16) * NPG + j0;
                    float rat[8], ga[8];
#pragma unroll
                    for (int n = 0; n < 2; ++n)
#pragma unroll
                        for (int e = 0; e < 4; ++e) { const float xr = acc[ai][0][m][n][e] + bv[0][n][e], xa = acc[ai][1][m][n][e] + bv[1][n][e];
                            const float dr = 1.0f + __expf(-xr), da = 1.0f + __expf(-xa);
                            ga[4 * n + e] = __builtin_amdgcn_rcpf(da); rat[4 * n + e] = da * __builtin_amdgcn_rcpf(dr); }
                    *(u32x4*)rowp = pack8(rat); *(u32x4*)(rowp + 2048) = pack8(ga); }
        } else {
            const int cl = colb - NPA - NPG;
#pragma unroll
            for (int ai = 0; ai < 2; ++ai)
#pragma unroll
                for (int m = 0; m < 4; ++m) { bf16_t* rowp = PL + (size_t)(u.kb >> 10) * ((size_t)M * NPL) + (size_t)(row0 + ai * 128 + m * 16) * NPL + cl;
#pragma unroll
                    for (int bj = 0; bj < 2; ++bj) { const f32x4 v0 = acc[ai][bj][m][0], v1 = acc[ai][bj][m][1];
                        u32x4 w; w.x = pk2(v0[0], v0[1]); w.y = pk2(v0[2], v0[3]); w.z = pk2(v1[0], v1[1]); w.w = pk2(v1[2], v1[3]);
                        *(u32x4*)(rowp + bj * 128) = w; } }
        }
        return true;
    }
};
struct EpiBranch {
    static constexpr bool PERM = true;
    const bf16_t* PG; bf16_t* MG;
    __device__ __forceinline__ bool operator()(f32x4 (&acc)[2][2][4][2], const pg8::Unit& u, int wr, int wc, int fr, int fq) const {
        const bool first = u.pm < 64;
        const int pm = first ? u.pm : u.pm - 64, pn = first ? u.pn : u.pn - 8;
        const int row0 = pm * 256 + wr * 64 + fr; const int colb = pn * 256 + wc * 32 + 8 * fq;
        const bf16_t* gbase = PG + (first ? 0 : 2048) + colb;
#pragma unroll
        for (int ai = 0; ai < 2; ++ai) {
            u32x4 g_[4][2];
#pragma unroll
            for (int m = 0; m < 4; ++m)
#pragma unroll
                for (int bj = 0; bj < 2; ++bj) g_[m][bj] = *(const u32x4*)(gbase + (size_t)(row0 + ai * 128 + m * 16) * NPG + bj * 128);
#pragma unroll
            for (int m = 0; m < 4; ++m) { const size_t row = (size_t)(row0 + ai * 128 + m * 16);
#pragma unroll
                for (int bj = 0; bj < 2; ++bj) { float g[8]; unpack8(g_[m][bj], g);
#pragma unroll
                    for (int e = 0; e < 4; ++e) { acc[ai][bj][m][0][e] *= g[e]; acc[ai][bj][m][1][e] *= g[4 + e]; }
                    if (!first) { const f32x4 v0 = acc[ai][bj][m][0], v1 = acc[ai][bj][m][1];
                        u32x4 w; w.x = pk2(v0[0], v0[1]); w.y = pk2(v0[2], v0[3]); w.z = pk2(v1[0], v1[1]); w.w = pk2(v1[2], v1[3]);
                        *(u32x4*)(MG + row * DM + colb + bj * 128) = w; } } }
            asm volatile("" ::: "memory");
        }
        return !first;
    }
};
struct EpiOut {
    static constexpr bool PERM = true;
    bf16_t* O; float* SSP;
    __device__ __forceinline__ bool operator()(f32x4 (&acc)[2][2][4][2], const pg8::Unit& u, int wr, int wc, int fr, int fq) const {
        const int row0 = u.pm * 256 + wr * 64 + fr; const int colb = u.pn * 256 + wc * 32 + 8 * fq;
#pragma unroll
        for (int ai = 0; ai < 2; ++ai)
#pragma unroll
            for (int m = 0; m < 4; ++m) { const size_t row = (size_t)(row0 + ai * 128 + m * 16); float ss = 0.f;
#pragma unroll
                for (int bj = 0; bj < 2; ++bj) { const f32x4 v0 = acc[ai][bj][m][0], v1 = acc[ai][bj][m][1];
                    ss += (v0[0] * v0[0] + v0[1] * v0[1]) + (v0[2] * v0[2] + v0[3] * v0[3]) + (v1[0] * v1[0] + v1[1] * v1[1]) + (v1[2] * v1[2] + v1[3] * v1[3]);
                    u32x4 w; w.x = pk2(v0[0], v0[1]); w.y = pk2(v0[2], v0[3]); w.z = pk2(v1[0], v1[1]); w.w = pk2(v1[2], v1[3]);
                    *(u32x4*)(O + row * DM + colb + bj * 128) = w; }
                ss += __shfl_xor(ss, 16); ss += __shfl_xor(ss, 32);
                if (fq == 0) SSP[row * 32 + u.pn * 4 + wc] = ss; }
        return true;
    }
};

#define XB_TMO      128
#define XB_XCNT(j)  (256  + 64 * (j))
#define XB_XSUB(j)  (1280 + 64 * (j))
#define XB_XGEN(j)  (2304 + 64 * (j))
#define XB_TOP      3328
#define XB_TOPGEN   3392
#define XCD_BAR_WORDS 3456
#define XB_SPIN_CAP (1u << 18)
__device__ __forceinline__ unsigned xb_ld(unsigned* p)              { return __hip_atomic_load(p, __ATOMIC_RELAXED, __HIP_MEMORY_SCOPE_AGENT); }
__device__ __forceinline__ unsigned xb_add(unsigned* p, unsigned v) { return __hip_atomic_fetch_add(p, v, __ATOMIC_RELAXED, __HIP_MEMORY_SCOPE_AGENT); }
__device__ __forceinline__ unsigned xb_xcc_id() { return (unsigned)__builtin_amdgcn_s_getreg((3 << 11) | 20) & 0xFu; }
#define XB_SPIN(cond, bar) do { unsigned _sp = 0; while (cond) { __builtin_amdgcn_s_sleep(1); \
    if ((++_sp & 255u) == 0u) { if (xb_ld(&(bar)[XB_TMO])) break; if (_sp > XB_SPIN_CAP) { atomicAdd(&(bar)[XB_TMO], 1u); break; } } } } while (0)
struct XcdBarrier { unsigned* bar; unsigned x; volatile LAS unsigned* st; };
__device__ __forceinline__ XcdBarrier xcd_barrier_post(unsigned* bar, volatile LAS unsigned* st) {
    XcdBarrier b; b.bar = bar; b.x = xb_xcc_id(); b.st = st;
    if (threadIdx.x == 0) (void)xb_add(&bar[XB_XCNT(b.x)], 1u);
    return b;
}
__device__ __forceinline__ void xcd_barrier_complete(unsigned* bar, unsigned x, unsigned& nloc, unsigned& nx) {
    const unsigned G = gridDim.x * gridDim.y * gridDim.z;
    unsigned sum, cnt, mine, sp = 0u;
    for (;;) {
        sum = 0u; cnt = 0u; mine = 0u;
#pragma unroll
        for (unsigned j = 0; j < 16; ++j) { const unsigned c = xb_ld(&bar[XB_XCNT(j)]); sum += c; cnt += (c > 0u) ? 1u : 0u; mine = (j == x) ? c : mine; }
        if (sum == G) break;
        __builtin_amdgcn_s_sleep(1);
        if ((++sp & 255u) == 0u) { if (xb_ld(&bar[XB_TMO])) break; if (sp > XB_SPIN_CAP) { atomicAdd(&bar[XB_TMO], 1u); break; } }
    }
    nloc = mine > 0u ? mine : 1u; nx = cnt > 0u ? cnt : 1u;
}
__device__ __forceinline__ void xcd_barrier(const XcdBarrier& b) {
    asm volatile("s_waitcnt vmcnt(0)" ::: "memory");
    __syncthreads();
    if (threadIdx.x == 0) {
        unsigned* bar = b.bar;
        __builtin_amdgcn_s_waitcnt(0);
        unsigned nloc = b.st[0], nx = b.st[1];
        if (nloc == 0u) { xcd_barrier_complete(bar, b.x, nloc, nx); b.st[0] = nloc; b.st[1] = nx; }
        const unsigned old = xb_add(&bar[XB_XSUB(b.x)], 1u);
        const unsigned gen = old / nloc;
        if (old + 1u == (gen + 1u) * nloc) {
            __builtin_amdgcn_fence(__ATOMIC_RELEASE, "agent");
            asm volatile("s_waitcnt vmcnt(0)" ::: "memory");
            const unsigned og = xb_add(&bar[XB_TOP], 1u);
            const unsigned tg = og / nx;
            if (og + 1u == (tg + 1u) * nx) xb_add(&bar[XB_TOPGEN], 1u);
            else XB_SPIN(xb_ld(&bar[XB_TOPGEN]) == tg, bar);
            __builtin_amdgcn_fence(__ATOMIC_ACQUIRE, "agent");
            xb_add(&bar[XB_XGEN(b.x)], 1u);
            asm volatile("s_waitcnt vmcnt(0)" ::: "memory");
        } else {
            XB_SPIN(xb_ld(&bar[XB_XGEN(b.x)]) == gen, bar);
            __builtin_amdgcn_fence(__ATOMIC_ACQUIRE, "agent");
            asm volatile("s_waitcnt vmcnt(0)" ::: "memory");
        }
    }
    __syncthreads();
}

struct Frame {
    LAS unsigned char* lds;
    int tid, lane, wave, G, bid;
    const float *x, *pre_g, *post_g, *w_in, *mu_rkv, *mu_wa, *w0, *w1, *w2, *a0, *a1, *a2, *k_k, *k_a, *r_k, *lnx_g, *lnx_b, *rel_bias, *w_br, *w_ba, *b_merge, *w_out;
    float* out;
    bf16_t *HB, *WIN_T, *WCAT_T, *WOUT_T, *W2T, *A2T, *PA, *PG, *PL, *YCAT, *MERGED, *STATES;
    float *BONUS, *SSP;
    bf16_t* OBF; bf16_t *MD, *ND, *QD; unsigned* queue;
};

__device__ __forceinline__ float wave_sum(float v) {
#pragma unroll
    for (int o = 1; o < 64; o <<= 1) v += __shfl_xor(v, o);
    return v;
}

__device__ __forceinline__ void p0_transpose_item(const float* W, int K, int N, bf16_t* WT, int row_off, LAS float* scr, int item, int lane, const float* mu, float s0, float s1, bool gate_remap = false) {
    const int nblk = N / 32, kb = item / nblk, nb = item % nblk, k0 = 64 * kb, n0 = 32 * nb;
    int d0 = n0; if (gate_remap && n0 >= NPA) { const int g = n0 - NPA, br = g >> 11, j0 = g & 2047; d0 = NPA + 256 * (j0 >> 7) + 128 * br + (j0 & 127); }
    f32x4 v4[8];
#pragma unroll
    for (int i = 0; i < 8; ++i) { const int kk = 8 * i + (lane >> 3); v4[i] = *(const f32x4*)(W + (size_t)(k0 + kk) * N + n0 + (lane & 7) * 4); }
#pragma unroll
    for (int i = 0; i < 8; ++i) { const int kk = 8 * i + (lane >> 3); f32x4 v = v4[i]; if (mu) v = v * (s0 + s1 * mu[k0 + kk]);
        LAS float* d = scr + kk * 33 + (lane & 7) * 4; d[0] = v[0]; d[1] = v[1]; d[2] = v[2]; d[3] = v[3]; }
    LDS_WAIT(); asm volatile("" ::: "memory");
    const int c = lane & 7;
#pragma unroll
    for (int j = 0; j < 4; ++j) { const int n = (lane >> 3) + 8 * j; const LAS float* s = scr + (8 * c) * 33 + n;
        u32x4 o; o.x = pk2(s[0 * 33], s[1 * 33]); o.y = pk2(s[2 * 33], s[3 * 33]); o.z = pk2(s[4 * 33], s[5 * 33]); o.w = pk2(s[6 * 33], s[7 * 33]);
        *(u32x4*)(WT + (size_t)(row_off + d0 + n) * K + k0 + 8 * c) = o; }
    LDS_WAIT(); asm volatile("" ::: "memory");
}
__device__ __forceinline__ void p0_prologue(Frame& F) {
    LAS float* scr = (LAS float*)(F.lds + F.wave * 16384);
    const int gw = F.bid * NWAVES + F.wave, NGW = F.G * NWAVES;
    constexpr int I_IN = (DM / 64) * (NPA + NPG) / 32, I_L = (DM / 64) * (64 / 32), I_BR = (DBR / 64) * (DM / 32), I_OUT = (DM / 64) * (DM / 32), I_W2 = (64 / 64) * (DBR / 32);
    constexpr int NITEMS = I_IN + 4 * I_L + 2 * I_BR + I_OUT + 2 * I_W2;
    for (int it = gw; it < NITEMS; it += NGW) {
        int r = it;
        if (r < I_IN) { p0_transpose_item(F.w_in, DM, NPA + NPG, F.WIN_T, 0, scr, r, F.lane, nullptr, 1.f, 0.f, true); continue; } r -= I_IN;
        if (r < I_L) { p0_transpose_item(F.w1, DM, 64, F.WIN_T, NPA + NPG + 0, scr, r, F.lane, F.mu_wa, 1.f, -1.f); continue; } r -= I_L;
        if (r < I_L) { p0_transpose_item(F.w1, DM, 64, F.WIN_T, NPA + NPG + 64, scr, r, F.lane, F.mu_wa, 0.f, 1.f); continue; } r -= I_L;
        if (r < I_L) { p0_transpose_item(F.a1, DM, 64, F.WIN_T, NPA + NPG + 128, scr, r, F.lane, F.mu_wa + DM, 1.f, -1.f); continue; } r -= I_L;
        if (r < I_L) { p0_transpose_item(F.a1, DM, 64, F.WIN_T, NPA + NPG + 192, scr, r, F.lane, F.mu_wa + DM, 0.f, 1.f); continue; } r -= I_L;
        if (r < I_BR) { p0_transpose_item(F.w_br, DBR, DM, F.WCAT_T, 0, scr, r, F.lane, nullptr, 1.f, 0.f); continue; } r -= I_BR;
        if (r < I_BR) { p0_transpose_item(F.w_ba, DBR, DM, F.WCAT_T, DM, scr, r, F.lane, nullptr, 1.f, 0.f); continue; } r -= I_BR;
        if (r < I_OUT) { p0_transpose_item(F.w_out, DM, DM, F.WOUT_T, 0, scr, r, F.lane, nullptr, 1.f, 0.f); continue; } r -= I_OUT;
        if (r < I_W2) { p0_transpose_item(F.w2, 64, DBR, F.W2T, 0, scr, r, F.lane, nullptr, 1.f, 0.f); continue; } r -= I_W2;
        p0_transpose_item(F.a2, 64, DBR, F.A2T, 0, scr, r, F.lane, nullptr, 1.f, 0.f);
    }
    for (int m = gw; m < M; m += 2 * NGW) {
        const int m2 = (m + NGW < M) ? m + NGW : m;
        const f32x4* xr = (const f32x4*)(F.x + (size_t)m * DM) + F.lane; const f32x4* xr2 = (const f32x4*)(F.x + (size_t)m2 * DM) + F.lane; const f32x4* gr = (const f32x4*)F.pre_g + F.lane;
        f32x4 v[8], w[8]; float s = 0.f, s2 = 0.f;
#pragma unroll
        for (int j = 0; j < 8; ++j) { v[j] = xr[64 * j]; w[j] = xr2[64 * j]; }
#pragma unroll
        for (int j = 0; j < 8; ++j) { s += (v[j].x * v[j].x + v[j].y * v[j].y) + (v[j].z * v[j].z + v[j].w * v[j].w); s2 += (w[j].x * w[j].x + w[j].y * w[j].y) + (w[j].z * w[j].z + w[j].w * w[j].w); }
        const float rstd = 1.0f / sqrtf(wave_sum(s) * (1.f / DM) + NORM_EPS), rstd2 = 1.0f / sqrtf(wave_sum(s2) * (1.f / DM) + NORM_EPS);
        u32x2* o8 = (u32x2*)(F.HB + (size_t)m * DM) + F.lane; u32x2* o82 = (u32x2*)(F.HB + (size_t)m2 * DM) + F.lane;
#pragma unroll
        for (int j = 0; j < 8; ++j) { const f32x4 g = gr[64 * j]; u32x2 a; a.x = pk2(v[j].x * rstd * g.x, v[j].y * rstd * g.y); a.y = pk2(v[j].z * rstd * g.z, v[j].w * rstd * g.w); o8[64 * j] = a;
            u32x2 c; c.x = pk2(w[j].x * rstd2 * g.x, w[j].y * rstd2 * g.y); c.y = pk2(w[j].z * rstd2 * g.z, w[j].w * rstd2 * g.w); o82[64 * j] = c; }
    }
}

constexpr int LSTR = 72;
constexpr int SLOT = 64 * LSTR * 2;
__device__ __forceinline__ f32x4 mm16(const LAS bf16_t* A, int m0, const LAS bf16_t* Bt, int n0, f32x4 acc, int fr, int fq) {
#pragma unroll
    for (int ks = 0; ks < 2; ++ks) {
        const bf16x8 a = *(const LAS bf16x8*)(A + (m0 + fr) * LSTR + ks * 32 + fq * 8);
        const bf16x8 b = *(const LAS bf16x8*)(Bt + (n0 + fr) * LSTR + ks * 32 + fq * 8);
        acc = __builtin_amdgcn_mfma_f32_16x16x32_bf16(a, b, acc, 0, 0, 0);
    }
    return acc;
}

typedef short v4i16_t __attribute__((ext_vector_type(4)));
__device__ __forceinline__ s16x4 tr4(const LAS bf16_t* p) { return __builtin_bit_cast(s16x4, __builtin_amdgcn_ds_read_tr16_b64_v4i16((LAS v4i16_t*)p)); }
__device__ __forceinline__ s16x4 frag_tr16(const LAS bf16_t* X, int k0, int n0, int lane) {
    const int g = lane >> 4, q = (lane & 15) >> 2, p = lane & 3;
    return tr4(X + (k0 + 4 * g + q) * LSTR + n0 + 4 * p);
}
__device__ __forceinline__ bf16x8 frag_tr32(const LAS bf16_t* X, int k0, int n0, int lane) {
    const int g = lane >> 4, q = (lane & 15) >> 2, p = lane & 3;
    const s16x4 lo = tr4(X + (k0 + 8 * g + q) * LSTR + n0 + 4 * p), hi = tr4(X + (k0 + 8 * g + 4 + q) * LSTR + n0 + 4 * p);
    return (bf16x8){lo[0], lo[1], lo[2], lo[3], hi[0], hi[1], hi[2], hi[3]};
}

constexpr int P2_GRP_BYTES = 6 * SLOT + 20 * 64 * 16;
struct KVRegs { u32x4 k0, k1, v0, v1; };
__device__ __forceinline__ void kv_load(KVRegs& R, const bf16_t* p, int key0, int d80, int key1, int d81) {
    R.k0 = *(const u32x4*)(p + (size_t)key0 * NPA + PA_KA + d80); R.k1 = *(const u32x4*)(p + (size_t)key1 * NPA + PA_KA + d81);
    R.v0 = *(const u32x4*)(p + (size_t)key0 * NPA + PA_VA + d80); R.v1 = *(const u32x4*)(p + (size_t)key1 * NPA + PA_VA + d81);
}
__device__ __forceinline__ void kv_store(const KVRegs& R, LAS unsigned char* kvb, int key0, int d80, int key1, int d81) {
    LAS bf16_t* Ks = (LAS bf16_t*)kvb; LAS bf16_t* Vs = (LAS bf16_t*)(kvb + SLOT);
    *(LAS u32x4*)(Ks + key0 * LSTR + d80) = R.k0; *(LAS u32x4*)(Ks + key1 * LSTR + d81) = R.k1; *(LAS u32x4*)(Vs + key0 * LSTR + d80) = R.v0; *(LAS u32x4*)(Vs + key1 * LSTR + d81) = R.v1;
}
__device__ __forceinline__ float xrow16_max(float x) {
    auto s = __builtin_amdgcn_permlane16_swap(__float_as_uint(x), __float_as_uint(x), false, false);
    x = fmaxf(__uint_as_float(s[0]), __uint_as_float(s[1]));
    auto t = __builtin_amdgcn_permlane32_swap(__float_as_uint(x), __float_as_uint(x), false, false);
    return fmaxf(__uint_as_float(t[0]), __uint_as_float(t[1]));
}
__device__ __forceinline__ float xrow16_sum(float x) {
    auto s = __builtin_amdgcn_permlane16_swap(__float_as_uint(x), __float_as_uint(x), false, false);
    x = __uint_as_float(s[0]) + __uint_as_float(s[1]);
    auto t = __builtin_amdgcn_permlane32_swap(__float_as_uint(x), __float_as_uint(x), false, false);
    return __uint_as_float(t[0]) + __uint_as_float(t[1]);
}
constexpr int P2_CPI = 2, P2_NITEMS = BATCH * (NH / 2) * (NCHUNK / P2_CPI);
__device__ __forceinline__ void p2_attention(Frame& F) {
    const int tid = F.tid, lane = F.lane, wave = F.wave, fr = lane & 15, fq = lane >> 4;
    const int grp = wave >> 2, wq = wave & 3, tg = tid & 255;
    LAS unsigned char* gbase = F.lds + grp * P2_GRP_BYTES;
    LAS f32x4* Tb = (LAS f32x4*)(gbase + 6 * SLOT);
    const int key0 = (tg * 2) >> 3, d80 = ((tg * 2) & 7) * 8, key1 = (tg * 2 + 1) >> 3, d81 = ((tg * 2 + 1) & 7) * 8;
    const float L2E = 1.4426950408889634f;
    volatile LAS int* qslot = (volatile LAS int*)(F.lds + MISC_OFF + 64);
    int hp_prev = -1;
    for (;;) {
        __syncthreads();
        if (tid == 0) *qslot = (int)__hip_atomic_fetch_add(F.queue, 1u, __ATOMIC_RELAXED, __HIP_MEMORY_SCOPE_AGENT);
        __syncthreads();
        const int vb = *qslot;
        if (vb >= P2_NITEMS) break;
        constexpr int NR = NCHUNK / P2_CPI; const int b = vb / (NR * 8), hp = (vb / NR) & 7, cr = vb % NR, h = hp * 2 + grp;
        const int c0 = cr * P2_CPI, kb0 = (c0 >= 8) ? c0 - 8 : 0, nst = c0 + 2 - kb0;
        const bf16_t* kvbase = F.PA + (size_t)b * SEQ * NPA + h * 64;
        KVRegs RA, RB;
        kv_load(RA, kvbase + (size_t)kb0 * 64 * NPA, key0, d80, key1, d81);
        const size_t mrow0 = (size_t)b * SEQ + (size_t)c0 * 64;
        bf16x8 qa[2][2]; u32x2 zw[2][4];
#pragma unroll
        for (int x = 0; x < 2; ++x) {
#pragma unroll
            for (int ks = 0; ks < 2; ++ks) qa[x][ks] = *(const bf16x8*)(F.PA + (mrow0 + 64 * x + 16 * wq + fr) * NPA + PA_Q + h * 64 + ks * 32 + fq * 8);
#pragma unroll
            for (int dt = 0; dt < 4; ++dt) zw[x][dt] = *(const u32x2*)(F.PA + (mrow0 + 64 * x + 16 * wq + fr) * NPA + PA_ZA + h * 64 + 16 * dt + 4 * fq); }
        if (hp != hp_prev) for (int e = tg; e < 20 * 64; e += 256) { const int u = e / 64 - 3, ln = e & 63, lfr = ln & 15, lfq = ln >> 4; f32x4 t4;
#pragma unroll
            for (int r = 0; r < 4; ++r) { int rel = 16 * u + (lfr - 4 * lfq - r); rel = rel < -256 ? -256 : (rel > 256 ? 256 : rel); t4[r] = F.rel_bias[h * 513 + rel + 256]; }
            Tb[e] = t4; }
        hp_prev = hp;
        const float bcst = F.rel_bias[h * 513 + 512];
        kv_store(RA, gbase, key0, d80, key1, d81);
        kv_load(RA, kvbase + (size_t)(kb0 + 1) * 64 * NPA, key0, d80, key1, d81);
        __syncthreads();
        float mrun[2] = {-1e30f, -1e30f}, lsum[2] = {0.f, 0.f}; f32x4 o[2][4];
#pragma unroll
        for (int x = 0; x < 2; ++x)
#pragma unroll
            for (int dt = 0; dt < 4; ++dt) o[x][dt] = (f32x4){0.f, 0.f, 0.f, 0.f};
        int bufc = 0, st = 0;
#define P2_STEP(RW, RL) { \
            const bool more1 = st + 1 < nst, more2 = st + 2 < nst; \
            if (more2) kv_load(RL, kvbase + (size_t)(kb0 + st + 2) * 64 * NPA, key0, d80, key1, d81); \
            const LAS bf16_t* Ks = (const LAS bf16_t*)(gbase + bufc * 2 * SLOT); const LAS bf16_t* Vs = (const LAS bf16_t*)(gbase + bufc * 2 * SLOT + SLOT); \
            const int j0 = kb0 + st - (c0 - 8);                                        \
            f32x4 sc[2][4]; \
            _Pragma("unroll") for (int x = 0; x < 2; ++x) { const int jx = j0 - x; const bool act = (jx >= 0) && (jx <= 8); \
                _Pragma("unroll") for (int nt = 0; nt < 4; ++nt) { const int u = wq - nt + 4 * (8 - jx); const int ui = (act && u < 17) ? u + 3 : 0; const f32x4 tb = Tb[ui * 64 + lane]; \
                    const float cv = act ? bcst : -3e38f; sc[x][nt] = (act && u < 17) ? tb : (f32x4){cv, cv, cv, cv}; } } \
            _Pragma("unroll") for (int ks = 0; ks < 2; ++ks) _Pragma("unroll") for (int nt = 0; nt < 4; ++nt) { const bf16x8 kb = *(const LAS bf16x8*)(Ks + (16 * nt + fr) * LSTR + ks * 32 + fq * 8); \
                _Pragma("unroll") for (int x = 0; x < 2; ++x) sc[x][nt] = __builtin_amdgcn_mfma_f32_16x16x32_bf16(kb, qa[x][ks], sc[x][nt], 0, 0, 0); } \
            bf16x8 pb[2][2]; \
            _Pragma("unroll") for (int x = 0; x < 2; ++x) { \
                float rmax = fmaxf(fmaxf(sc[x][0][0], sc[x][0][1]), fmaxf(sc[x][0][2], sc[x][0][3])); \
                _Pragma("unroll") for (int nt = 1; nt < 4; ++nt) rmax = fmaxf(rmax, fmaxf(fmaxf(sc[x][nt][0], sc[x][nt][1]), fmaxf(sc[x][nt][2], sc[x][nt][3]))); \
                rmax = xrow16_max(rmax); \
                const float mn = fmaxf(mrun[x], rmax); const float alpha = __builtin_amdgcn_exp2f((mrun[x] - mn) * L2E); mrun[x] = mn; \
                const float mnl = mn * L2E; float ps = 0.f; \
                _Pragma("unroll") for (int nt = 0; nt < 4; ++nt) _Pragma("unroll") for (int r = 0; r < 4; ++r) { sc[x][nt][r] = __builtin_amdgcn_exp2f(fmaf(sc[x][nt][r], L2E, -mnl)); ps += sc[x][nt][r]; } \
                lsum[x] = lsum[x] * alpha + ps; \
                _Pragma("unroll") for (int dt = 0; dt < 4; ++dt) o[x][dt] = o[x][dt] * alpha; \
                _Pragma("unroll") for (int ks = 0; ks < 2; ++ks) { u32x4 w; w.x = pk2(sc[x][2 * ks][0], sc[x][2 * ks][1]); w.y = pk2(sc[x][2 * ks][2], sc[x][2 * ks][3]); w.z = pk2(sc[x][2 * ks + 1][0], sc[x][2 * ks + 1][1]); w.w = pk2(sc[x][2 * ks + 1][2], sc[x][2 * ks + 1][3]); pb[x][ks] = __builtin_bit_cast(bf16x8, w); } } \
            _Pragma("unroll") for (int ks = 0; ks < 2; ++ks) _Pragma("unroll") for (int dt = 0; dt < 4; ++dt) { const s16x4 v0 = frag_tr16(Vs, 32 * ks, 16 * dt, lane), v1 = frag_tr16(Vs, 32 * ks + 16, 16 * dt, lane); \
                    const bf16x8 va = (bf16x8){v0[0], v0[1], v0[2], v0[3], v1[0], v1[1], v1[2], v1[3]}; \
                    _Pragma("unroll") for (int x = 0; x < 2; ++x) o[x][dt] = __builtin_amdgcn_mfma_f32_16x16x32_bf16(va, pb[x][ks], o[x][dt], 0, 0, 0); } \
            const int bufn = (bufc == 2) ? 0 : bufc + 1; \
            if (more1) kv_store(RW, gbase + bufn * 2 * SLOT, key0, d80, key1, d81); \
            __syncthreads(); \
            if (!more1) break; \
            ++st; bufc = bufn; }
        for (;;) {
            P2_STEP(RA, RB)
            P2_STEP(RB, RA)
        }
#undef P2_STEP
#pragma unroll
        for (int x = 0; x < 2; ++x) {
            const float inv = 1.0f / xrow16_sum(lsum[x]); const size_t m = mrow0 + 64 * x + 16 * wq + fr;
#pragma unroll
            for (int dt = 0; dt < 4; ++dt) { const int col = h * 64 + 16 * dt + 4 * fq;
                const float z0 = bflo(zw[x][dt].x), z1 = bfhi(zw[x][dt].x), z2 = bflo(zw[x][dt].y), z3 = bfhi(zw[x][dt].y);
                u32x2 yw; yw.x = pk2(o[x][dt][0] * inv * z0 * sigmoidf_(z0), o[x][dt][1] * inv * z1 * sigmoidf_(z1)); yw.y = pk2(o[x][dt][2] * inv * z2 * sigmoidf_(z2), o[x][dt][3] * inv * z3 * sigmoidf_(z3));
                *(u32x2*)(F.YCAT + ((size_t)M + m) * DBR + col) = yw; } }
    }
}

constexpr int FSTR = 68;
constexpr int DSTR = 24;
__device__ __forceinline__ f32x4 mfma16(s16x4 a, s16x4 b, f32x4 c) {
    const bf16x8 a8 = (bf16x8){a[0], a[1], a[2], a[3], 0, 0, 0, 0}, b8 = (bf16x8){b[0], b[1], b[2], b[3], 0, 0, 0, 0};
    return __builtin_amdgcn_mfma_f32_16x16x32_bf16(a8, b8, c, 0, 0, 0); }
__device__ __forceinline__ s16x4 cvt_hi(const f32x4 v) { u32x2 w; w.x = pk2(v[0], v[1]); w.y = pk2(v[2], v[3]); return __builtin_bit_cast(s16x4, w); }
__device__ __forceinline__ s16x4 cvt_lo(const f32x4 v, const s16x4 hi) { const u32x2 h = __builtin_bit_cast(u32x2, hi);
    u32x2 w; w.x = pk2(v[0] - bflo(h.x), v[1] - bfhi(h.x)); w.y = pk2(v[2] - bflo(h.y), v[3] - bfhi(h.y)); return __builtin_bit_cast(s16x4, w); }
struct P3Loads { u32x4 w2, a2, pr, pk, pv, qr, qk, qv; f32x4 mur[2], muk[2], muv[2], kkp[2], kap[2], rkp[2]; };
__device__ __forceinline__ void p3_load(Frame& F, P3Loads& G, int h, size_t m, int t_e, int c8, bool hasprev) {
    const u32x4 zero4 = (u32x4){0u, 0u, 0u, 0u};
    G.w2 = *(const u32x4*)(F.W2T + (size_t)(h * 64 + t_e) * 64 + c8); G.a2 = *(const u32x4*)(F.A2T + (size_t)(h * 64 + t_e) * 64 + c8);
    const bf16_t* rowp = F.PA + m * NPA + h * 64 + c8;
    G.pr = *(const u32x4*)(rowp + PA_R); G.pk = *(const u32x4*)(rowp + PA_K); G.pv = *(const u32x4*)(rowp + PA_V);
    G.qr = hasprev ? *(const u32x4*)(rowp - NPA + PA_R) : zero4; G.qk = hasprev ? *(const u32x4*)(rowp - NPA + PA_K) : zero4; G.qv = hasprev ? *(const u32x4*)(rowp - NPA + PA_V) : zero4;
    const int ch0 = h * 64 + c8;
#pragma unroll
    for (int q = 0; q < 2; ++q) { G.mur[q] = *(const f32x4*)(F.mu_rkv + ch0 + 4 * q); G.muk[q] = *(const f32x4*)(F.mu_rkv + DBR + ch0 + 4 * q); G.muv[q] = *(const f32x4*)(F.mu_rkv + 2 * DBR + ch0 + 4 * q);
        G.kkp[q] = *(const f32x4*)(F.k_k + ch0 + 4 * q); G.kap[q] = *(const f32x4*)(F.k_a + ch0 + 4 * q); G.rkp[q] = *(const f32x4*)(F.r_k + ch0 + 4 * q); }
}
__device__ __forceinline__ void p3_prep(Frame& F) {
    const int wave = F.wave;
    LAS unsigned char* L = F.lds;
    LAS bf16_t* X_A = (LAS bf16_t*)(L + 0 * SLOT);
    LAS bf16_t* X_B = (LAS bf16_t*)(L + 1 * SLOT);
    LAS bf16_t* X_K = (LAS bf16_t*)(L + 2 * SLOT);
    LAS bf16_t* X_R = (LAS bf16_t*)(L + 3 * SLOT);
    LAS bf16_t* X_V = (LAS bf16_t*)(L + 4 * SLOT);
    LAS bf16_t* S_TW = (LAS bf16_t*)(L + 5 * SLOT);
    LAS bf16_t* S_TA = (LAS bf16_t*)(L + 6 * SLOT);
    LAS bf16_t* A_AB = (LAS bf16_t*)(L + 7 * SLOT);
    LAS bf16_t* A_AK = (LAS bf16_t*)(L + 8 * SLOT);
    LAS bf16_t* A_RB = (LAS bf16_t*)(L + 9 * SLOT);
    LAS bf16_t* A_RK = (LAS bf16_t*)(L + 10 * SLOT);
    LAS bf16_t* DB = (LAS bf16_t*)(L + 11 * SLOT);
    LAS float* CLf = (LAS float*)(L + 12 * SLOT);
    LAS float* Af = CLf + 64 * FSTR;
    LAS float* GL = Af + 64 * FSTR;
    LAS bf16_t* ST_Q = A_AK; LAS bf16_t* ST_Y = X_A; LAS bf16_t* ST_M = X_V; LAS bf16_t* ST_N = (LAS bf16_t*)CLf;
    const int mt = wave >> 1, ntb = (wave & 1) * 2;
    for (int vb = F.bid; vb < 256; vb += F.G) {
        const int b = vb >> 7, c = vb & 127; const size_t mrow0 = (size_t)b * SEQ + (size_t)c * 64;
        {
            const int t_e = F.tid >> 3, c8 = (F.tid & 7) * 8; const size_t m = mrow0 + t_e; const bool hasprev = (c > 0) || (t_e > 0);
            const u32x4 zero4 = (u32x4){0u, 0u, 0u, 0u};
            float sw[8], sa[8];
#pragma unroll
            for (int e = 0; e < 8; ++e) { sw[e] = 0.f; sa[e] = 0.f; }
#pragma unroll
            for (int q = 0; q < 4; ++q) { const bf16_t* slab = F.PL + (size_t)q * ((size_t)M * NPL);
                const u32x4 g_law = *(const u32x4*)(slab + m * NPL + 0 + c8), g_laa = *(const u32x4*)(slab + m * NPL + 128 + c8);
                const u32x4 g_lbw = hasprev ? *(const u32x4*)(slab + (m - 1) * NPL + 64 + c8) : zero4, g_lba = hasprev ? *(const u32x4*)(slab + (m - 1) * NPL + 192 + c8) : zero4;
                float law[8], laa[8], lbw[8], lba[8];
                unpack8(g_law, law); unpack8(g_laa, laa); unpack8(g_lbw, lbw); unpack8(g_lba, lba);
#pragma unroll
                for (int e = 0; e < 8; ++e) { sw[e] += law[e] + lbw[e]; sa[e] += laa[e] + lba[e]; } }
            float tw[8], ta[8];
#pragma unroll
            for (int e = 0; e < 8; ++e) { tw[e] = tanhf_(sw[e]); ta[e] = sa[e]; }
            __syncthreads();
            *(LAS u32x4*)(S_TW + t_e * LSTR + c8) = pack8(tw); *(LAS u32x4*)(S_TA + t_e * LSTR + c8) = pack8(ta);
        }
        P3Loads G; p3_load(F, G, 0, mrow0 + (F.tid >> 3), F.tid >> 3, (F.tid & 7) * 8, (c > 0) || ((F.tid >> 3) > 0));
        for (int h = 0; h < NH; ++h) {
            int tid = F.tid; asm volatile("" : "+v"(tid));
            const int lane = tid & 63, fr = lane & 15, fq = lane >> 4;
            const int t_e = tid >> 3, c8 = (tid & 7) * 8;
            const size_t m = mrow0 + t_e; const bool hasprev = (c > 0) || (t_e > 0);
            const u32x4 g_w2 = G.w2, g_a2 = G.a2, g_pr = G.pr, g_pk = G.pk, g_pv = G.pv, g_qr = G.qr, g_qk = G.qk, g_qv = G.qv;
            float mur[8], muk[8], muv[8], kkp[8], kap[8], rkp[8];
#pragma unroll
            for (int e = 0; e < 8; ++e) { mur[e] = G.mur[e >> 2][e & 3]; muk[e] = G.muk[e >> 2][e & 3]; muv[e] = G.muv[e >> 2][e & 3]; kkp[e] = G.kkp[e >> 2][e & 3]; kap[e] = G.kap[e >> 2][e & 3]; rkp[e] = G.rkp[e >> 2][e & 3]; }
            __syncthreads();
            *(LAS u32x4*)(A_AB + t_e * LSTR + c8) = g_w2; *(LAS u32x4*)(A_AK + t_e * LSTR + c8) = g_a2;
            __syncthreads();
            {
                const int ctile = wave & 3, ch = 16 * ctile + fr; const bool isw = wave < 4;
                const LAS bf16_t* Asrc = isw ? S_TW : S_TA; const LAS bf16_t* Bsrc = isw ? A_AB : A_AK;
                bf16x8 bw[2];
#pragma unroll
                for (int ks = 0; ks < 2; ++ks) bw[ks] = *(const LAS bf16x8*)(Bsrc + ch * LSTR + ks * 32 + fq * 8);
                f32x4 d[4];
#pragma unroll
                for (int mt4 = 0; mt4 < 4; ++mt4) d[mt4] = (f32x4){0.f, 0.f, 0.f, 0.f};
#pragma unroll
                for (int ks = 0; ks < 2; ++ks)
#pragma unroll
                    for (int mt4 = 0; mt4 < 4; ++mt4) d[mt4] = __builtin_amdgcn_mfma_f32_16x16x32_bf16(*(const LAS bf16x8*)(Asrc + (16 * mt4 + fr) * LSTR + ks * 32 + fq * 8), bw[ks], d[mt4], 0, 0, 0);
                const float b0v = isw ? F.w0[h * 64 + ch] : F.a0[h * 64 + ch];
                if (isw) {
                    float base = 0.f;
#pragma unroll
                    for (int mt4 = 0; mt4 < 4; ++mt4) {
                        f32x4 p;
#pragma unroll
                        for (int r = 0; r < 4; ++r) p[r] = -DECAY_SCALE * sigmoidf_(b0v + d[mt4][r]);
                        p[1] += p[0]; p[2] += p[1]; p[3] += p[2];
                        const float T = p[3];
                        const float x1 = __shfl_up(T, 16), x2 = __shfl_up(T, 32), x3 = __shfl_up(T, 48);
                        const float pf = ((fq >= 1) ? x1 : 0.f) + ((fq >= 2) ? x2 : 0.f) + ((fq >= 3) ? x3 : 0.f);
                        const float S = __shfl(pf + T, fr + 48);
#pragma unroll
                        for (int r = 0; r < 4; ++r) CLf[(16 * mt4 + 4 * fq + r) * FSTR + ch] = base + pf + p[r];
                        base += S;
                    }
                } else {
#pragma unroll
                    for (int mt4 = 0; mt4 < 4; ++mt4)
#pragma unroll
                        for (int r = 0; r < 4; ++r) Af[(16 * mt4 + 4 * fq + r) * FSTR + ch] = sigmoidf_(b0v + d[mt4][r]);
                }
            }
            __syncthreads();
            {
                float pr[8], pk[8], pv[8], qr[8], qk[8], qv[8];
                unpack8(g_pr, pr); unpack8(g_pk, pk); unpack8(g_pv, pv); unpack8(g_qr, qr); unpack8(g_qk, qk); unpack8(g_qv, qv);
                float rr[8], kk[8], vv[8], kn[8], av[8], cl[8], clp[8]; float nrm = 0.f;
#pragma unroll
                for (int e = 0; e < 8; ++e) {
                    rr[e] = pr[e] + (qr[e] - pr[e]) * mur[e]; kk[e] = pk[e] + (qk[e] - pk[e]) * muk[e]; vv[e] = pv[e] + (qv[e] - pv[e]) * muv[e];
                    kn[e] = kk[e] * kkp[e]; nrm += kn[e] * kn[e];
                    av[e] = Af[t_e * FSTR + c8 + e]; cl[e] = CLf[t_e * FSTR + c8 + e]; clp[e] = (t_e > 0) ? CLf[(t_e - 1) * FSTR + c8 + e] : 0.f; }
                nrm += __shfl_xor(nrm, 1); nrm += __shfl_xor(nrm, 2); nrm += __shfl_xor(nrm, 4);
                const float inrm = 1.0f / fmaxf(sqrtf(nrm), 1e-12f);
                float at_[8], bt_[8], kt_[8], rt_[8]; float bon = 0.f;
#pragma unroll
                for (int e = 0; e < 8; ++e) {
                    const float kkn = kn[e] * inrm; const float kmod = kk[e] * (1.0f + (av[e] - 1.0f) * kap[e]);
                    const float gin = __expf(cl[e]), gex = __expf(clp[e]), ginv = __expf(-cl[e]);
                    at_[e] = -kkn * gex; bt_[e] = kkn * av[e] * ginv; kt_[e] = kmod * ginv; rt_[e] = rr[e] * gin;
                    bon += rr[e] * kmod * rkp[e]; }
                bon += __shfl_xor(bon, 1); bon += __shfl_xor(bon, 2); bon += __shfl_xor(bon, 4);
                if ((tid & 7) == 0) F.BONUS[m * NH + h] = bon;
                if (t_e == 63) {
#pragma unroll
                    for (int e = 0; e < 8; ++e) GL[c8 + e] = __expf(cl[e]); }
                *(LAS u32x4*)(X_A + t_e * LSTR + c8) = pack8(at_); *(LAS u32x4*)(X_B + t_e * LSTR + c8) = pack8(bt_);
                *(LAS u32x4*)(X_K + t_e * LSTR + c8) = pack8(kt_); *(LAS u32x4*)(X_R + t_e * LSTR + c8) = pack8(rt_);
                *(LAS u32x4*)(X_V + t_e * LSTR + c8) = pack8(vv);
            }
            __syncthreads();
            if (h + 1 < NH) p3_load(F, G, h + 1, m, t_e, c8, hasprev);
#pragma unroll
            for (int q = 0; q < 2; ++q) { const int it = mt, tt = ntb + q; const int t = 16 * tt + fr, i0 = 16 * it + 4 * fq;
                const f32x4 z4 = (f32x4){0.f, 0.f, 0.f, 0.f};
                const f32x4 d_ab = mm16(X_B, 16 * it, X_A, 16 * tt, z4, fr, fq), d_ak = mm16(X_K, 16 * it, X_A, 16 * tt, z4, fr, fq);
                const f32x4 d_rb = mm16(X_B, 16 * it, X_R, 16 * tt, z4, fr, fq), d_rk = mm16(X_K, 16 * it, X_R, 16 * tt, z4, fr, fq);
                f32x4 e_ab, e_ak, e_rb, e_rk;
#pragma unroll
                for (int r = 0; r < 4; ++r) { const int i = i0 + r; e_ab[r] = (i < t) ? d_ab[r] : 0.f; e_ak[r] = (i < t) ? d_ak[r] : 0.f; e_rb[r] = (i <= t) ? d_rb[r] : 0.f; e_rk[r] = (i <= t) ? d_rk[r] : 0.f; }
                *(LAS s16x4*)(A_AB + t * LSTR + i0) = cvt_hi(e_ab); *(LAS s16x4*)(A_AK + t * LSTR + i0) = cvt_hi(e_ak);
                *(LAS s16x4*)(A_RB + t * LSTR + i0) = cvt_hi(e_rb); *(LAS s16x4*)(A_RK + t * LSTR + i0) = cvt_hi(e_rk); }
            __syncthreads();
            f32x4 rhs[4]; bf16x8 vf[2];
            const int ct = wave & 3;
            if (wave < 4) {
                const s16x4 a_t = *(const LAS s16x4*)(A_AB + (16 * wave + fr) * LSTR + 16 * wave + 4 * fq);
                const s16x4 a_c = frag_tr16(A_AB, 16 * wave, 16 * wave, lane);
                const f32x4 z4 = (f32x4){0.f, 0.f, 0.f, 0.f};
                f32x4 iden;
#pragma unroll
                for (int r = 0; r < 4; ++r) iden[r] = (4 * fq + r == fr) ? 1.0f : 0.0f;
                const u32x2 atw = __builtin_bit_cast(u32x2, a_t), acw = __builtin_bit_cast(u32x2, a_c);
                f32x4 Sc = iden + (f32x4){bflo(acw.x), bfhi(acw.x), bflo(acw.y), bfhi(acw.y)}, St = iden + (f32x4){bflo(atw.x), bfhi(atw.x), bflo(atw.y), bfhi(atw.y)};
                f32x4 Pc = mfma16(a_t, a_c, z4), Pt = mfma16(a_c, a_t, z4);
#pragma unroll
                for (int lvl = 0; lvl < 3; ++lvl) {
                    const s16x4 pt = cvt_hi(Pt), pc = cvt_hi(Pc);
                    const s16x4 sh = cvt_hi(Sc), sl = cvt_lo(Sc, sh);
                    const f32x4 Sc2 = mfma16(pt, sl, mfma16(pt, sh, Sc)), St2 = mfma16(sl, pt, mfma16(sh, pt, St));
                    Sc = Sc2; St = St2;
                    if (lvl < 2) { const f32x4 Pc2 = mfma16(pt, pc, z4), Pt2 = mfma16(pc, pt, z4); Pc = Pc2; Pt = Pt2; }
                }
                *(LAS s16x4*)(DB + (16 * wave + fr) * DSTR + 4 * fq) = cvt_hi(St);
#pragma unroll
                for (int bi = 0; bi < 4; ++bi)
#pragma unroll
                    for (int r = 0; r < 4; ++r) rhs[bi][r] = bf2f(X_A[(16 * bi + 4 * fq + r) * LSTR + 16 * ct + fr]);
                vf[0] = (bf16x8){0, 0, 0, 0, 0, 0, 0, 0}; vf[1] = vf[0];
            } else {
#pragma unroll
                for (int ks = 0; ks < 2; ++ks) vf[ks] = frag_tr32(X_V, ks * 32, 16 * ct, lane);
#pragma unroll
                for (int bi = 0; bi < 4; ++bi) rhs[bi] = (f32x4){0.f, 0.f, 0.f, 0.f};
#pragma unroll
                for (int ks = 0; ks < 2; ++ks)
#pragma unroll
                    for (int bi = 0; bi < 4; ++bi) rhs[bi] = __builtin_amdgcn_mfma_f32_16x16x32_bf16(*(const LAS bf16x8*)(A_AK + (16 * bi + fr) * LSTR + ks * 32 + fq * 8), vf[ks], rhs[bi], 0, 0, 0);
            }
            __syncthreads();
            s16x4 xb[4];
#pragma unroll
            for (int bi = 0; bi < 4; ++bi) {
                f32x4 acc = rhs[bi];
#pragma unroll
                for (int bj = 0; bj < 4; ++bj) if (bj < bi) acc = mfma16(*(const LAS s16x4*)(A_AB + (16 * bi + fr) * LSTR + 16 * bj + 4 * fq), xb[bj], acc);
                const s16x4 hi = cvt_hi(acc), lo = cvt_lo(acc, hi); const s16x4 df = *(const LAS s16x4*)(DB + (16 * bi + fr) * DSTR + 4 * fq);
                f32x4 x = mfma16(df, hi, (f32x4){0.f, 0.f, 0.f, 0.f}); x = mfma16(df, lo, x);
                xb[bi] = cvt_hi(x);
            }
            const int col = 16 * ct + fr; const int c4 = 16 * ct + 4 * fq;
            {
                f32x4 acc[4];
#pragma unroll
                for (int bi = 0; bi < 4; ++bi) { const int t = 16 * bi + fr;
                    if (wave < 4) { const u32x2 rw = *(const LAS u32x2*)(X_R + t * LSTR + c4); acc[bi] = (f32x4){bflo(rw.x), bfhi(rw.x), bflo(rw.y), bfhi(rw.y)}; }
                    else acc[bi] = (f32x4){0.f, 0.f, 0.f, 0.f}; }
                if (wave >= 4) {
#pragma unroll
                    for (int ks = 0; ks < 2; ++ks)
#pragma unroll
                        for (int bi = 0; bi < 4; ++bi) acc[bi] = __builtin_amdgcn_mfma_f32_16x16x32_bf16(vf[ks], *(const LAS bf16x8*)(A_RK + (16 * bi + fr) * LSTR + ks * 32 + fq * 8), acc[bi], 0, 0, 0);
                }
#pragma unroll
                for (int bj = 0; bj < 4; ++bj)
#pragma unroll
                    for (int bi = 0; bi < 4; ++bi) if (bj <= bi) acc[bi] = mfma16(xb[bj], *(const LAS s16x4*)(A_RB + (16 * bi + fr) * LSTR + 16 * bj + 4 * fq), acc[bi]);
#pragma unroll
                for (int bi = 0; bi < 4; ++bi) { const int t = 16 * bi + fr; const s16x4 o4 = cvt_hi(acc[bi]);
                    if (wave < 4) *(LAS s16x4*)(ST_Q + t * LSTR + c4) = o4; else *(LAS s16x4*)(ST_Y + t * LSTR + c4) = o4; }
            }
            {
                f32x4 acc[4];
#pragma unroll
                for (int mk = 0; mk < 4; ++mk) acc[mk] = (f32x4){0.f, 0.f, 0.f, 0.f};
                if (wave < 4) {
#pragma unroll
                    for (int bj = 0; bj < 4; ++bj)
#pragma unroll
                        for (int mk = 0; mk < 4; ++mk) acc[mk] = mfma16(xb[bj], frag_tr16(X_B, 16 * bj, 16 * mk, lane), acc[mk]);
#pragma unroll
                    for (int mk = 0; mk < 4; ++mk) { const int k = 16 * mk + fr; const float gl = GL[k]; f32x4 v = acc[mk];
#pragma unroll
                        for (int r = 0; r < 4; ++r) v[r] = gl * (v[r] + ((k == c4 + r) ? 1.0f : 0.0f));
                        *(LAS s16x4*)(ST_M + k * LSTR + 32 * (ct >> 1) + 8 * fq + 4 * (ct & 1)) = cvt_hi(v); }
                } else {
#pragma unroll
                    for (int ks = 0; ks < 2; ++ks)
#pragma unroll
                        for (int mk = 0; mk < 4; ++mk) acc[mk] = __builtin_amdgcn_mfma_f32_16x16x32_bf16(frag_tr32(X_K, ks * 32, 16 * mk, lane), vf[ks], acc[mk], 0, 0, 0);
#pragma unroll
                    for (int bj = 0; bj < 4; ++bj)
#pragma unroll
                        for (int mk = 0; mk < 4; ++mk) acc[mk] = mfma16(frag_tr16(X_B, 16 * bj, 16 * mk, lane), xb[bj], acc[mk]);
#pragma unroll
                    for (int mk = 0; mk < 4; ++mk) { const f32x4 gl4 = *(const LAS f32x4*)(GL + 16 * mk + 4 * fq);
                        *(LAS s16x4*)(ST_N + col * LSTR + 16 * mk + 4 * fq) = cvt_hi(acc[mk] * gl4); }
                }
            }
            __syncthreads();
            { const size_t mr = mrow0 + t_e;
              const size_t ub = (size_t)((b * NH + h) * NCHUNK + c) * 4096 + t_e * 64 + c8;
              *(u32x4*)(F.QD + ub) = *(const LAS u32x4*)(ST_Q + t_e * LSTR + c8);
              *(u32x4*)(F.YCAT + mr * DBR + h * 64 + c8) = *(const LAS u32x4*)(ST_Y + t_e * LSTR + c8);
              *(u32x4*)(F.MD + ub) = *(const LAS u32x4*)(ST_M + t_e * LSTR + c8);
              *(u32x4*)(F.ND + ub) = *(const LAS u32x4*)(ST_N + t_e * LSTR + c8); }
        }
    }
}

struct ScanBuf { u32x4 m[4][2]; u32x2 nn[4]; };
__device__ __forceinline__ void scan_load(ScanBuf& B, const bf16_t* PA, size_t mrow0, int h, int v, int fr, int fq) {
#pragma unroll
    for (int i = 0; i < 4; ++i) { const bf16_t* mrowp = PA + (mrow0 + 16 * i + fr) * NPA + PA_KA + h * 64;
#pragma unroll
        for (int ks = 0; ks < 2; ++ks) B.m[i][ks] = *(const u32x4*)(mrowp + 32 * ks + 8 * fq);
        B.nn[i] = *(const u32x2*)(PA + (mrow0 + v) * NPA + PA_VA + h * 64 + 16 * i + 4 * fq); }
}
__device__ __forceinline__ void scan_step(f32x4 (&st)[4], const ScanBuf& B, bf16_t* sp, int fq) {
    u32x2 pk[4];
#pragma unroll
    for (int i = 0; i < 4; ++i) { pk[i].x = pk2(st[i][0], st[i][1]); pk[i].y = pk2(st[i][2], st[i][3]); *(u32x2*)(sp + 16 * i + 4 * fq) = pk[i]; }
    bf16x8 bfr[2];
#pragma unroll
    for (int ks = 0; ks < 2; ++ks) { u32x4 w; w.x = pk[2 * ks].x; w.y = pk[2 * ks].y; w.z = pk[2 * ks + 1].x; w.w = pk[2 * ks + 1].y; bfr[ks] = __builtin_bit_cast(bf16x8, w); }
#pragma unroll
    for (int i = 0; i < 4; ++i) { f32x4 n; n[0] = bflo(B.nn[i].x); n[1] = bfhi(B.nn[i].x); n[2] = bflo(B.nn[i].y); n[3] = bfhi(B.nn[i].y);
#pragma unroll
        for (int ks = 0; ks < 2; ++ks) n = __builtin_amdgcn_mfma_f32_16x16x32_bf16(__builtin_bit_cast(bf16x8, B.m[i][ks]), bfr[ks], n, 0, 0, 0);
        st[i] = n; }
}
constexpr int SC_NST = 2;
constexpr int SC_STEP_BYTES = 8192 + 2048, SC_SLOT_BYTES = SC_NST * SC_STEP_BYTES, SC_NSLOT = 6;
constexpr int SC_SO_OFF = SC_NSLOT * SC_SLOT_BYTES, SC_SO_STEP = 16 * LSTR * 2, SC_SO_SLOT = SC_NST * SC_SO_STEP;
__device__ __forceinline__ void scan_dma(Frame& F, int wave, int lane, int it, LAS unsigned char* slot, size_t row0, int h, int vt) {
    const int r8 = lane >> 3, cg = ((lane & 7) ^ r8) * 8;
#pragma unroll
    for (int q = 0; q < 4; ++q) { const int j = (wave - 1) + 5 * q;
        { const int st = j / 10, w10 = j % 10; const size_t ubase = row0;
            const bf16_t* g = (w10 < 8) ? F.MD + ubase + (size_t)(SC_NST * it + st) * 4096 + (8 * w10 + r8) * 64 + cg : F.ND + ubase + (size_t)(SC_NST * it + st) * 4096 + (16 * vt + 8 * (w10 - 8) + r8) * 64 + cg;
            __builtin_amdgcn_global_load_lds((const unsigned*)g, (LAS unsigned*)(slot + st * SC_STEP_BYTES + w10 * 1024), 16, 0, 0); } }
}
__device__ __forceinline__ void scan_flush(int L2, int it, const LAS unsigned char* so, bf16_t* sp0v0) {
#pragma unroll
    for (int st = 0; st < SC_NST; ++st) { const int rr = (L2 >> 3) & 15, ch = L2 & 7;
        *(u32x4*)(sp0v0 + (size_t)(SC_NST * it + st) * 4096 + rr * 64 + ch * 8) = *(const LAS u32x4*)(so + st * SC_SO_STEP + rr * (LSTR * 2) + ch * 16); }
}
__device__ __forceinline__ void p4_scan(Frame& F) {
    const int lane = F.lane, wave = F.wave, fr = lane & 15, fq = lane >> 4;
    constexpr int NIT = NCHUNK / SC_NST;
    for (int vb = F.bid; vb < 128; vb += F.G) {
        const int b = vb >> 6, h = (vb >> 2) & 15, vt = vb & 3;
        const size_t row0 = (size_t)((b * NH + h) * NCHUNK) * 4096;
        const int L = (wave - 1) * 64 + lane;
        bf16_t* sp0v0 = F.STATES + ((size_t)((b * NH + h) * NCHUNK)) * 4096 + (16 * vt) * 64;
        __syncthreads();
        if (wave >= 1 && wave <= 5) {
#pragma unroll
            for (int p = 0; p < 5; ++p) scan_dma(F, wave, lane, p, F.lds + p * SC_SLOT_BYTES, row0, h, vt);
        }
        asm volatile("s_waitcnt vmcnt(0)\n\ts_barrier" ::: "memory");
        f32x4 st[4];
#pragma unroll
        for (int i = 0; i < 4; ++i) st[i] = (f32x4){0.f, 0.f, 0.f, 0.f};
        int cur = 0, cur3 = 0;
        for (int it = 0; it < NIT; ++it) {
            if (wave >= 6) {
                if (it >= 1) scan_flush(L - 320, it - 1, F.lds + SC_SO_OFF + ((cur3 == 0) ? 2 : cur3 - 1) * SC_SO_SLOT, sp0v0);
            } else if (wave >= 1) {
                const int s5 = (cur == 0) ? 5 : cur - 1;
                if (it + 5 < NIT) scan_dma(F, wave, lane, it + 5, F.lds + s5 * SC_SLOT_BYTES, row0, h, vt);
                asm volatile("s_waitcnt vmcnt(16)" ::: "memory");
            } else {
                const LAS unsigned char* slot = F.lds + cur * SC_SLOT_BYTES; LAS unsigned char* so = F.lds + SC_SO_OFF + cur3 * SC_SO_SLOT;
#pragma unroll
                for (int s4 = 0; s4 < SC_NST; ++s4) {
                    u32x2 pk[4];
#pragma unroll
                    for (int i = 0; i < 4; ++i) { pk[i].x = pk2(st[i][0], st[i][1]); pk[i].y = pk2(st[i][2], st[i][3]); *(LAS u32x2*)(so + s4 * SC_SO_STEP + fr * (LSTR * 2) + (16 * i + 4 * fq) * 2) = pk[i]; }
                    bf16x8 bfr[2];
#pragma unroll
                    for (int ks = 0; ks < 2; ++ks) { u32x4 w; w.x = pk[2 * ks].x; w.y = pk[2 * ks].y; w.z = pk[2 * ks + 1].x; w.w = pk[2 * ks + 1].y; bfr[ks] = __builtin_bit_cast(bf16x8, w); }
                    f32x4 nw[4];
#pragma unroll
                    for (int i = 0; i < 4; ++i) {
                        const u32x2 nn = *(const LAS u32x2*)(slot + s4 * SC_STEP_BYTES + 8192 + fr * 128 + (((2 * i + (fq >> 1)) ^ (fr & 7)) * 16) + (fq & 1) * 8);
                        nw[i] = (f32x4){bflo(nn.x), bfhi(nn.x), bflo(nn.y), bfhi(nn.y)}; }
#pragma unroll
                    for (int ks = 0; ks < 2; ++ks)
#pragma unroll
                        for (int i = 0; i < 4; ++i) { const u32x4 mf = *(const LAS u32x4*)(slot + s4 * SC_STEP_BYTES + (16 * i + fr) * 128 + (((4 * ks + fq) ^ (fr & 7)) * 16));
                            nw[i] = __builtin_amdgcn_mfma_f32_16x16x32_bf16(__builtin_bit_cast(bf16x8, mf), bfr[ks], nw[i], 0, 0, 0); }
#pragma unroll
                    for (int i = 0; i < 4; ++i) st[i] = nw[i];
                }
            }
            asm volatile("s_waitcnt lgkmcnt(0)\n\ts_barrier" ::: "memory");
            cur = (cur == 5) ? 0 : cur + 1; cur3 = (cur3 == 2) ? 0 : cur3 + 1;
        }
        if (wave >= 6) scan_flush(L - 320, NIT - 1, F.lds + SC_SO_OFF + ((cur3 == 0) ? 2 : cur3 - 1) * SC_SO_SLOT, sp0v0);
    }
}

struct P5LoadsA { bf16x8 qa[2], sb[4][2]; u32x2 yl[4]; };
struct P5LoadsB { u32x2 pv[4], qv[4], zw[4]; f32x4 mu4[4], g4[4], b4[4]; float bon; };
__device__ __forceinline__ void p5_load_a(Frame& F, P5LoadsA& G, int u, int wq, int fr, int fq) {
    const int c = u & 127, h = (u >> 7) & 15, b = u >> 11; const size_t m = (size_t)b * SEQ + (size_t)c * 64 + 16 * wq + fr;
    const bf16_t* sp = F.STATES + (size_t)u * 4096;
#pragma unroll
    for (int ks = 0; ks < 2; ++ks) G.qa[ks] = *(const bf16x8*)(F.QD + (size_t)u * 4096 + (16 * wq + fr) * 64 + ks * 32 + fq * 8);
#pragma unroll
    for (int nt = 0; nt < 4; ++nt) {
#pragma unroll
        for (int ks = 0; ks < 2; ++ks) G.sb[nt][ks] = *(const bf16x8*)(sp + (16 * nt + fr) * 64 + ks * 32 + fq * 8);
        G.yl[nt] = *(const u32x2*)(F.YCAT + m * DBR + h * 64 + 16 * nt + 4 * fq); }
}
__device__ __forceinline__ void p5_load_b(Frame& F, P5LoadsB& G, int u, int wq, int fr, int fq) {
    const int c = u & 127, h = (u >> 7) & 15, b = u >> 11; const int t = 16 * wq + fr; const size_t m = (size_t)b * SEQ + (size_t)c * 64 + t; const bool hasprev = (c > 0) || (t > 0);
#pragma unroll
    for (int nt = 0; nt < 4; ++nt) { const int ch = h * 64 + 16 * nt + 4 * fq;
        G.pv[nt] = *(const u32x2*)(F.PA + m * NPA + PA_V + ch); G.qv[nt] = hasprev ? *(const u32x2*)(F.PA + (m - 1) * NPA + PA_V + ch) : (u32x2){0u, 0u};
        G.zw[nt] = *(const u32x2*)(F.PA + m * NPA + PA_ZR + ch);
        G.mu4[nt] = *(const f32x4*)(F.mu_rkv + 2 * DBR + ch); G.g4[nt] = *(const f32x4*)(F.lnx_g + ch); G.b4[nt] = *(const f32x4*)(F.lnx_b + ch); }
    G.bon = F.BONUS[m * NH + h];
}
__device__ __forceinline__ void p5_out(Frame& F) {
    const int lane = F.lane, wave = F.wave, fr = lane & 15, fq = lane >> 4, grp = wave >> 2, wq = wave & 3;
    constexpr int NU = BATCH * NH * NCHUNK;
    int u = F.bid * 2 + grp; const int ustep = F.G * 2;
    if (u >= NU) return;
    P5LoadsA GA; p5_load_a(F, GA, u, wq, fr, fq);
    for (; u < NU; u += ustep) {
        const int c = u & 127, h = (u >> 7) & 15, b = u >> 11; const size_t m = (size_t)b * SEQ + (size_t)c * 64 + 16 * wq + fr;
        P5LoadsB GB; p5_load_b(F, GB, u, wq, fr, fq);
        f32x4 y[4];
#pragma unroll
        for (int nt = 0; nt < 4; ++nt) y[nt] = (f32x4){bflo(GA.yl[nt].x), bfhi(GA.yl[nt].x), bflo(GA.yl[nt].y), bfhi(GA.yl[nt].y)};
#pragma unroll
        for (int ks = 0; ks < 2; ++ks)
#pragma unroll
            for (int nt = 0; nt < 4; ++nt) y[nt] = __builtin_amdgcn_mfma_f32_16x16x32_bf16(GA.sb[nt][ks], GA.qa[ks], y[nt], 0, 0, 0);
        if (u + ustep < NU) p5_load_a(F, GA, u + ustep, wq, fr, fq);
        float s = 0.f;
#pragma unroll
        for (int nt = 0; nt < 4; ++nt) s += (y[nt][0] + y[nt][1]) + (y[nt][2] + y[nt][3]);
        s += __shfl_xor(s, 16); s += __shfl_xor(s, 32);
        const float mean = s * (1.0f / 64.0f);
        float q = 0.f;
#pragma unroll
        for (int nt = 0; nt < 4; ++nt)
#pragma unroll
            for (int r = 0; r < 4; ++r) { const float d = y[nt][r] - mean; q += d * d; }
        q += __shfl_xor(q, 16); q += __shfl_xor(q, 32);
        const float rstd = 1.0f / sqrtf(q * (1.0f / 64.0f) + GN_EPS);
#pragma unroll
        for (int nt = 0; nt < 4; ++nt) { const int ch = h * 64 + 16 * nt + 4 * fq;
            const f32x4 pv = (f32x4){bflo(GB.pv[nt].x), bfhi(GB.pv[nt].x), bflo(GB.pv[nt].y), bfhi(GB.pv[nt].y)}, qv = (f32x4){bflo(GB.qv[nt].x), bfhi(GB.qv[nt].x), bflo(GB.qv[nt].y), bfhi(GB.qv[nt].y)};
            const f32x4 z = (f32x4){bflo(GB.zw[nt].x), bfhi(GB.zw[nt].x), bflo(GB.zw[nt].y), bfhi(GB.zw[nt].y)};
            const f32x4 vv = pv + (qv - pv) * GB.mu4[nt];
            f32x4 o4;
#pragma unroll
            for (int r = 0; r < 4; ++r) o4[r] = ((y[nt][r] - mean) * rstd * GB.g4[nt][r] + GB.b4[nt][r] + GB.bon * vv[r]) * (z[r] * sigmoidf_(z[r]));
            u32x2 ow; ow.x = pk2(o4[0], o4[1]); ow.y = pk2(o4[2], o4[3]);
            *(u32x2*)(F.YCAT + m * DBR + ch) = ow; }
    }
}

__device__ __forceinline__ void p8_final(Frame& F) {
    const int gw = F.bid * NWAVES + F.wave, NGW = F.G * NWAVES;
    for (int m0 = gw; m0 < M; m0 += 2 * NGW) {
#pragma unroll
        for (int q = 0; q < 2; ++q) { const int m = (m0 + q * NGW < M) ? m0 + q * NGW : m0;
            const f32x4* xr = (const f32x4*)(F.x + (size_t)m * DM) + 2 * F.lane; const f32x4* gr = (const f32x4*)F.post_g + 2 * F.lane;
            const u32x4* orow = (const u32x4*)(F.OBF + (size_t)m * DM) + F.lane;
            f32x4* outr = (f32x4*)(F.out + (size_t)m * DM) + 2 * F.lane;
            u32x4 ow[4]; f32x4 x0[4], x1[4];
#pragma unroll
            for (int jj = 0; jj < 4; ++jj) { ow[jj] = orow[64 * jj]; x0[jj] = xr[128 * jj]; x1[jj] = xr[128 * jj + 1]; }
            float ss = (F.lane < 32) ? F.SSP[(size_t)m * 32 + F.lane] : 0.f;
            ss = wave_sum(ss);
            const float rstd = 1.0f / sqrtf(ss * (1.f / DM) + NORM_EPS);
#pragma unroll
            for (int jj = 0; jj < 4; ++jj) { float ov[8]; unpack8(ow[jj], ov);
                const f32x4 g0 = gr[128 * jj], g1 = gr[128 * jj + 1];
                outr[128 * jj] = x0[jj] + (f32x4){ov[0], ov[1], ov[2], ov[3]} * rstd * g0; outr[128 * jj + 1] = x1[jj] + (f32x4){ov[4], ov[5], ov[6], ov[7]} * rstd * g1; }
        }
    }
}

struct Args { const float* in[22]; float* out; unsigned char* ws; int ph_lo, ph_hi, li, pad; };
constexpr int N_PHASES = 9;
__global__ void __launch_bounds__(NTHREADS, 2) mk_fwd(Args args) {
    extern __shared__ __attribute__((aligned(16))) unsigned char lds[];
    Frame F;
    F.lds = (LAS unsigned char*)lds;
    F.tid = threadIdx.x; F.lane = F.tid & 63; F.wave = __builtin_amdgcn_readfirstlane(F.tid >> 6);
    F.G = gridDim.x; F.bid = blockIdx.x;
    unsigned char* ws = args.ws;
    F.x = args.in[0]; F.pre_g = args.in[1]; F.post_g = args.in[2]; F.w_in = args.in[3]; F.mu_rkv = args.in[4]; F.mu_wa = args.in[5]; F.w0 = args.in[6]; F.w1 = args.in[7]; F.w2 = args.in[8];
    F.a0 = args.in[9]; F.a1 = args.in[10]; F.a2 = args.in[11]; F.k_k = args.in[12]; F.k_a = args.in[13]; F.r_k = args.in[14]; F.lnx_g = args.in[15]; F.lnx_b = args.in[16]; F.rel_bias = args.in[17];
    F.w_br = args.in[18]; F.w_ba = args.in[19]; F.b_merge = args.in[20]; F.w_out = args.in[21]; F.out = args.out;
    F.HB = (bf16_t*)((unsigned char*)args.out + DO_HB); F.WIN_T = (bf16_t*)((unsigned char*)args.out + DO_WIN); F.STATES = (bf16_t*)((unsigned char*)args.out + DO_STATES);
    F.MD = (bf16_t*)((unsigned char*)args.out + DO_MD); F.ND = (bf16_t*)((unsigned char*)args.out + DO_ND); F.QD = (bf16_t*)((unsigned char*)args.out + DO_QD);
    F.WCAT_T = (bf16_t*)(ws + WS_WCAT); F.WOUT_T = (bf16_t*)(ws + WS_WOUT); F.W2T = (bf16_t*)(ws + WS_W2T); F.A2T = F.W2T + DBR * 64;
    F.BONUS = (float*)(ws + WS_BONUS); F.SSP = (float*)(ws + WS_SSP); F.PL = (bf16_t*)(ws + WS_PLS); F.PG = (bf16_t*)(ws + WS_PG); F.PA = (bf16_t*)(ws + WS_PA);
    F.MERGED = (bf16_t*)(ws + WS_MERGED); F.YCAT = (bf16_t*)(ws + WS_YCAT); F.OBF = (bf16_t*)(ws + WS_OBF); F.queue = (unsigned*)(ws + WS_CTL) + 65536;
    for (int u = F.tid; u < (LDS_BYTES - LDSCTL_OFF) / 4; u += NTHREADS) ((LAS unsigned*)(F.lds + LDSCTL_OFF))[u] = 0u;
    __syncthreads();
    const int lo = args.ph_lo, hi = args.ph_hi;
    XcdBarrier bar; bar.bar = (unsigned*)(ws + WS_CTL) + CW_BAR; bar.x = 0; bar.st = nullptr;
    if (hi - lo > 1) bar = xcd_barrier_post((unsigned*)(ws + WS_CTL) + CW_BAR, (volatile LAS unsigned*)(F.lds + MISC_OFF) + 8);
#define IN(k) (lo <= (k) && (k) < hi)
#define SEAM(k) do { if (IN(k) && IN((k) + 1)) xcd_barrier(bar); } while (0)
#define PHASE(k, ...) do { if (IN(k)) { __VA_ARGS__; SEAM(k); if (PROBE_REP == (k)) { __VA_ARGS__; xcd_barrier(bar); } } } while (0)
    PHASE(0, p0_prologue(F));
    PHASE(1, {
        pg8::Gemm g{F.HB, F.WIN_T, M, NIN, DM}; pg8::SplitOrder S; S.so.init(M, NPA + NPG, F.G, F.bid, DM, WGM_P1); S.extra_pn = (NPA + NPG) / 256;
        LAS float* bml = (LAS float*)(F.lds + RING_BYTES);
        for (int i = F.tid; i < 2 * DM / 4; i += NTHREADS) ((LAS f32x4*)bml)[i] = ((const f32x4*)F.b_merge)[i];
        __syncthreads();
        EpiIn E{F.PA, F.PG, F.PL, bml};
        pg8::gemm_phase<EpiIn, pg8::SplitOrder, P1_ALIGN, P1_SP2>(F.lds, g, S, E);
    });
    PHASE(3, p3_prep(F));
    PHASE(4, { p4_scan(F); p2_attention(F); });
    PHASE(5, p5_out(F));
    PHASE(6, {
        pg8::Gemm g{F.YCAT, F.WCAT_T, 2 * M, 2 * DM, DBR}; pg8::PairOrder S; S.so.init(M, DM, F.G, F.bid, DBR, WGM_P6); S.dpm = M / 256; S.dpn = DM / 256;
        EpiBranch E{F.PG, F.MERGED};
        pg8::gemm_phase<EpiBranch, pg8::PairOrder, true, true>(F.lds, g, S, E);
    });
    PHASE(7, {
        pg8::Gemm g{F.MERGED, F.WOUT_T, M, DM, DM}; pg8::StaticOrder S; S.init(M, DM, F.G, F.bid, DM, WGM_P7);
        EpiOut E{F.OBF, F.SSP};
        pg8::gemm_phase<EpiOut, pg8::StaticOrder, true, true>(F.lds, g, S, E);
    });
    if (IN(8)) { p8_final(F); }
#undef PHASE
#undef IN
#undef SEAM
}

extern "C" void kernel_launch(void* const* d_in, const int* in_sizes, int n_in, void* d_out, int out_size, void* d_ws, size_t ws_size, hipStream_t stream) {
    static int grid = 0;
    if (grid == 0) {
        if (n_in != 22 || in_sizes[0] != M * DM || out_size != M * DM || ws_size < WS_END) { fprintf(stderr, "kernel_launch: unexpected shapes (n_in %d in0 %d out %d ws %zu); nothing launched\n", n_in, n_in > 0 ? in_sizes[0] : -1, out_size, ws_size); grid = -1; return; }
        int dev = 0, cus = 0;
        if (hipGetDevice(&dev) != hipSuccess || hipDeviceGetAttribute(&cus, hipDeviceAttributeMultiprocessorCount, dev) != hipSuccess) { fprintf(stderr, "kernel_launch: device query failed\n"); grid = -1; return; }
        if (hipFuncSetAttribute((const void*)mk_fwd, hipFuncAttributeMaxDynamicSharedMemorySize, LDS_BYTES) != hipSuccess) { fprintf(stderr, "kernel_launch: hipFuncSetAttribute failed\n"); grid = -1; return; }
        int per_cu = 0;
        if (hipOccupancyMaxActiveBlocksPerMultiprocessor(&per_cu, (const void*)mk_fwd, NTHREADS, LDS_BYTES) != hipSuccess || per_cu < 1) fprintf(stderr, "kernel_launch: note: occupancy query reports %d blocks per CU\n", per_cu);
        (void)hipGetLastError();
        grid = cus > 256 ? 256 : cus;
        if (grid != 256) { fprintf(stderr, "kernel_launch: this build needs a 256-CU device (got %d); nothing launched\n", cus); grid = -1; return; }
    }
    if (grid < 0) return;
    (void)hipMemsetAsync((char*)d_ws + WS_CTL, 0, CTL_ZERO_BYTES, stream);
    Args a{};
    for (int i = 0; i < 22; ++i) a.in[i] = (const float*)d_in[i];
    a.out = (float*)d_out; a.ws = (unsigned char*)d_ws;
#if MK_N_LAUNCHES == 1
    a.ph_lo = 0; a.ph_hi = N_PHASES; a.li = 0;
    hipLaunchKernelGGL(mk_fwd, dim3(grid), dim3(NTHREADS), LDS_BYTES, stream, a);
#else
    for (int li = 0; li < N_PHASES; ++li) { a.ph_lo = li; a.ph_hi = li + 1; a.li = li; hipLaunchKernelGGL(mk_fwd, dim3(grid), dim3(NTHREADS), LDS_BYTES, stream, a); }
#endif
}
```

```cpp
#include <hip/hip_runtime.h>
#include <cstdio>
#include <cstdint>

#ifndef MK_N_LAUNCHES
#define MK_N_LAUNCHES 1
#endif
#ifndef WGM_P1
#define WGM_P1 6
#endif
#ifndef WGM_P6
#define WGM_P6 2
#endif
#ifndef WGM_P7
#define WGM_P7 2
#endif
#ifndef P1_ALIGN
#define P1_ALIGN true
#endif
#ifndef P1_SP2
#define P1_SP2 true
#endif
#ifndef XCD_REMAP
#define XCD_REMAP 1
#endif
#ifndef ROT_COLS
#define ROT_COLS 0
#endif
#ifndef PROBE_REP
#define PROBE_REP -1
#endif

#define LAS __attribute__((address_space(3)))
#define GAS __attribute__((address_space(1)))
typedef unsigned short bf16_t;
typedef short bf16x8 __attribute__((ext_vector_type(8)));
typedef short s16x4 __attribute__((ext_vector_type(4)));
typedef float f32x4 __attribute__((ext_vector_type(4)));
typedef float f32x2 __attribute__((ext_vector_type(2)));
typedef unsigned u32x4 __attribute__((ext_vector_type(4)));
typedef unsigned u32x2 __attribute__((ext_vector_type(2)));
typedef __bf16 bf16x2_t __attribute__((ext_vector_type(2)));

constexpr int BATCH = 2, SEQ = 8192, DM = 2048, DBR = 1024, NH = 16, HD = 64, CHUNK = 64, NCHUNK = SEQ / CHUNK, M = BATCH * SEQ;
constexpr int NPA = 8192, NPG = 4096, NPL = 256, NIN = NPA + NPG + NPL;
constexpr int PA_R = 0, PA_K = 1024, PA_V = 2048, PA_ZR = 3072, PA_Q = 4096, PA_KA = 5120, PA_VA = 6144, PA_ZA = 7168;
constexpr int PG_R = 0, PG_K = 1, PG_V = 2, PG_ZR = 3, PG_Q = 4, PG_KA = 5, PG_VA = 6, PG_ZA = 7;
__host__ __device__ __forceinline__ size_t pah(int g, int b, int h) { return (size_t)((g * 2 + b) * 16 + h) * ((size_t)8192 * 64); }
constexpr float NORM_EPS = 1e-6f, GN_EPS = 64e-5f, DECAY_SCALE = 0.606531f;
constexpr int NWAVES = 8, NTHREADS = 512;

constexpr size_t MiB = 1u << 20;
constexpr size_t WS_CTL = 0, CTL_ZERO_BYTES = 1 * MiB;
constexpr size_t WS_WCAT = 1 * MiB;
constexpr size_t WS_WOUT = 9 * MiB;
constexpr size_t WS_W2T = 17 * MiB;
constexpr size_t WS_BT = 17 * MiB + 512 * 1024;
constexpr size_t WS_BONUS = 18 * MiB;
constexpr size_t WS_SSP = 19 * MiB;
constexpr size_t WS_PL = 22 * MiB;
constexpr size_t WS_PG = 30 * MiB;
constexpr size_t WS_PA = 158 * MiB;
constexpr size_t WS_MERGED = WS_PA;
constexpr size_t WS_OBF = WS_PA + 64 * MiB;
constexpr size_t WS_YCAT = 414 * MiB;
constexpr size_t WS_PLS = 478 * MiB;
constexpr size_t WS_END = 510 * MiB;
constexpr size_t DO_HB = 0, DO_WIN = 64 * MiB, DO_STATES = 0;
constexpr size_t DO_MD = 32 * MiB, DO_ND = 64 * MiB, DO_QD = 96 * MiB;
constexpr int CW_BAR = 4096;

constexpr int RING_BYTES = 131072;
constexpr int LDSCTL_OFF = 152576, MISC_OFF = LDSCTL_OFF + 320;
constexpr int LDS_BYTES = 153600;

typedef GAS unsigned gu32;
#define RLX_AGENT __ATOMIC_RELAXED, __HIP_MEMORY_SCOPE_AGENT
#define LDS_WAIT() asm volatile("s_waitcnt lgkmcnt(0)" ::: "memory")
#define VM_WAIT() asm volatile("s_waitcnt vmcnt(0)" ::: "memory")
__device__ __forceinline__ unsigned pk2(float lo, float hi) { f32x2 v = {lo, hi}; bf16x2_t b = __builtin_convertvector(v, bf16x2_t); return __builtin_bit_cast(unsigned, b); }
__device__ __forceinline__ bf16_t f2bf(float f) { return (bf16_t)(pk2(f, 0.f) & 0xffffu); }
__device__ __forceinline__ float bflo(unsigned w) { return __uint_as_float(w << 16); }
__device__ __forceinline__ float bfhi(unsigned w) { return __uint_as_float(w & 0xffff0000u); }
__device__ __forceinline__ float bf2f(bf16_t h) { return __uint_as_float(((unsigned)h) << 16); }
__device__ __forceinline__ void unpack8(const u32x4 w, float (&f)[8]) { f[0] = bflo(w.x); f[1] = bfhi(w.x); f[2] = bflo(w.y); f[3] = bfhi(w.y); f[4] = bflo(w.z); f[5] = bfhi(w.z); f[6] = bflo(w.w); f[7] = bfhi(w.w); }
__device__ __forceinline__ u32x4 pack8(const float (&f)[8]) { u32x4 w; w.x = pk2(f[0], f[1]); w.y = pk2(f[2], f[3]); w.z = pk2(f[4], f[5]); w.w = pk2(f[6], f[7]); return w; }
__device__ __forceinline__ void load8(const float* p, float (&f)[8]) { const f32x4 a = *(const f32x4*)p, b = *(const f32x4*)(p + 4); f[0] = a.x; f[1] = a.y; f[2] = a.z; f[3] = a.w; f[4] = b.x; f[5] = b.y; f[6] = b.z; f[7] = b.w; }
__device__ __forceinline__ float sigmoidf_(float x) { return __builtin_amdgcn_rcpf(1.f + __expf(-x)); }
__device__ __forceinline__ float tanhf_(float x) { return 1.f - 2.f * __builtin_amdgcn_rcpf(1.f + __expf(2.f * x)); }
__device__ __forceinline__ float xrow16_sum_(float x) {
    auto s = __builtin_amdgcn_permlane16_swap(__float_as_uint(x), __float_as_uint(x), false, false);
    x = __uint_as_float(s[0]) + __uint_as_float(s[1]);
    auto t = __builtin_amdgcn_permlane32_swap(__float_as_uint(x), __float_as_uint(x), false, false);
    return __uint_as_float(t[0]) + __uint_as_float(t[1]);
}

namespace pg8 {
constexpr int BM = 256, BK = 64, HALF = 128, HTB = HALF * BK * 2  , STAGE_BYTES = 8 * HTB, NXCD = 8;
__host__ __device__ __forceinline__ int lds_byte(int r, int c) { const int st = (r >> 4) * 2 + (c >> 5), rr = r & 15, cc = c & 31, ob = rr * 64 + cc * 2; return st * 1024 + (ob ^ (((ob >> 9) & 1) << 5)); }
__host__ __device__ __forceinline__ void stage_rc(int b, int& R, int& C) { const int st = b / 1024, sb = b % 1024, swz = sb ^ (((sb >> 9) & 1) << 5); R = (st >> 1) * 16 + swz / 64; C = (st & 1) * 32 + (swz % 64) / 2; }
__host__ __device__ __forceinline__ int perm32(int rho) { const int n = rho >> 4, i = rho & 15; return 8 * (i >> 2) + 4 * n + (i & 3); }

struct Unit { int pm, pn, kb, nt; };
struct Gemm { const bf16_t* A; const bf16_t* Bt; int M, N, K; };

struct StaticOrder {
    int nM, nN, nwg, G, c, ntk, WGM;
    __host__ __device__ void init(int M_, int N_, int G_, int c_, int K_, int wgm_) { nM = M_ / BM; nN = N_ / BM; nwg = nM * nN; G = G_; c = c_; ntk = K_ / BK; WGM = wgm_; }
    __host__ __device__ void tile(int L, int& pm, int& pn) const {
        int wgid = L; if (XCD_REMAP) { const int q = nwg / NXCD, r = nwg % NXCD, xcd = wgid % NXCD, off = wgid / NXCD; wgid = (xcd < r ? xcd * (q + 1) : r * (q + 1) + (xcd - r) * q) + off; }
        if (WGM > 0) { const int nig = WGM * nN, gid = wgid / nig, fm = gid * WGM, gsz = (nM - fm) < WGM ? (nM - fm) : WGM;
            pm = fm + ((wgid % nig) % gsz); pn = (wgid % nig) / gsz;
            if (ROT_COLS) pn = (pn + ROT_COLS * gid) % nN; }
        else { const int W = -WGM, nig = W * nM, gid = wgid / nig, fn = gid * W, gsz = (nN - fn) < W ? (nN - fn) : W;
            pn = fn + ((wgid % nig) % gsz); pm = (wgid % nig) / gsz; }
    }
    __host__ __device__ bool next(int i, Unit& u) const {
        const long L = (long)i * G + c; if (L >= nwg) return false;
        int pm, pn; tile((int)L, pm, pn);
        u.pm = pm; u.pn = pn; u.kb = 0; u.nt = ntk; return true;
    }
};
struct SplitOrder {
    StaticOrder so; int extra_pn;
    __host__ __device__ bool next(int i, Unit& u) const {
        const long L = (long)i * so.G + so.c; const bool normal = L < so.nwg; const int Lq = (int)(L - so.nwg);
        if (!normal && Lq >= 256) return false;
        int pm, pn; so.tile(normal ? (int)L : 0, pm, pn);
        u.pm = normal ? pm : (Lq >> 2); u.pn = normal ? pn : extra_pn; u.kb = normal ? 0 : (Lq & 3) * 1024; u.nt = normal ? so.ntk : 8; return true;
    }
};
struct PairOrder {
    StaticOrder so; int dpm, dpn;
    __host__ __device__ bool next(int i, Unit& u) const { if (!so.next(i >> 1, u)) return false; if (i & 1) { u.pm += dpm; u.pn += dpn; } return true; }
};

template <class Epi, class Sched, bool ALIGN_EPI = false, bool SP2 = false>
__device__ __forceinline__ void gemm_phase(LAS unsigned char* lds, const Gemm g, const Sched& S, const Epi& E) {
    const int tid = threadIdx.x, wid = __builtin_amdgcn_readfirstlane(tid >> 6), lane = tid & 63, wr = wid >> 2, wc = wid & 3, fr = lane & 15, fq = lane >> 4;
    const int K = g.K;
    unsigned voffA[2], voffB[2];
#pragma unroll
    for (int i = 0; i < 2; ++i) { int R, C; stage_rc(tid * 16 + i * 8192, R, C); const int Rb = Epi::PERM ? ((R >> 5) * 64 + perm32(R & 31)) : R;
        voffA[i] = (unsigned)(R * K + C) * 2u; voffB[i] = (unsigned)(Rb * K + C) * 2u; }
    const size_t kstep = (size_t)(BK * 2);
    const size_t hstep = (size_t)HALF * K * 2;
    const size_t tstep = 2 * hstep;
    const size_t hstepB = Epi::PERM ? (size_t)32 * K * 2 : hstep;
    const unsigned ldsw = (unsigned)wid * 1024u;
    const int aoff = lds_byte(wr * 64 + fr, fq * 8), boff = lds_byte(wc * 32 + fr, fq * 8);
#define PG8_SA(b, h) (((b) * 2 + (h)) * HTB)
#define PG8_SB(b, h) ((4 + (b) * 2 + (h)) * HTB)
#define PG8_STAGE(bufoff, gbase, voff) do { _Pragma("unroll") for (int _i = 0; _i < 2; ++_i) \
        __builtin_amdgcn_global_load_lds((const unsigned*)((const char*)(gbase) + (voff)[_i]), (LAS unsigned*)(lds + (bufoff) + ldsw + _i * 8192), 16, 0, 0); } while (0)
#define PG8_LDA(dst, b, h) do { _Pragma("unroll") for (int m = 0; m < 4; ++m) _Pragma("unroll") for (int k = 0; k < 2; ++k) dst[m][k] = *(const LAS bf16x8*)(lds + PG8_SA(b, h) + aoff + m * 2048 + k * 1024); } while (0)
#define PG8_LDB(dst, b, h) do { _Pragma("unroll") for (int n = 0; n < 2; ++n) _Pragma("unroll") for (int k = 0; k < 2; ++k) dst[n][k] = *(const LAS bf16x8*)(lds + PG8_SB(b, h) + boff + n * 2048 + k * 1024); } while (0)
#define PG8_MMA(ai, bj, At, Bt) do { __builtin_amdgcn_s_setprio(1); _Pragma("unroll") for (int m = 0; m < 4; ++m) _Pragma("unroll") for (int n = 0; n < 2; ++n) _Pragma("unroll") for (int k = 0; k < 2; ++k) \
        acc[ai][bj][m][n] = __builtin_amdgcn_mfma_f32_16x16x32_bf16(Bt[n][k], At[m][k], acc[ai][bj][m][n], 0, 0, 0); __builtin_amdgcn_s_setprio(0); } while (0)
#define PG8_WAIT_V(n) asm volatile("s_waitcnt vmcnt(" #n ")" ::: "memory")
#define PG8_WAIT_L(n) asm volatile("s_waitcnt lgkmcnt(" #n ")" ::: "memory")
#define PG8_BAR __builtin_amdgcn_s_barrier()
#define PG8_SCHED __builtin_amdgcn_sched_barrier(0)
    Unit cur, nxt; int ui = 0;
    if (!S.next(0, cur)) return;
    f32x4 acc[2][2][4][2];
#pragma unroll
    for (int a = 0; a < 2; ++a)
#pragma unroll
        for (int b = 0; b < 2; ++b)
#pragma unroll
            for (int m = 0; m < 4; ++m)
#pragma unroll
                for (int n = 0; n < 2; ++n) acc[a][b][m][n] = (f32x4){0.f, 0.f, 0.f, 0.f};
    bf16x8 At[4][2], B0[2][2], B1[2][2];
    const char* cA = (const char*)g.A + (size_t)cur.pm * tstep + cur.kb; const char* cB = (const char*)g.Bt + (size_t)cur.pn * tstep + cur.kb;
    if constexpr (SP2) {
        PG8_STAGE(PG8_SB(0, 0), cB, voffB); PG8_STAGE(PG8_SB(0, 1), cB + hstepB, voffB); PG8_STAGE(PG8_SA(0, 0), cA, voffA); PG8_STAGE(PG8_SA(0, 1), cA + hstep, voffA);
        if (wr == 1) PG8_BAR;
        PG8_WAIT_V(2); PG8_BAR;
        PG8_STAGE(PG8_SB(1, 0), cB + kstep, voffB); PG8_STAGE(PG8_SA(1, 0), cA + kstep, voffA); PG8_STAGE(PG8_SB(1, 1), cB + hstepB + kstep, voffB);
        PG8_WAIT_V(6); PG8_BAR;
    } else {
        PG8_STAGE(PG8_SB(0, 0), cB, voffB); PG8_STAGE(PG8_SA(0, 0), cA, voffA); PG8_STAGE(PG8_SB(0, 1), cB + hstepB, voffB); PG8_STAGE(PG8_SA(0, 1), cA + hstep, voffA);
        if (wr == 1) PG8_BAR;
        PG8_WAIT_V(4); PG8_BAR;
        PG8_STAGE(PG8_SB(1, 0), cB + kstep, voffB); PG8_STAGE(PG8_SA(1, 0), cA + kstep, voffA); PG8_STAGE(PG8_SB(1, 1), cB + hstepB + kstep, voffB);
        PG8_WAIT_V(6); PG8_BAR;
    }
    for (;;) {
        const bool has_next = S.next(ui + 1, nxt);
        const char* nA = has_next ? (const char*)g.A + (size_t)nxt.pm * tstep + nxt.kb : cA; const char* nB = has_next ? (const char*)g.Bt + (size_t)nxt.pn * tstep + nxt.kb : cB;
        const int nt = cur.nt;
        for (int t = 0; t < nt; t += 2) {
            const bool last = (t == nt - 2);
            const char* a1 = cA + (size_t)(t + 1) * kstep;
            const char* a2 = last ? nA : cA + (size_t)(t + 2) * kstep; const char* b2 = last ? nB : cB + (size_t)(t + 2) * kstep;
            const char* a3 = a2 + kstep; const char* b3 = b2 + kstep;
            if constexpr (SP2) {
            PG8_LDB(B0, 0, 0); PG8_LDB(B1, 0, 1); PG8_SCHED; PG8_LDA(At, 0, 0); PG8_STAGE(PG8_SA(1, 1), a1 + hstep, voffA);
            PG8_WAIT_V(8); PG8_WAIT_L(0); PG8_BAR; PG8_MMA(0, 0, At, B0); PG8_MMA(0, 1, At, B1); PG8_BAR; PG8_SCHED;
            PG8_LDA(At, 0, 1); PG8_STAGE(PG8_SB(0, 0), b2, voffB); PG8_STAGE(PG8_SB(0, 1), b2 + hstepB, voffB); PG8_STAGE(PG8_SA(0, 0), a2, voffA);
            PG8_WAIT_V(8); PG8_WAIT_L(0); PG8_BAR; PG8_MMA(1, 0, At, B0); PG8_MMA(1, 1, At, B1); PG8_BAR; PG8_SCHED;
            PG8_LDB(B0, 1, 0); PG8_LDB(B1, 1, 1); PG8_SCHED; PG8_LDA(At, 1, 0); PG8_STAGE(PG8_SA(0, 1), a2 + hstep, voffA);
            PG8_WAIT_V(8); PG8_WAIT_L(0); PG8_BAR; PG8_MMA(0, 0, At, B0); PG8_MMA(0, 1, At, B1); PG8_BAR; PG8_SCHED;
            PG8_LDA(At, 1, 1); PG8_STAGE(PG8_SB(1, 0), b3, voffB); PG8_STAGE(PG8_SB(1, 1), b3 + hstepB, voffB); PG8_STAGE(PG8_SA(1, 0), a3, voffA);
            PG8_WAIT_V(8); PG8_WAIT_L(0); PG8_BAR; PG8_MMA(1, 0, At, B0); PG8_MMA(1, 1, At, B1); PG8_BAR; PG8_SCHED;
            } else {
            PG8_LDB(B0, 0, 0); PG8_SCHED; PG8_LDA(At, 0, 0); PG8_STAGE(PG8_SA(1, 1), a1 + hstep, voffA);
            PG8_WAIT_L(8); PG8_BAR; PG8_WAIT_L(0); PG8_MMA(0, 0, At, B0); PG8_BAR; PG8_SCHED;
            PG8_LDB(B1, 0, 1); PG8_STAGE(PG8_SB(0, 0), b2, voffB);
            PG8_BAR; PG8_WAIT_L(0); PG8_MMA(0, 1, At, B1); PG8_BAR;
            PG8_LDA(At, 0, 1); PG8_STAGE(PG8_SA(0, 0), a2, voffA);
            PG8_BAR; PG8_WAIT_L(0); PG8_MMA(1, 0, At, B0); PG8_BAR; PG8_SCHED;
            PG8_STAGE(PG8_SB(0, 1), b2 + hstepB, voffB);
            PG8_WAIT_V(6); PG8_BAR; PG8_MMA(1, 1, At, B1); PG8_BAR;
            PG8_LDB(B0, 1, 0); PG8_SCHED; PG8_LDA(At, 1, 0); PG8_STAGE(PG8_SA(0, 1), a2 + hstep, voffA);
            PG8_WAIT_L(8); PG8_BAR; PG8_WAIT_L(0); PG8_MMA(0, 0, At, B0); PG8_BAR; PG8_SCHED;
            PG8_LDB(B1, 1, 1); PG8_STAGE(PG8_SB(1, 0), b3, voffB);
            PG8_BAR; PG8_WAIT_L(0); PG8_MMA(0, 1, At, B1); PG8_BAR;
            PG8_LDA(At, 1, 1); PG8_STAGE(PG8_SA(1, 0), a3, voffA);
            PG8_BAR; PG8_WAIT_L(0); PG8_MMA(1, 0, At, B0); PG8_BAR; PG8_SCHED;
            PG8_STAGE(PG8_SB(1, 1), b3 + hstepB, voffB);
            PG8_WAIT_V(6); PG8_BAR; PG8_MMA(1, 1, At, B1); PG8_BAR;
            }
        }
        if constexpr (ALIGN_EPI) { if (wr == 0) PG8_BAR; }
        const bool zero_acc = E(acc, cur, wr, wc, fr, fq);
        if (!has_next) break;
        if (zero_acc) {
#pragma unroll
        for (int a = 0; a < 2; ++a)
#pragma unroll
            for (int b = 0; b < 2; ++b)
#pragma unroll
                for (int m = 0; m < 4; ++m)
#pragma unroll
                    for (int n = 0; n < 2; ++n) acc[a][b][m][n] = (f32x4){0.f, 0.f, 0.f, 0.f};
        }
        cur = nxt; cA = nA; cB = nB; ++ui;
        if constexpr (ALIGN_EPI) { if (wr == 1) PG8_BAR; }
    }
    PG8_WAIT_V(0);
    if constexpr (!ALIGN_EPI) { if (wr == 0) PG8_BAR; }
    PG8_BAR;
#undef PG8_SA
#undef PG8_SB
#undef PG8_STAGE
#undef PG8_LDA
#undef PG8_LDB
#undef PG8_MMA
#undef PG8_WAIT_V
#undef PG8_WAIT_L
#undef PG8_BAR
#undef PG8_SCHED
}
}

struct EpiIn {
    static constexpr bool PERM = true;
    bf16_t* PA; bf16_t* PG; bf16_t* PL; const LAS float* bmerge;
    __device__ __forceinline__ bool operator()(f32x4 (&acc)[2][2][4][2], const pg8::Unit& u, int wr, int wc, int fr, int fq) const {
        const int row0 = u.pm * 256 + wr * 64 + fr; const int colb = u.pn * 256 + wc * 64 + 8 * fq;
        if (u.pn < 32) {
            if (u.pn >= 16 && u.pn < 20) {
#pragma unroll
                for (int ai = 0; ai < 2; ++ai)
#pragma unroll
                    for (int bj = 0; bj < 2; ++bj)
#pragma unroll
                        for (int m = 0; m < 4; ++m) { acc[ai][bj][m][0] = acc[ai][bj][m][0] * 0.125f; acc[ai][bj][m][1] = acc[ai][bj][m][1] * 0.125f; } }
#pragma unroll
            for (int ai = 0; ai < 2; ++ai)
#pragma unroll
                for (int m = 0; m < 4; ++m) { const int row = row0 - fr + (fr & 7) + ai * 128 + m * 16; const bool hi = fr >> 3;
                    bf16_t* rowp = PA + pah(u.pn >> 2, row >> 13, 4 * (u.pn & 3) + wc) + (size_t)(row & 8191) * 64 + 8 * fq + 32 * (fr >> 3);
                    u32x4 w[2];
#pragma unroll
                    for (int bj = 0; bj < 2; ++bj) { const f32x4 v0 = acc[ai][bj][m][0], v1 = acc[ai][bj][m][1];
                        w[bj].x = pk2(v0[0], v0[1]); w[bj].y = pk2(v0[2], v0[3]); w[bj].z = pk2(v1[0], v1[1]); w[bj].w = pk2(v1[2], v1[3]); }
                    const u32x4 t = hi ? w[0] : w[1]; u32x4 r;
#pragma unroll
                    for (int c = 0; c < 4; ++c) r[c] = (unsigned)__builtin_amdgcn_mov_dpp((int)t[c], 0x128, 0xf, 0xf, true);
                    __builtin_nontemporal_store(hi ? r : w[0], (u32x4*)rowp);
                    __builtin_nontemporal_store(hi ? w[1] : r, (u32x4*)(rowp + 8 * 64)); }
        } else if (u.pn < 48) {
            const int j0 = (u.pn - 32) * 128 + wc * 32 + 8 * fq;
            f32x4 bv[2][2];
#pragma unroll
            for (int bj = 0; bj < 2; ++bj)
#pragma unroll
                for (int n = 0; n < 2; ++n) bv[bj][n] = *(const LAS f32x4*)(bmerge + bj * 2048 + j0 + 4 * n);
#pragma unroll
            for (int ai = 0; ai < 2; ++ai)
#pragma unroll
                for (int m = 0; m < 4; ++m) {
                    bf16_t* rowp = PG + ((((((size_t)(u.pm * 16 + (u.pn - 32)) * 2 + 0) * 2 + ai) * 4 + m) * 8 + (wr * 4 + wc)) * 64 + (fq * 16 + fr)) * 8;
                    float rat[8], ga[8];
#pragma unroll
                    for (int n = 0; n < 2; ++n)
#pragma unroll
                        for (int e = 0; e < 4; ++e) {
                            const float dr = 1.0f + __builtin_amdgcn_exp2f(fmaf(acc[ai][0][m][n][e], -1.4426950408889634f, bv[0][n][e])), da = 1.0f + __builtin_amdgcn_exp2f(fmaf(acc[ai][1][m][n][e], -1.4426950408889634f, bv[1][n][e]));
                            ga[4 * n + e] = __builtin_amdgcn_rcpf(da); rat[4 * n + e] = da * __builtin_amdgcn_rcpf(dr); }
                    __builtin_nontemporal_store(pack8(rat), (u32x4*)rowp); __builtin_nontemporal_store(pack8(ga), (u32x4*)(rowp + (size_t)2 * 4 * 8 * 64 * 8)); }
        } else {
            const int cl = colb - NPA - NPG;
#pragma unroll
            for (int ai = 0; ai < 2; ++ai)
#pragma unroll
                for (int m = 0; m < 4; ++m) { bf16_t* rowp = PL + (size_t)(u.kb >> 10) * ((size_t)M * NPL) + (size_t)(row0 + ai * 128 + m * 16) * NPL + cl;
#pragma unroll
                    for (int bj = 0; bj < 2; ++bj) { const f32x4 v0 = acc[ai][bj][m][0], v1 = acc[ai][bj][m][1];
                        u32x4 w; w.x = pk2(v0[0], v0[1]); w.y = pk2(v0[2], v0[3]); w.z = pk2(v1[0], v1[1]); w.w = pk2(v1[2], v1[3]);
                        *(u32x4*)(rowp + bj * 32) = w; } }
        }
        return true;
    }
};
struct EpiBranch {
    static constexpr bool PERM = true;
    const bf16_t* PG; bf16_t* MG;
    __device__ __forceinline__ bool operator()(f32x4 (&acc)[2][2][4][2], const pg8::Unit& u, int wr, int wc, int fr, int fq) const {
        const bool first = u.pm < 64;
        const int pm = first ? u.pm : u.pm - 64, pn = first ? u.pn : u.pn - 8;
        const int row0 = pm * 256 + wr * 64 + fr; const int colb = pn * 256 + wc * 64 + 8 * fq;
        const int lane_ = fq * 16 + fr, wid_ = wr * 4 + wc;
#pragma unroll
        for (int ai = 0; ai < 2; ++ai) {
            u32x4 g_[4][2];
#pragma unroll
            for (int m = 0; m < 4; ++m)
#pragma unroll
                for (int bj = 0; bj < 2; ++bj) g_[m][bj] = __builtin_nontemporal_load((const u32x4*)(PG + ((((((size_t)(pm * 16 + 2 * pn + (wc >> 1)) * 2 + (first ? 0 : 1)) * 2 + ai) * 4 + m) * 8 + (wr * 4 + 2 * (wc & 1) + bj)) * 64 + lane_) * 8));
#pragma unroll
            for (int m = 0; m < 4; ++m) { const size_t row = (size_t)(row0 + ai * 128 + m * 16);
#pragma unroll
                for (int bj = 0; bj < 2; ++bj) { float g[8]; unpack8(g_[m][bj], g);
#pragma unroll
                    for (int e = 0; e < 4; ++e) { acc[ai][bj][m][0][e] *= g[e]; acc[ai][bj][m][1][e] *= g[4 + e]; }
                    if (!first) { const f32x4 v0 = acc[ai][bj][m][0], v1 = acc[ai][bj][m][1];
                        u32x4 w; w.x = pk2(v0[0], v0[1]); w.y = pk2(v0[2], v0[3]); w.z = pk2(v1[0], v1[1]); w.w = pk2(v1[2], v1[3]);
                        *(u32x4*)(MG + row * DM + colb + bj * 32) = w; } } }
            asm volatile("" ::: "memory");
        }
        return !first;
    }
};
struct EpiOut {
    static constexpr bool PERM = true;
    bf16_t* O; float* SSP;
    __device__ __forceinline__ bool operator()(f32x4 (&acc)[2][2][4][2], const pg8::Unit& u, int wr, int wc, int fr, int fq) const {
        const int row0 = u.pm * 256 + wr * 64 + fr; const int colb = u.pn * 256 + wc * 64 + 8 * fq;
#pragma unroll
        for (int ai = 0; ai < 2; ++ai)
#pragma unroll
            for (int m = 0; m < 4; ++m) { const size_t row = (size_t)(row0 + ai * 128 + m * 16); float ss = 0.f;
#pragma unroll
                for (int bj = 0; bj < 2; ++bj) { const f32x4 v0 = acc[ai][bj][m][0], v1 = acc[ai][bj][m][1];
                    ss += (v0[0] * v0[0] + v0[1] * v0[1]) + (v0[2] * v0[2] + v0[3] * v0[3]) + (v1[0] * v1[0] + v1[1] * v1[1]) + (v1[2] * v1[2] + v1[3] * v1[3]);
                    u32x4 w; w.x = pk2(v0[0], v0[1]); w.y = pk2(v0[2], v0[3]); w.z = pk2(v1[0], v1[1]); w.w = pk2(v1[2], v1[3]);
                    *(u32x4*)(O + row * DM + colb + bj * 32) = w; }
                ss = xrow16_sum_(ss);
                if (fq == 0) SSP[row * 32 + u.pn * 4 + wc] = ss; }
        return true;
    }
};

#define XB_TMO      128
#define XB_XCNT(j)  (256  + 64 * (j))
#define XB_XSUB(j)  (1280 + 64 * (j))
#define XB_XGEN(j)  (2304 + 64 * (j))
#define XB_TOP      3328
#define XB_TOPGEN   3392
#define XCD_BAR_WORDS 3456
#define XB_SPIN_CAP (1u << 18)
__device__ __forceinline__ unsigned xb_ld(unsigned* p)              { return __hip_atomic_load(p, __ATOMIC_RELAXED, __HIP_MEMORY_SCOPE_AGENT); }
__device__ __forceinline__ unsigned xb_add(unsigned* p, unsigned v) { return __hip_atomic_fetch_add(p, v, __ATOMIC_RELAXED, __HIP_MEMORY_SCOPE_AGENT); }
__device__ __forceinline__ unsigned xb_xcc_id() { return (unsigned)__builtin_amdgcn_s_getreg((3 << 11) | 20) & 0xFu; }
#define XB_SPIN(cond, bar) do { unsigned _sp = 0; while (cond) { __builtin_amdgcn_s_sleep(1); \
    if ((++_sp & 255u) == 0u) { if (xb_ld(&(bar)[XB_TMO])) break; if (_sp > XB_SPIN_CAP) { atomicAdd(&(bar)[XB_TMO], 1u); break; } } } } while (0)
struct XcdBarrier { unsigned* bar; unsigned x; volatile LAS unsigned* st; };
__device__ __forceinline__ XcdBarrier xcd_barrier_post(unsigned* bar, volatile LAS unsigned* st) {
    XcdBarrier b; b.bar = bar; b.x = xb_xcc_id(); b.st = st;
    if (threadIdx.x == 0) (void)xb_add(&bar[XB_XCNT(b.x)], 1u);
    return b;
}
__device__ __forceinline__ void xcd_barrier_complete(unsigned* bar, unsigned x, unsigned& nloc, unsigned& nx) {
    const unsigned G = gridDim.x * gridDim.y * gridDim.z;
    unsigned sum, cnt, mine, sp = 0u;
    for (;;) {
        sum = 0u; cnt = 0u; mine = 0u;
#pragma unroll
        for (unsigned j = 0; j < 16; ++j) { const unsigned c = xb_ld(&bar[XB_XCNT(j)]); sum += c; cnt += (c > 0u) ? 1u : 0u; mine = (j == x) ? c : mine; }
        if (sum == G) break;
        __builtin_amdgcn_s_sleep(1);
        if ((++sp & 255u) == 0u) { if (xb_ld(&bar[XB_TMO])) break; if (sp > XB_SPIN_CAP) { atomicAdd(&bar[XB_TMO], 1u); break; } }
    }
    nloc = mine > 0u ? mine : 1u; nx = cnt > 0u ? cnt : 1u;
}
__device__ __forceinline__ void xcd_barrier(const XcdBarrier& b) {
    asm volatile("s_waitcnt vmcnt(0)" ::: "memory");
    __syncthreads();
    if (threadIdx.x == 0) {
        unsigned* bar = b.bar;
        __builtin_amdgcn_s_waitcnt(0);
        unsigned nloc = b.st[0], nx = b.st[1];
        if (nloc == 0u) { xcd_barrier_complete(bar, b.x, nloc, nx); b.st[0] = nloc; b.st[1] = nx; }
        const unsigned old = xb_add(&bar[XB_XSUB(b.x)], 1u);
        const unsigned gen = old / nloc;
        if (old + 1u == (gen + 1u) * nloc) {
            __builtin_amdgcn_fence(__ATOMIC_RELEASE, "agent");
            asm volatile("s_waitcnt vmcnt(0)" ::: "memory");
            const unsigned og = xb_add(&bar[XB_TOP], 1u);
            const unsigned tg = og / nx;
            if (og + 1u == (tg + 1u) * nx) xb_add(&bar[XB_TOPGEN], 1u);
            else XB_SPIN(xb_ld(&bar[XB_TOPGEN]) == tg, bar);
            __builtin_amdgcn_fence(__ATOMIC_ACQUIRE, "agent");
            xb_add(&bar[XB_XGEN(b.x)], 1u);
            asm volatile("s_waitcnt vmcnt(0)" ::: "memory");
        } else {
            XB_SPIN(xb_ld(&bar[XB_XGEN(b.x)]) == gen, bar);
            __builtin_amdgcn_fence(__ATOMIC_ACQUIRE, "agent");
            asm volatile("s_waitcnt vmcnt(0)" ::: "memory");
        }
    }
    __syncthreads();
}

struct Frame {
    LAS unsigned char* lds;
    int tid, lane, wave, G, bid;
    const float *x, *pre_g, *post_g, *w_in, *mu_rkv, *mu_wa, *w0, *w1, *w2, *a0, *a1, *a2, *k_k, *k_a, *r_k, *lnx_g, *lnx_b, *rel_bias, *w_br, *w_ba, *b_merge, *w_out;
    float* out;
    bf16_t *HB, *WIN_T, *WCAT_T, *WOUT_T, *W2T, *A2T, *PA, *PG, *PL, *YCAT, *MERGED, *STATES;
    float *BONUS, *SSP;
    bf16_t* OBF; bf16_t *MD, *ND, *QD; unsigned* queue; float* BT;
};

__device__ __forceinline__ float wave_sum(float v) {
#pragma unroll
    for (int o = 1; o < 64; o <<= 1) v += __shfl_xor(v, o);
    return v;
}

struct P0Item { const float* src; bf16_t* dst; const float* mu; float s0, s1; int N, K; };
__device__ __forceinline__ P0Item p0_mk(const float* W, int K, int N, bf16_t* WT, int row_off, int item, const float* mu, float s0, float s1, bool gate_remap = false) {
    const int nblk = N / 32, kb = item / nblk, nb = item % nblk, k0 = 64 * kb, n0 = 32 * nb;
    int d0 = n0; if (gate_remap && n0 >= NPA) { const int g = n0 - NPA, br = g >> 11, j0 = g & 2047; d0 = NPA + 256 * (j0 >> 7) + 64 * ((j0 & 127) >> 5) + 32 * br + (j0 & 31); }
    P0Item T; T.src = W + (size_t)k0 * N + n0; T.dst = WT + (size_t)(row_off + d0) * K + k0; T.mu = mu ? mu + k0 : nullptr; T.s0 = s0; T.s1 = s1; T.N = N; T.K = K; return T;
}
constexpr int P0_I_IN = (DM / 64) * (NPA + NPG) / 32, P0_I_L = (DM / 64) * (64 / 32), P0_I_BR = (DBR / 64) * (DM / 32), P0_I_OUT = (DM / 64) * (DM / 32), P0_I_W2 = (64 / 64) * (DBR / 32);
constexpr int P0_NITEMS = P0_I_IN + 4 * P0_I_L + 2 * P0_I_BR + P0_I_OUT + 2 * P0_I_W2;
template <class FrameT> __device__ __forceinline__ P0Item p0_decode(FrameT& F, int it) {
    int r = it;
    if (r < P0_I_IN) return p0_mk(F.w_in, DM, NPA + NPG, F.WIN_T, 0, r, nullptr, 1.f, 0.f, true); r -= P0_I_IN;
    if (r < P0_I_L) return p0_mk(F.w1, DM, 64, F.WIN_T, NPA + NPG + 0, r, F.mu_wa, 1.f, -1.f); r -= P0_I_L;
    if (r < P0_I_L) return p0_mk(F.w1, DM, 64, F.WIN_T, NPA + NPG + 64, r, F.mu_wa, 0.f, 1.f); r -= P0_I_L;
    if (r < P0_I_L) return p0_mk(F.a1, DM, 64, F.WIN_T, NPA + NPG + 128, r, F.mu_wa + DM, 1.f, -1.f); r -= P0_I_L;
    if (r < P0_I_L) return p0_mk(F.a1, DM, 64, F.WIN_T, NPA + NPG + 192, r, F.mu_wa + DM, 0.f, 1.f); r -= P0_I_L;
    if (r < P0_I_BR) return p0_mk(F.w_br, DBR, DM, F.WCAT_T, 0, r, nullptr, 1.f, 0.f); r -= P0_I_BR;
    if (r < P0_I_BR) return p0_mk(F.w_ba, DBR, DM, F.WCAT_T, DM, r, nullptr, 1.f, 0.f); r -= P0_I_BR;
    if (r < P0_I_OUT) return p0_mk(F.w_out, DM, DM, F.WOUT_T, 0, r, nullptr, 1.f, 0.f); r -= P0_I_OUT;
    if (r < P0_I_W2) return p0_mk(F.w2, 64, DBR, F.W2T, 0, r, nullptr, 1.f, 0.f); r -= P0_I_W2;
    return p0_mk(F.a2, 64, DBR, F.A2T, 0, r, nullptr, 1.f, 0.f);
}
__device__ __forceinline__ void p0_load(const P0Item& T, f32x4 (&v4)[8], int lane) {
#pragma unroll
    for (int i = 0; i < 8; ++i) { const int kk = 8 * i + (lane >> 3); v4[i] = __builtin_nontemporal_load((const f32x4*)(T.src + (size_t)kk * T.N + (lane & 7) * 4)); }
}
__device__ __forceinline__ void p0_store(const P0Item& T, f32x4 (&v4)[8], LAS float* scr, int lane) {
#pragma unroll
    for (int i = 0; i < 8; ++i) { const int kk = 8 * i + (lane >> 3); f32x4 v = v4[i]; if (T.mu) v = v * (T.s0 + T.s1 * T.mu[kk]);
        LAS float* d = scr + kk * 33 + (lane & 7) * 4; d[0] = v[0]; d[1] = v[1]; d[2] = v[2]; d[3] = v[3]; }
    LDS_WAIT(); asm volatile("" ::: "memory");
    const int c = lane & 7;
#pragma unroll
    for (int j = 0; j < 4; ++j) { const int n = (lane >> 3) + 8 * j; const LAS float* s = scr + (8 * c) * 33 + n;
        u32x4 o; o.x = pk2(s[0 * 33], s[1 * 33]); o.y = pk2(s[2 * 33], s[3 * 33]); o.z = pk2(s[4 * 33], s[5 * 33]); o.w = pk2(s[6 * 33], s[7 * 33]);
        *(u32x4*)(T.dst + (size_t)n * T.K + 8 * c) = o; }
    LDS_WAIT(); asm volatile("" ::: "memory");
}
__device__ __forceinline__ void p0_prologue(Frame& F) {
    LAS float* scr = (LAS float*)(F.lds + F.wave * 16384);
    const int gw = F.bid * NWAVES + F.wave, NGW = F.G * NWAVES;
    if (gw < P0_NITEMS) {
        P0Item T = p0_decode(F, gw); f32x4 va[8]; p0_load(T, va, F.lane);
        for (int it = gw; it < P0_NITEMS; it += NGW) {
            const int itn = (it + NGW < P0_NITEMS) ? it + NGW : it;
            const P0Item Tn = p0_decode(F, itn); f32x4 vb[8]; p0_load(Tn, vb, F.lane);
            p0_store(T, va, scr, F.lane);
            T = Tn;
#pragma unroll
            for (int i = 0; i < 8; ++i) va[i] = vb[i];
        }
    }
    for (int tl = gw; tl < NH * 21; tl += NGW) { const int h = tl / 21, u = tl % 21 - 3, lfr = F.lane & 15, lfq = F.lane >> 4; f32x4 t4;
#pragma unroll
        for (int r = 0; r < 4; ++r) { int rel = 16 * u + (lfr - 4 * lfq - r); rel = rel < -256 ? -256 : (rel > 256 ? 256 : rel); t4[r] = F.rel_bias[h * 513 + rel + 256]; }
        ((f32x4*)F.BT)[(size_t)tl * 64 + F.lane] = t4; }
    f32x4 gp[8];
#pragma unroll
    for (int j = 0; j < 8; ++j) gp[j] = ((const f32x4*)F.pre_g + F.lane)[64 * j];
    for (int m = gw; m < M; m += 2 * NGW) {
        const int m2 = (m + NGW < M) ? m + NGW : m;
        const f32x4* xr = (const f32x4*)(F.x + (size_t)m * DM) + F.lane; const f32x4* xr2 = (const f32x4*)(F.x + (size_t)m2 * DM) + F.lane;
        f32x4 v[8], w[8]; float s = 0.f, s2 = 0.f;
#pragma unroll
        for (int j = 0; j < 8; ++j) { v[j] = __builtin_nontemporal_load(xr + 64 * j); w[j] = __builtin_nontemporal_load(xr2 + 64 * j); }
#pragma unroll
        for (int j = 0; j < 8; ++j) { s += (v[j].x * v[j].x + v[j].y * v[j].y) + (v[j].z * v[j].z + v[j].w * v[j].w); s2 += (w[j].x * w[j].x + w[j].y * w[j].y) + (w[j].z * w[j].z + w[j].w * w[j].w); }
        const float rstd = 1.0f / sqrtf(wave_sum(s) * (1.f / DM) + NORM_EPS), rstd2 = 1.0f / sqrtf(wave_sum(s2) * (1.f / DM) + NORM_EPS);
        u32x2* o8 = (u32x2*)(F.HB + (size_t)m * DM) + F.lane; u32x2* o82 = (u32x2*)(F.HB + (size_t)m2 * DM) + F.lane;
#pragma unroll
        for (int j = 0; j < 8; ++j) { const f32x4 g = gp[j]; u32x2 a; a.x = pk2(v[j].x * rstd * g.x, v[j].y * rstd * g.y); a.y = pk2(v[j].z * rstd * g.z, v[j].w * rstd * g.w); o8[64 * j] = a;
            u32x2 c; c.x = pk2(w[j].x * rstd2 * g.x, w[j].y * rstd2 * g.y); c.y = pk2(w[j].z * rstd2 * g.z, w[j].w * rstd2 * g.w); o82[64 * j] = c; }
    }
}

constexpr int LSTR = 72;
constexpr int SLOT = 64 * LSTR * 2;
__device__ __forceinline__ f32x4 mm16(const LAS bf16_t* A, int m0, const LAS bf16_t* Bt, int n0, f32x4 acc, int fr, int fq) {
#pragma unroll
    for (int ks = 0; ks < 2; ++ks) {
        const bf16x8 a = *(const LAS bf16x8*)(A + (m0 + fr) * LSTR + ks * 32 + fq * 8);
        const bf16x8 b = *(const LAS bf16x8*)(Bt + (n0 + fr) * LSTR + ks * 32 + fq * 8);
        acc = __builtin_amdgcn_mfma_f32_16x16x32_bf16(a, b, acc, 0, 0, 0);
    }
    return acc;
}

typedef short v4i16_t __attribute__((ext_vector_type(4)));
__device__ __forceinline__ s16x4 tr4(const LAS bf16_t* p) { return __builtin_bit_cast(s16x4, __builtin_amdgcn_ds_read_tr16_b64_v4i16((LAS v4i16_t*)p)); }
__device__ __forceinline__ s16x4 frag_tr16(const LAS bf16_t* X, int k0, int n0, int lane) {
    const int g = lane >> 4, q = (lane & 15) >> 2, p = lane & 3;
    return tr4(X + (k0 + 4 * g + q) * LSTR + n0 + 4 * p);
}
__device__ __forceinline__ bf16x8 frag_tr32(const LAS bf16_t* X, int k0, int n0, int lane) {
    const int g = lane >> 4, q = (lane & 15) >> 2, p = lane & 3;
    const s16x4 lo = tr4(X + (k0 + 8 * g + q) * LSTR + n0 + 4 * p), hi = tr4(X + (k0 + 8 * g + 4 + q) * LSTR + n0 + 4 * p);
    return (bf16x8){lo[0], lo[1], lo[2], lo[3], hi[0], hi[1], hi[2], hi[3]};
}

constexpr int P2_NBT = 21;
constexpr int P2_TB_OFF = 4 * SLOT;
struct KVRegs { u32x4 k0, v0; };
__device__ __forceinline__ void kv_load(KVRegs& R, const bf16_t* p, int koff) {
    constexpr size_t KV = (size_t)(PG_VA - PG_KA) * 2 * 16 * 8192 * 64;
    R.k0 = *(const u32x4*)(p + koff); R.v0 = *(const u32x4*)(p + KV + koff);
}
__device__ __forceinline__ void kv_store(const KVRegs& R, LAS unsigned char* kvb, int key0, int d80) {
    LAS bf16_t* Ks = (LAS bf16_t*)kvb; LAS bf16_t* Vs = (LAS bf16_t*)(kvb + SLOT);
    *(LAS u32x4*)(Ks + key0 * LSTR + d80) = R.k0; *(LAS u32x4*)(Vs + key0 * LSTR + d80) = R.v0;
}
__device__ __forceinline__ float max2_(float a, float b) { float r; asm("v_max_f32 %0, %1, %2" : "=v"(r) : "v"(a), "v"(b)); return r; }
__device__ __forceinline__ float max3_(float a, float b, float c) { float r; asm("v_max3_f32 %0, %1, %2, %3" : "=v"(r) : "v"(a), "v"(b), "v"(c)); return r; }
__device__ __forceinline__ float xrow16_max(float x) {
    auto s = __builtin_amdgcn_permlane16_swap(__float_as_uint(x), __float_as_uint(x), false, false);
    x = max2_(__uint_as_float(s[0]), __uint_as_float(s[1]));
    auto t = __builtin_amdgcn_permlane32_swap(__float_as_uint(x), __float_as_uint(x), false, false);
    return max2_(__uint_as_float(t[0]), __uint_as_float(t[1]));
}
template <int CTRL> __device__ __forceinline__ float dpp_f(float x) { return __builtin_bit_cast(float, __builtin_amdgcn_mov_dpp(__builtin_bit_cast(int, x), CTRL, 0xf, 0xf, true)); }
__device__ __forceinline__ float oct_sum(float x) { x += dpp_f<0xB1>(x); x += dpp_f<0x4E>(x); x += dpp_f<0x141>(x); return x; }
__device__ __forceinline__ float xrow16_sum(float x) {
    auto s = __builtin_amdgcn_permlane16_swap(__float_as_uint(x), __float_as_uint(x), false, false);
    x = __uint_as_float(s[0]) + __uint_as_float(s[1]);
    auto t = __builtin_amdgcn_permlane32_swap(__float_as_uint(x), __float_as_uint(x), false, false);
    return __uint_as_float(t[0]) + __uint_as_float(t[1]);
}
constexpr int P2_CPI = 4, P2_NITEMS = BATCH * NH * (NCHUNK / P2_CPI);
struct P2Item { int b, h, c0, kb0, nst; };
__device__ __forceinline__ P2Item p2_decode(int vb) {
    const int q8 = vb >> 7, v7 = vb & 127;
    const int bh = 4 * q8 + ((v7 < 120) ? v7 / 30 : (v7 - 120) & 3), cq = (v7 < 120) ? 2 + v7 % 30 : 1 - ((v7 - 120) >> 2);
    P2Item I; I.b = bh >> 4; I.h = bh & 15; I.c0 = cq * P2_CPI; I.kb0 = (I.c0 >= 8) ? I.c0 - 8 : 0; I.nst = I.c0 + 4 - I.kb0; return I;
}
__device__ __forceinline__ void p2_attention(Frame& F) {
    const int tid = F.tid, lane = F.lane, wave = F.wave, fr = lane & 15, fq = lane >> 4;
    const int grp = wave >> 2, wq = wave & 3;
    LAS unsigned char* gbase = F.lds;
    const int key0 = tid >> 3, d80 = (tid & 7) * 8, koff = tid * 8;
    const float L2E = 1.4426950408889634f;
    volatile LAS int* qslot = (volatile LAS int*)(F.lds + MISC_OFF + 64);
    const unsigned myx = xb_xcc_id() & 7u;
#define P2_POP(dst) { int got_ = P2_NITEMS; for (int t_ = 0; t_ < 8; ++t_) { const unsigned q_ = (myx + t_) & 7u; \
        const unsigned v_ = __hip_atomic_fetch_add(F.queue + 32 * q_, 1u, __ATOMIC_RELAXED, __HIP_MEMORY_SCOPE_AGENT); if (v_ < 128u) { got_ = (int)(q_ * 128u + v_); break; } } dst = got_; }
    __syncthreads();
    if (tid == 0) { int g0; P2_POP(g0) *qslot = g0; }
    __syncthreads();
    int vb = *qslot;
    if (vb >= P2_NITEMS) return;
    int tbsel = 0;
    KVRegs RA, RB; bf16x8 qa[2][2];
    { const P2Item I = p2_decode(vb); const bf16_t* kvb0 = F.PA + pah(PG_KA, I.b, I.h) + (size_t)I.kb0 * 4096; const int tok0 = (I.c0 + 2 * grp) * 64;
      kv_load(RA, kvb0, koff);
#pragma unroll
      for (int x = 0; x < 2; ++x)
#pragma unroll
          for (int ks = 0; ks < 2; ++ks) qa[x][ks] = *(const bf16x8*)(F.PA + pah(PG_Q, I.b, I.h) + (size_t)(tok0 + 64 * x + 16 * wq + fr) * 64 + ks * 32 + fq * 8);
      LAS f32x4* Tb0 = (LAS f32x4*)(gbase + P2_TB_OFF);
      for (int e = tid; e < P2_NBT * 64; e += NTHREADS) Tb0[e] = ((const f32x4*)F.BT)[(size_t)I.h * (P2_NBT * 64) + e];
      kv_store(RA, gbase, key0, d80);
      kv_load(RA, kvb0 + 4096, koff);
      __syncthreads(); }
    for (;;) {
        const P2Item I = p2_decode(vb);
        int vb_next = 0;
        if (tid == 0) P2_POP(vb_next)
        const int b = I.b, h = I.h, c0 = I.c0, kb0 = I.kb0, nst = I.nst;
        const int cg = c0 + 2 * grp;
        const bf16_t* kvbase = F.PA + pah(PG_KA, b, h);
        const size_t mrow0 = (size_t)b * SEQ + (size_t)cg * 64; const int tok0 = cg * 64;
        const LAS f32x4* Tb = (const LAS f32x4*)(gbase + P2_TB_OFF + tbsel * (P2_NBT * 1024));
        u32x2 zw[2][4];
#pragma unroll
        for (int x = 0; x < 2; ++x)
#pragma unroll
            for (int dt = 0; dt < 4; ++dt) zw[x][dt] = *(const u32x2*)(F.PA + pah(PG_ZA, b, h) + (size_t)(tok0 + 64 * x + 16 * wq + fr) * 64 + 16 * dt + 4 * fq);
        const float bcst = F.rel_bias[h * 513 + 512];
        float mrun[2] = {-1e30f, -1e30f}, lsum[2] = {0.f, 0.f}; f32x4 o[2][4];
#pragma unroll
        for (int x = 0; x < 2; ++x)
#pragma unroll
            for (int dt = 0; dt < 4; ++dt) o[x][dt] = (f32x4){0.f, 0.f, 0.f, 0.f};
        int bufc = 0, st = 0;
        int nxt = P2_NITEMS; P2Item N = I; const bf16_t* nkv = kvbase;
        bf16x8 qn[2][2];
#pragma unroll
        for (int x = 0; x < 2; ++x)
#pragma unroll
            for (int ks = 0; ks < 2; ++ks) qn[x][ks] = qa[x][ks];
#define P2_STEP(RW, RL) { \
            const bool more1 = st + 1 < nst; \
            if (st == 1) { nxt = *qslot; if (nxt < P2_NITEMS) { N = p2_decode(nxt); nkv = F.PA + pah(PG_KA, N.b, N.h) + (size_t)N.kb0 * 4096; } }     \
            { const int tb_ = st + 2; const bf16_t* lp_ = (tb_ < nst) ? kvbase + (size_t)(kb0 + tb_) * 4096 : ((nxt < P2_NITEMS) ? nkv + (size_t)(tb_ - nst) * 4096 : kvbase + (size_t)(kb0 + nst - 1) * 4096); \
              kv_load(RL, lp_, koff); }                                                \
            const LAS bf16_t* Ks = (const LAS bf16_t*)(gbase + bufc * 2 * SLOT); const LAS bf16_t* Vs = (const LAS bf16_t*)(gbase + bufc * 2 * SLOT + SLOT); \
            const int j0 = kb0 + st - (cg - 8);                                        \
            if (j0 >= 0 && j0 <= 9) {                                                  \
            f32x4 sc[2][4]; float bc[2]; bf16x8 kf[4]; \
            _Pragma("unroll") for (int nt = 0; nt < 4; ++nt) kf[nt] = *(const LAS bf16x8*)(Ks + (16 * nt + fr) * LSTR + fq * 8); \
            _Pragma("unroll") for (int x = 0; x < 2; ++x) { const int jx = j0 - x; \
                if (jx >= 4 && jx <= 8) { bc[x] = 0.f; _Pragma("unroll") for (int nt = 0; nt < 4; ++nt) { const int u = wq - nt + 4 * (8 - jx); sc[x][nt] = Tb[((u < 17 ? u : 17) + 3) * 64 + lane]; }     \
                    _Pragma("unroll") for (int nt = 0; nt < 4; ++nt) sc[x][nt] = __builtin_amdgcn_mfma_f32_16x16x32_bf16(kf[nt], qa[x][0], sc[x][nt], 0, 0, 0); } \
                else { bc[x] = (jx >= 0 && jx <= 3) ? bcst : -3e38f;                   \
                    _Pragma("unroll") for (int nt = 0; nt < 4; ++nt) sc[x][nt] = __builtin_amdgcn_mfma_f32_16x16x32_bf16(kf[nt], qa[x][0], (f32x4){0.f, 0.f, 0.f, 0.f}, 0, 0, 0); } } \
            _Pragma("unroll") for (int nt = 0; nt < 4; ++nt) { const bf16x8 kb = *(const LAS bf16x8*)(Ks + (16 * nt + fr) * LSTR + 32 + fq * 8); \
                _Pragma("unroll") for (int x = 0; x < 2; ++x) sc[x][nt] = __builtin_amdgcn_mfma_f32_16x16x32_bf16(kb, qa[x][1], sc[x][nt], 0, 0, 0); } \
            bf16x8 pb[2][2]; \
            _Pragma("unroll") for (int x = 0; x < 2; ++x) { \
                float rmax = max3_(sc[x][0][0], sc[x][0][1], sc[x][0][2]); rmax = max3_(rmax, sc[x][0][3], sc[x][1][0]); \
                rmax = max3_(rmax, sc[x][1][1], sc[x][1][2]); rmax = max3_(rmax, sc[x][1][3], sc[x][2][0]); rmax = max3_(rmax, sc[x][2][1], sc[x][2][2]); \
                rmax = max3_(rmax, sc[x][2][3], sc[x][3][0]); rmax = max3_(rmax, sc[x][3][1], sc[x][3][2]); rmax = max2_(rmax, sc[x][3][3]); \
                rmax = xrow16_max(rmax) + bc[x]; \
                const float mn = max2_(mrun[x], rmax); const float alpha = __builtin_amdgcn_exp2f((mrun[x] - mn) * L2E); mrun[x] = mn; \
                const float mnl = (mn - bc[x]) * L2E; float ps = 0.f; \
                _Pragma("unroll") for (int nt = 0; nt < 4; ++nt) _Pragma("unroll") for (int r = 0; r < 4; ++r) sc[x][nt][r] = __builtin_amdgcn_exp2f(fmaf(sc[x][nt][r], L2E, -mnl)); \
                { const f32x4 t4 = (sc[x][0] + sc[x][1]) + (sc[x][2] + sc[x][3]); ps = (t4[0] + t4[1]) + (t4[2] + t4[3]); } \
                lsum[x] = lsum[x] * alpha + ps; \
                _Pragma("unroll") for (int dt = 0; dt < 4; ++dt) o[x][dt] = o[x][dt] * alpha; \
                _Pragma("unroll") for (int ks = 0; ks < 2; ++ks) { u32x4 w; w.x = pk2(sc[x][2 * ks][0], sc[x][2 * ks][1]); w.y = pk2(sc[x][2 * ks][2], sc[x][2 * ks][3]); w.z = pk2(sc[x][2 * ks + 1][0], sc[x][2 * ks + 1][1]); w.w = pk2(sc[x][2 * ks + 1][2], sc[x][2 * ks + 1][3]); pb[x][ks] = __builtin_bit_cast(bf16x8, w); } } \
            _Pragma("unroll") for (int ks = 0; ks < 2; ++ks) _Pragma("unroll") for (int dt = 0; dt < 4; ++dt) { const s16x4 v0 = frag_tr16(Vs, 32 * ks, 16 * dt, lane), v1 = frag_tr16(Vs, 32 * ks + 16, 16 * dt, lane); \
                    const bf16x8 va = (bf16x8){v0[0], v0[1], v0[2], v0[3], v1[0], v1[1], v1[2], v1[3]}; \
                    _Pragma("unroll") for (int x = 0; x < 2; ++x) o[x][dt] = __builtin_amdgcn_mfma_f32_16x16x32_bf16(va, pb[x][ks], o[x][dt], 0, 0, 0); } \
            } \
            if (st == 0 && tid == 0) *qslot = vb_next;                                 \
            if (!more1 && nxt < P2_NITEMS) {                                           \
                const int ntok = (N.c0 + 2 * grp) * 64; \
                _Pragma("unroll") for (int x = 0; x < 2; ++x) _Pragma("unroll") for (int ks = 0; ks < 2; ++ks) qn[x][ks] = *(const bf16x8*)(F.PA + pah(PG_Q, N.b, N.h) + (size_t)(ntok + 64 * x + 16 * wq + fr) * 64 + ks * 32 + fq * 8); \
                if (N.h != h) { LAS f32x4* Tn = (LAS f32x4*)(gbase + P2_TB_OFF + (tbsel ^ 1) * (P2_NBT * 1024)); f32x4 bt[3]; \
                    _Pragma("unroll") for (int i3 = 0; i3 < 3; ++i3) { const int e = tid + 512 * i3; bt[i3] = (e < P2_NBT * 64) ? ((const f32x4*)F.BT)[(size_t)N.h * (P2_NBT * 64) + e] : (f32x4){0.f, 0.f, 0.f, 0.f}; } \
                    _Pragma("unroll") for (int i3 = 0; i3 < 3; ++i3) { const int e = tid + 512 * i3; if (e < P2_NBT * 64) Tn[e] = bt[i3]; } } } \
            const int bufn = bufc ^ 1; \
            kv_store(RW, gbase + bufn * 2 * SLOT, key0, d80);                           \
            __syncthreads(); \
            if (!more1) break; \
            ++st; bufc = bufn; }
        for (;;) {
            P2_STEP(RA, RB)
            P2_STEP(RB, RA)
        }
#undef P2_STEP
#pragma unroll
        for (int x = 0; x < 2; ++x) {
            const float inv = 1.0f / xrow16_sum(lsum[x]); const size_t m = mrow0 + 64 * x + 16 * wq + fr;
#pragma unroll
            for (int dt = 0; dt < 4; ++dt) { const int col = h * 64 + 16 * dt + 4 * fq;
                const float z0 = bflo(zw[x][dt].x), z1 = bfhi(zw[x][dt].x), z2 = bflo(zw[x][dt].y), z3 = bfhi(zw[x][dt].y);
                u32x2 yw; yw.x = pk2(o[x][dt][0] * inv * z0 * sigmoidf_(z0), o[x][dt][1] * inv * z1 * sigmoidf_(z1)); yw.y = pk2(o[x][dt][2] * inv * z2 * sigmoidf_(z2), o[x][dt][3] * inv * z3 * sigmoidf_(z3));
                *(u32x2*)(F.YCAT + ((size_t)M + m) * DBR + col) = yw; } }
        if (nxt >= P2_NITEMS) break;
        if (N.h != h) tbsel ^= 1;
        vb = nxt;
#pragma unroll
        for (int x = 0; x < 2; ++x)
#pragma unroll
            for (int ks = 0; ks < 2; ++ks) qa[x][ks] = qn[x][ks];
    }
#undef P2_POP
}

constexpr int FSTR = 68;
constexpr int DSTR = 24;
__device__ __forceinline__ f32x4 mfma16(s16x4 a, s16x4 b, f32x4 c) {
    const bf16x8 a8 = (bf16x8){a[0], a[1], a[2], a[3], 0, 0, 0, 0}, b8 = (bf16x8){b[0], b[1], b[2], b[3], 0, 0, 0, 0};
    return __builtin_amdgcn_mfma_f32_16x16x32_bf16(a8, b8, c, 0, 0, 0); }
__device__ __forceinline__ f32x4 mfma32p(s16x4 a0, s16x4 a1, s16x4 b0, s16x4 b1, f32x4 c) {
    const bf16x8 a8 = (bf16x8){a0[0], a0[1], a0[2], a0[3], a1[0], a1[1], a1[2], a1[3]}, b8 = (bf16x8){b0[0], b0[1], b0[2], b0[3], b1[0], b1[1], b1[2], b1[3]};
    return __builtin_amdgcn_mfma_f32_16x16x32_bf16(a8, b8, c, 0, 0, 0); }
__device__ __forceinline__ s16x4 cvt_hi(const f32x4 v) { u32x2 w; w.x = pk2(v[0], v[1]); w.y = pk2(v[2], v[3]); return __builtin_bit_cast(s16x4, w); }
__device__ __forceinline__ s16x4 cvt_lo(const f32x4 v, const s16x4 hi) { const u32x2 h = __builtin_bit_cast(u32x2, hi);
    u32x2 w; w.x = pk2(v[0] - bflo(h.x), v[1] - bfhi(h.x)); w.y = pk2(v[2] - bflo(h.y), v[3] - bfhi(h.y)); return __builtin_bit_cast(s16x4, w); }
struct P3Loads { bf16x8 bw[2]; float b0v; u32x4 pr, pk, pv, qr, qk, qv; f32x4 par; };
struct P3Off { unsigned w, b0, row; };
__device__ __forceinline__ void p3_load(Frame& F, P3Loads& G, int h, int b, int c, const P3Off& o) {
    { const char* wb = (const char*)(((F.wave < 4) ? F.W2T : F.A2T) + (size_t)h * 4096);
      G.bw[0] = *(const bf16x8*)(wb + o.w); G.bw[1] = *(const bf16x8*)(wb + o.w + 64);
      G.b0v = *(const float*)((const char*)(((F.wave < 4) ? F.w0 : F.a0) + h * 64) + o.b0); }
    constexpr size_t GSB = (size_t)2 * 16 * 8192 * 64 * 2;
    const char* rb = (const char*)(F.PA + pah(PG_R, b, h) + (size_t)c * 4096);
    G.pr = *(const u32x4*)(rb + o.row); G.pk = *(const u32x4*)(rb + GSB + o.row); G.pv = *(const u32x4*)(rb + 2 * GSB + o.row);
    G.qr = *(const u32x4*)(rb - 128 + o.row); G.qk = *(const u32x4*)(rb - 128 + GSB + o.row); G.qv = *(const u32x4*)(rb - 128 + 2 * GSB + o.row);
    { const int tp = (F.tid < 96) ? F.tid : 0, a = tp >> 4, ch = h * 64 + 4 * (tp & 15);
      const float* src = (a < 3) ? F.mu_rkv + a * DBR + ch : ((a == 3) ? F.k_k + ch : ((a == 4) ? F.k_a + ch : F.r_k + ch));
      G.par = *(const f32x4*)src; }
}
__device__ __forceinline__ void p3_prep(Frame& F) {
    const int wave = F.wave;
    LAS unsigned char* L = F.lds;
    LAS bf16_t* X_A = (LAS bf16_t*)(L + 0 * SLOT);
    LAS bf16_t* X_B = (LAS bf16_t*)(L + 1 * SLOT);
    LAS bf16_t* X_K = (LAS bf16_t*)(L + 2 * SLOT);
    LAS bf16_t* X_R = (LAS bf16_t*)(L + 3 * SLOT);
    LAS bf16_t* X_V = (LAS bf16_t*)(L + 4 * SLOT);
    LAS bf16_t* S_TW = (LAS bf16_t*)(L + 5 * SLOT);
    LAS bf16_t* S_TA = (LAS bf16_t*)(L + 6 * SLOT);
    LAS bf16_t* A_AB = (LAS bf16_t*)(L + 7 * SLOT);
    LAS bf16_t* A_AK = (LAS bf16_t*)(L + 8 * SLOT);
    LAS bf16_t* A_RB = (LAS bf16_t*)(L + 9 * SLOT);
    LAS bf16_t* A_RK = (LAS bf16_t*)(L + 10 * SLOT);
    LAS bf16_t* DB = (LAS bf16_t*)(L + 11 * SLOT);
    LAS float* CLf = (LAS float*)(L + 12 * SLOT);
    LAS float* Af = CLf + 64 * FSTR;
    LAS float* GL = Af + 64 * FSTR;
    LAS float* PARB = GL + 64;
    LAS bf16_t* ST_Q = A_AK; LAS bf16_t* ST_Y = X_A; LAS bf16_t* ST_M = X_V; LAS bf16_t* ST_N = X_R;
    const int mt = wave >> 1, ntb = (wave & 1) * 2;
    for (int vb = F.bid; vb < 256; vb += F.G) {
        const int b = vb >> 7, c = vb & 127; const size_t mrow0 = (size_t)b * SEQ + (size_t)c * 64;
        {
            const int t_e = F.tid >> 3, c8 = (F.tid & 7) * 8; const size_t m = mrow0 + t_e; const bool hasprev = (c > 0) || (t_e > 0);
            const u32x4 zero4 = (u32x4){0u, 0u, 0u, 0u};
            float sw[8], sa[8];
#pragma unroll
            for (int e = 0; e < 8; ++e) { sw[e] = 0.f; sa[e] = 0.f; }
#pragma unroll
            for (int q = 0; q < 4; ++q) { const bf16_t* slab = F.PL + (size_t)q * ((size_t)M * NPL);
                const u32x4 g_law = *(const u32x4*)(slab + m * NPL + 0 + c8), g_laa = *(const u32x4*)(slab + m * NPL + 128 + c8);
                const u32x4 g_lbw = hasprev ? *(const u32x4*)(slab + (m - 1) * NPL + 64 + c8) : zero4, g_lba = hasprev ? *(const u32x4*)(slab + (m - 1) * NPL + 192 + c8) : zero4;
                float law[8], laa[8], lbw[8], lba[8];
                unpack8(g_law, law); unpack8(g_laa, laa); unpack8(g_lbw, lbw); unpack8(g_lba, lba);
#pragma unroll
                for (int e = 0; e < 8; ++e) { sw[e] += law[e] + lbw[e]; sa[e] += laa[e] + lba[e]; } }
            float tw[8], ta[8];
#pragma unroll
            for (int e = 0; e < 8; ++e) { tw[e] = tanhf_(sw[e]); ta[e] = sa[e]; }
            __syncthreads();
            *(LAS u32x4*)(S_TW + t_e * LSTR + c8) = pack8(tw); *(LAS u32x4*)(S_TA + t_e * LSTR + c8) = pack8(ta);
        }
        P3Off poff; { const int l_ = F.lane, ch_ = 16 * (wave & 3) + (l_ & 15); poff.w = (unsigned)(ch_ * 64 + (l_ >> 4) * 8) * 2u; poff.b0 = (unsigned)ch_ * 4u; poff.row = (unsigned)((F.tid >> 3) * 64 + (F.tid & 7) * 8) * 2u; }
        P3Loads G; p3_load(F, G, 0, b, c, poff);
        __syncthreads();
        for (int h = 0; h < NH; ++h) {
            int tid = F.tid; asm volatile("" : "+v"(tid));
            const int lane = tid & 63, fr = lane & 15, fq = lane >> 4;
            const int t_e = tid >> 3, c8 = (tid & 7) * 8;
            const size_t m = mrow0 + t_e; const bool hasprev = (c > 0) || (t_e > 0);
            const u32x4 g_pr = G.pr, g_pk = G.pk, g_pv = G.pv, g_qr = G.qr, g_qk = G.qk, g_qv = G.qv; const bf16x8 g_bw0 = G.bw[0], g_bw1 = G.bw[1]; const float g_b0v = G.b0v;
            LAS float* parh = PARB + (h & 1) * 384;
            if (tid < 96) *(LAS f32x4*)(parh + 4 * tid) = G.par;
            {
                const int ctile = wave & 3, ch = 16 * ctile + fr; const bool isw = wave < 4;
                const LAS bf16_t* Asrc = isw ? S_TW : S_TA;
                const bf16x8 bw[2] = {g_bw0, g_bw1};
                f32x4 d[4];
#pragma unroll
                for (int mt4 = 0; mt4 < 4; ++mt4) d[mt4] = (f32x4){0.f, 0.f, 0.f, 0.f};
#pragma unroll
                for (int ks = 0; ks < 2; ++ks)
#pragma unroll
                    for (int mt4 = 0; mt4 < 4; ++mt4) d[mt4] = __builtin_amdgcn_mfma_f32_16x16x32_bf16(*(const LAS bf16x8*)(Asrc + (16 * mt4 + fr) * LSTR + ks * 32 + fq * 8), bw[ks], d[mt4], 0, 0, 0);
                const float b0v = g_b0v;
                if (isw) {
                    float base = 0.f;
#pragma unroll
                    for (int mt4 = 0; mt4 < 4; ++mt4) {
                        f32x4 p;
#pragma unroll
                        for (int r = 0; r < 4; ++r) p[r] = -DECAY_SCALE * sigmoidf_(b0v + d[mt4][r]);
                        p[1] += p[0]; p[2] += p[1]; p[3] += p[2];
                        const float T = p[3];
                        const auto s16 = __builtin_amdgcn_permlane16_swap(__float_as_uint(T), __float_as_uint(T), false, false);
                        const float nb = (fq & 1) ? __uint_as_float(s16[0]) : __uint_as_float(s16[1]);
                        const float pr2 = T + nb;
                        const auto s32 = __builtin_amdgcn_permlane32_swap(__float_as_uint(pr2), __float_as_uint(pr2), false, false);
                        const float op = (fq & 2) ? __uint_as_float(s32[0]) : __uint_as_float(s32[1]);
                        const float pf = ((fq & 1) ? nb : 0.f) + ((fq & 2) ? op : 0.f);
                        const float S = pr2 + op;
#pragma unroll
                        for (int r = 0; r < 4; ++r) CLf[(16 * mt4 + 4 * fq + r) * FSTR + ch] = __expf(base + pf + p[r]);
                        base += S;
                    }
                } else {
#pragma unroll
                    for (int mt4 = 0; mt4 < 4; ++mt4)
#pragma unroll
                        for (int r = 0; r < 4; ++r) Af[(16 * mt4 + 4 * fq + r) * FSTR + ch] = sigmoidf_(b0v + d[mt4][r]);
                }
            }
            __syncthreads();
            {
                float pr[8], pk[8], pv[8], qr[8], qk[8], qv[8];
                unpack8(g_pr, pr); unpack8(g_pk, pk); unpack8(g_pv, pv); unpack8(g_qr, qr); unpack8(g_qk, qk); unpack8(g_qv, qv);
                if (!hasprev) {
#pragma unroll
                    for (int e = 0; e < 8; ++e) { qr[e] = 0.f; qk[e] = 0.f; qv[e] = 0.f; } }
                float mur[8], muk[8], muv[8], kkp[8], kap[8], rkp[8];
#pragma unroll
                for (int q = 0; q < 2; ++q) { const f32x4 p0 = *(const LAS f32x4*)(parh + c8 + 4 * q), p1 = *(const LAS f32x4*)(parh + 64 + c8 + 4 * q), p2 = *(const LAS f32x4*)(parh + 128 + c8 + 4 * q),
                                                            p3 = *(const LAS f32x4*)(parh + 192 + c8 + 4 * q), p4 = *(const LAS f32x4*)(parh + 256 + c8 + 4 * q), p5 = *(const LAS f32x4*)(parh + 320 + c8 + 4 * q);
#pragma unroll
                    for (int r = 0; r < 4; ++r) { mur[4 * q + r] = p0[r]; muk[4 * q + r] = p1[r]; muv[4 * q + r] = p2[r]; kkp[4 * q + r] = p3[r]; kap[4 * q + r] = p4[r]; rkp[4 * q + r] = p5[r]; } }
                float rr[8], kk[8], vv[8], kn[8], av[8], cl[8], clp[8]; float nrm = 0.f;
#pragma unroll
                for (int e = 0; e < 8; ++e) {
                    rr[e] = pr[e] + (qr[e] - pr[e]) * mur[e]; kk[e] = pk[e] + (qk[e] - pk[e]) * muk[e]; vv[e] = pv[e] + (qv[e] - pv[e]) * muv[e];
                    kn[e] = kk[e] * kkp[e]; nrm += kn[e] * kn[e];
                }
                { const int tp = (t_e > 0) ? t_e - 1 : 0;
#pragma unroll
                  for (int q = 0; q < 2; ++q) { const f32x4 a4 = *(const LAS f32x4*)(Af + t_e * FSTR + c8 + 4 * q), g4 = *(const LAS f32x4*)(CLf + t_e * FSTR + c8 + 4 * q), p4 = *(const LAS f32x4*)(CLf + tp * FSTR + c8 + 4 * q);
#pragma unroll
                      for (int r = 0; r < 4; ++r) { av[4 * q + r] = a4[r]; cl[4 * q + r] = g4[r]; clp[4 * q + r] = (t_e > 0) ? p4[r] : 1.0f; } } }
                nrm = oct_sum(nrm);
                const float inrm = 1.0f / fmaxf(sqrtf(nrm), 1e-12f);
                float at_[8], bt_[8], kt_[8], rt_[8]; float bon = 0.f;
#pragma unroll
                for (int e = 0; e < 8; ++e) {
                    const float kkn = kn[e] * inrm; const float kmod = kk[e] * (1.0f + (av[e] - 1.0f) * kap[e]);
                    const float gin = cl[e], gex = clp[e], ginv = __builtin_amdgcn_rcpf(cl[e]);
                    at_[e] = -kkn * gex; bt_[e] = kkn * av[e] * ginv; kt_[e] = kmod * ginv; rt_[e] = rr[e] * gin;
                    bon += rr[e] * kmod * rkp[e]; }
                bon = oct_sum(bon);
                if ((tid & 7) == 0) F.BONUS[m * NH + h] = bon;
                if (t_e == 63) {
#pragma unroll
                    for (int e = 0; e < 8; ++e) GL[c8 + e] = cl[e]; }
                *(LAS u32x4*)(X_A + t_e * LSTR + c8) = pack8(at_); *(LAS u32x4*)(X_B + t_e * LSTR + c8) = pack8(bt_);
                *(LAS u32x4*)(X_K + t_e * LSTR + c8) = pack8(kt_); *(LAS u32x4*)(X_R + t_e * LSTR + c8) = pack8(rt_);
                *(LAS u32x4*)(X_V + t_e * LSTR + c8) = pack8(vv);
            }
            __syncthreads();
            p3_load(F, G, (h + 1 < NH) ? h + 1 : h, b, c, poff);
#pragma unroll
            for (int q = 0; q < 2; ++q) { const int it = mt, tt = ntb + q; const int t = 16 * tt + fr, i0 = 16 * it + 4 * fq;
                const f32x4 z4 = (f32x4){0.f, 0.f, 0.f, 0.f};
                const f32x4 d_ab = mm16(X_B, 16 * it, X_A, 16 * tt, z4, fr, fq), d_ak = mm16(X_K, 16 * it, X_A, 16 * tt, z4, fr, fq);
                const f32x4 d_rb = mm16(X_B, 16 * it, X_R, 16 * tt, z4, fr, fq), d_rk = mm16(X_K, 16 * it, X_R, 16 * tt, z4, fr, fq);
                f32x4 e_ab, e_ak, e_rb, e_rk;
#pragma unroll
                for (int r = 0; r < 4; ++r) { const int i = i0 + r; e_ab[r] = (i < t) ? d_ab[r] : 0.f; e_ak[r] = (i < t) ? d_ak[r] : 0.f; e_rb[r] = (i <= t) ? d_rb[r] : 0.f; e_rk[r] = (i <= t) ? d_rk[r] : 0.f; }
                *(LAS s16x4*)(A_AB + t * LSTR + i0) = cvt_hi(e_ab); *(LAS s16x4*)(A_AK + t * LSTR + i0) = cvt_hi(e_ak);
                *(LAS s16x4*)(A_RB + t * LSTR + i0) = cvt_hi(e_rb); *(LAS s16x4*)(A_RK + t * LSTR + i0) = cvt_hi(e_rk); }
            __syncthreads();
            f32x4 rhs[4]; bf16x8 vf[2]; u32x2 rq[4];
            const int ct = wave & 3;
#pragma unroll
            for (int bi = 0; bi < 4; ++bi) rq[bi] = (u32x2){0u, 0u};
            if (wave < 4) {
#pragma unroll
                for (int bi = 0; bi < 4; ++bi) rq[bi] = *(const LAS u32x2*)(X_R + (16 * bi + fr) * LSTR + 16 * ct + 4 * fq);
                const s16x4 a_t = *(const LAS s16x4*)(A_AB + (16 * wave + fr) * LSTR + 16 * wave + 4 * fq);
                const s16x4 a_c = frag_tr16(A_AB, 16 * wave, 16 * wave, lane);
                const f32x4 z4 = (f32x4){0.f, 0.f, 0.f, 0.f};
                f32x4 iden;
#pragma unroll
                for (int r = 0; r < 4; ++r) iden[r] = (4 * fq + r == fr) ? 1.0f : 0.0f;
                const u32x2 atw = __builtin_bit_cast(u32x2, a_t), acw = __builtin_bit_cast(u32x2, a_c);
                f32x4 Sc = iden + (f32x4){bflo(acw.x), bfhi(acw.x), bflo(acw.y), bfhi(acw.y)}, St = iden + (f32x4){bflo(atw.x), bfhi(atw.x), bflo(atw.y), bfhi(atw.y)};
                f32x4 Pc = mfma16(a_t, a_c, z4), Pt = mfma16(a_c, a_t, z4);
#pragma unroll
                for (int lvl = 0; lvl < 3; ++lvl) {
                    const s16x4 pt = cvt_hi(Pt), pc = cvt_hi(Pc);
                    const s16x4 sh = cvt_hi(Sc), sl = cvt_lo(Sc, sh);
                    const f32x4 Sc2 = mfma32p(pt, pt, sh, sl, Sc), St2 = mfma32p(sh, sl, pt, pt, St);
                    Sc = Sc2; St = St2;
                    if (lvl < 2) { const f32x4 Pc2 = mfma16(pt, pc, z4), Pt2 = mfma16(pc, pt, z4); Pc = Pc2; Pt = Pt2; }
                }
                *(LAS s16x4*)(DB + (16 * wave + fr) * DSTR + 4 * fq) = cvt_hi(St);
#pragma unroll
                for (int bi = 0; bi < 4; ++bi) { const u32x2 w = __builtin_bit_cast(u32x2, frag_tr16(X_A, 16 * bi, 16 * ct, lane));
                    rhs[bi] = (f32x4){bflo(w.x), bfhi(w.x), bflo(w.y), bfhi(w.y)}; }
                vf[0] = (bf16x8){0, 0, 0, 0, 0, 0, 0, 0}; vf[1] = vf[0];
            } else {
#pragma unroll
                for (int ks = 0; ks < 2; ++ks) vf[ks] = frag_tr32(X_V, ks * 32, 16 * ct, lane);
#pragma unroll
                for (int bi = 0; bi < 4; ++bi) rhs[bi] = (f32x4){0.f, 0.f, 0.f, 0.f};
#pragma unroll
                for (int ks = 0; ks < 2; ++ks)
#pragma unroll
                    for (int bi = 0; bi < 4; ++bi) rhs[bi] = __builtin_amdgcn_mfma_f32_16x16x32_bf16(*(const LAS bf16x8*)(A_AK + (16 * bi + fr) * LSTR + ks * 32 + fq * 8), vf[ks], rhs[bi], 0, 0, 0);
            }
            __syncthreads();
            s16x4 xb[4];
#pragma unroll
            for (int bi = 0; bi < 4; ++bi) {
                f32x4 acc = rhs[bi];
                const LAS bf16_t* arow = A_AB + (16 * bi + fr) * LSTR + 4 * fq;
                if (bi >= 2) acc = mfma32p(*(const LAS s16x4*)arow, *(const LAS s16x4*)(arow + 16), xb[0], xb[1], acc);
                if (bi == 1) acc = mfma16(*(const LAS s16x4*)arow, xb[0], acc);
                if (bi == 3) acc = mfma16(*(const LAS s16x4*)(arow + 32), xb[2], acc);
                const s16x4 hi = cvt_hi(acc), lo = cvt_lo(acc, hi); const s16x4 df = *(const LAS s16x4*)(DB + (16 * bi + fr) * DSTR + 4 * fq);
                const f32x4 x = mfma32p(df, df, hi, lo, (f32x4){0.f, 0.f, 0.f, 0.f});
                xb[bi] = cvt_hi(x);
            }
            const int col = 16 * ct + fr; const int c4 = 16 * ct + 4 * fq;
            {
                f32x4 acc[4];
#pragma unroll
                for (int bi = 0; bi < 4; ++bi) acc[bi] = (f32x4){bflo(rq[bi].x), bfhi(rq[bi].x), bflo(rq[bi].y), bfhi(rq[bi].y)};
                if (wave >= 4) {
#pragma unroll
                    for (int ks = 0; ks < 2; ++ks)
#pragma unroll
                        for (int bi = 0; bi < 4; ++bi) acc[bi] = __builtin_amdgcn_mfma_f32_16x16x32_bf16(vf[ks], *(const LAS bf16x8*)(A_RK + (16 * bi + fr) * LSTR + ks * 32 + fq * 8), acc[bi], 0, 0, 0);
                }
#pragma unroll
                for (int kp = 0; kp < 2; ++kp)
#pragma unroll
                    for (int bi = 0; bi < 4; ++bi) if (2 * kp <= bi) { const LAS bf16_t* ar = A_RB + (16 * bi + fr) * LSTR + 32 * kp + 4 * fq;
                        acc[bi] = mfma32p(xb[2 * kp], xb[2 * kp + 1], *(const LAS s16x4*)ar, *(const LAS s16x4*)(ar + 16), acc[bi]); }
#pragma unroll
                for (int bi = 0; bi < 4; ++bi) { const int t = 16 * bi + fr; const s16x4 o4 = cvt_hi(acc[bi]);
                    if (wave < 4) *(LAS s16x4*)(ST_Q + t * LSTR + c4) = o4; else *(LAS s16x4*)(ST_Y + t * LSTR + c4) = o4; }
            }
            {
                f32x4 acc[4];
#pragma unroll
                for (int mk = 0; mk < 4; ++mk) acc[mk] = (f32x4){0.f, 0.f, 0.f, 0.f};
                if (wave < 4) {
#pragma unroll
                    for (int kp = 0; kp < 2; ++kp)
#pragma unroll
                        for (int mk = 0; mk < 4; ++mk) acc[mk] = mfma32p(xb[2 * kp], xb[2 * kp + 1], frag_tr16(X_B, 32 * kp, 16 * mk, lane), frag_tr16(X_B, 32 * kp + 16, 16 * mk, lane), acc[mk]);
#pragma unroll
                    for (int mk = 0; mk < 4; ++mk) { const int k = 16 * mk + fr; const float gl = GL[k]; f32x4 v = acc[mk];
#pragma unroll
                        for (int r = 0; r < 4; ++r) v[r] = gl * (v[r] + ((k == c4 + r) ? 1.0f : 0.0f));
                        *(LAS s16x4*)(ST_M + k * LSTR + 32 * (ct >> 1) + 8 * fq + 4 * (ct & 1)) = cvt_hi(v); }
                } else {
#pragma unroll
                    for (int ks = 0; ks < 2; ++ks)
#pragma unroll
                        for (int mk = 0; mk < 4; ++mk) acc[mk] = __builtin_amdgcn_mfma_f32_16x16x32_bf16(frag_tr32(X_K, ks * 32, 16 * mk, lane), vf[ks], acc[mk], 0, 0, 0);
#pragma unroll
                    for (int kp = 0; kp < 2; ++kp)
#pragma unroll
                        for (int mk = 0; mk < 4; ++mk) acc[mk] = mfma32p(frag_tr16(X_B, 32 * kp, 16 * mk, lane), frag_tr16(X_B, 32 * kp + 16, 16 * mk, lane), xb[2 * kp], xb[2 * kp + 1], acc[mk]);
#pragma unroll
                    for (int mk = 0; mk < 4; ++mk) { const f32x4 gl4 = *(const LAS f32x4*)(GL + 16 * mk + 4 * fq);
                        *(LAS s16x4*)(ST_N + col * LSTR + 16 * mk + 4 * fq) = cvt_hi(acc[mk] * gl4); }
                }
            }
            __syncthreads();
            { const size_t mr = mrow0 + t_e;
              const size_t ub = (size_t)((b * NH + h) * NCHUNK + c) * 4096 + t_e * 64 + c8;
              *(u32x4*)(F.QD + ub) = *(const LAS u32x4*)(ST_Q + t_e * LSTR + c8);
              *(u32x4*)(F.YCAT + mr * DBR + h * 64 + c8) = *(const LAS u32x4*)(ST_Y + t_e * LSTR + c8);
              *(u32x4*)(F.MD + ub) = *(const LAS u32x4*)(ST_M + t_e * LSTR + c8);
              *(u32x4*)(F.ND + ub) = *(const LAS u32x4*)(ST_N + t_e * LSTR + c8); }
        }
    }
}

constexpr int SC_STEP_BYTES = 8192 + 8192, SC_NSLOT = 8, SC_AHEAD = SC_NSLOT - 1;
constexpr int SC_SO_OFF = SC_NSLOT * SC_STEP_BYTES, SC_SO_STEP = 64 * LSTR * 2;
__device__ __forceinline__ void scan_dma(Frame& F, int lw, int lane, int c, LAS unsigned char* slot, size_t row0) {
    const int r8 = lane >> 3, cg = ((lane & 7) ^ r8) * 8;
#pragma unroll
    for (int q = 0; q < 8; ++q) { const int j = lw + 2 * q;
        const bf16_t* g = ((q < 4) ? F.MD : F.ND) + row0 + (size_t)c * 4096 + (8 * (j & 7) + r8) * 64 + cg;
        __builtin_amdgcn_global_load_lds((const unsigned*)g, (LAS unsigned*)(slot + j * 1024), 16, 0, 0); }
}
__device__ __forceinline__ void scan_flush(int L2, int c, const LAS unsigned char* so, bf16_t* sp0) {
#pragma unroll
    for (int q = 0; q < 4; ++q) { const int idx = L2 + 128 * q, rr = idx >> 3, ch = idx & 7;
        *(u32x4*)(sp0 + (size_t)c * 4096 + rr * 64 + ch * 8) = *(const LAS u32x4*)(so + rr * (LSTR * 2) + ch * 16); }
}
__device__ __forceinline__ void p4_scan(Frame& F) {
    const int lane = F.lane, wave = F.wave, fr = lane & 15, fq = lane >> 4;
    for (int vb = F.bid; vb < BATCH * NH; vb += F.G) {
        const size_t row0 = (size_t)(vb * NCHUNK) * 4096;
        bf16_t* sp0 = F.STATES + row0;
        __syncthreads();
        if (wave == 4 || wave == 5) {
#pragma unroll
            for (int p = 0; p < SC_AHEAD; ++p) scan_dma(F, wave - 4, lane, p, F.lds + p * SC_STEP_BYTES, row0);
        }
        asm volatile("s_waitcnt vmcnt(48)\n\ts_barrier" ::: "memory");
        f32x4 st[4];
#pragma unroll
        for (int i = 0; i < 4; ++i) st[i] = (f32x4){0.f, 0.f, 0.f, 0.f};
        int cur = 0, cur2 = 0;
        for (int it = 0; it < NCHUNK; ++it) {
            if (wave >= 6) {
                if (it >= 1) scan_flush((wave - 6) * 64 + lane, it - 1, F.lds + SC_SO_OFF + (cur2 ^ 1) * SC_SO_STEP, sp0);
            } else if (wave >= 4) {
                if (it + SC_AHEAD < NCHUNK) { scan_dma(F, wave - 4, lane, it + SC_AHEAD, F.lds + ((cur + SC_AHEAD) & 7) * SC_STEP_BYTES, row0);
                    asm volatile("s_waitcnt vmcnt(48)" ::: "memory"); }
                else asm volatile("s_waitcnt vmcnt(0)" ::: "memory");
            } else {
                const LAS unsigned char* slot = F.lds + cur * SC_STEP_BYTES; LAS unsigned char* so = F.lds + SC_SO_OFF + cur2 * SC_SO_STEP;
                u32x2 pk[4];
#pragma unroll
                for (int i = 0; i < 4; ++i) { pk[i].x = pk2(st[i][0], st[i][1]); pk[i].y = pk2(st[i][2], st[i][3]); *(LAS u32x2*)(so + (16 * wave + fr) * (LSTR * 2) + (16 * i + 4 * fq) * 2) = pk[i]; }
                bf16x8 bfr[2];
#pragma unroll
                for (int ks = 0; ks < 2; ++ks) { u32x4 w; w.x = pk[2 * ks].x; w.y = pk[2 * ks].y; w.z = pk[2 * ks + 1].x; w.w = pk[2 * ks + 1].y; bfr[ks] = __builtin_bit_cast(bf16x8, w); }
                f32x4 nw[4];
#pragma unroll
                for (int i = 0; i < 4; ++i) {
                    const u32x2 nn = *(const LAS u32x2*)(slot + 8192 + (16 * wave + fr) * 128 + (((2 * i + (fq >> 1)) ^ (fr & 7)) * 16) + (fq & 1) * 8);
                    nw[i] = (f32x4){bflo(nn.x), bfhi(nn.x), bflo(nn.y), bfhi(nn.y)}; }
#pragma unroll
                for (int ks = 0; ks < 2; ++ks)
#pragma unroll
                    for (int i = 0; i < 4; ++i) { const u32x4 mf = *(const LAS u32x4*)(slot + (16 * i + fr) * 128 + (((4 * ks + fq) ^ (fr & 7)) * 16));
                        nw[i] = __builtin_amdgcn_mfma_f32_16x16x32_bf16(__builtin_bit_cast(bf16x8, mf), bfr[ks], nw[i], 0, 0, 0); }
#pragma unroll
                for (int i = 0; i < 4; ++i) st[i] = nw[i];
            }
            asm volatile("s_waitcnt lgkmcnt(0)\n\ts_barrier" ::: "memory");
            cur = (cur + 1) & 7; cur2 ^= 1;
        }
        if (wave >= 6) scan_flush((wave - 6) * 64 + lane, NCHUNK - 1, F.lds + SC_SO_OFF + (cur2 ^ 1) * SC_SO_STEP, sp0);
    }
}

struct P5LoadsA { bf16x8 qa[2], sb[4][2]; u32x4 yl[2]; };
struct P5LoadsB { u32x4 pv[2], qv[2], zw[2]; f32x4 mu4[4], g4[4], b4[4]; float bon; };
__device__ __forceinline__ f32x4 p5_quad(const u32x4 (&w)[2], int nt) { const u32x4 v = w[nt >> 1]; const unsigned a = (nt & 1) ? v.z : v.x, b = (nt & 1) ? v.w : v.y; return (f32x4){bflo(a), bfhi(a), bflo(b), bfhi(b)}; }
__device__ __forceinline__ void p5_load_a(Frame& F, P5LoadsA& G, int u, int wq, int fr, int fq) {
    const int c = u & 127, h = (u >> 7) & 15, b = u >> 11; const size_t m = (size_t)b * SEQ + (size_t)c * 64 + 16 * wq + fr;
    const bf16_t* sp = F.STATES + (size_t)u * 4096;
#pragma unroll
    for (int ks = 0; ks < 2; ++ks) G.qa[ks] = *(const bf16x8*)(F.QD + (size_t)u * 4096 + (16 * wq + fr) * 64 + ks * 32 + fq * 8);
#pragma unroll
    for (int nt = 0; nt < 4; ++nt)
#pragma unroll
        for (int ks = 0; ks < 2; ++ks) G.sb[nt][ks] = *(const bf16x8*)(sp + (16 * (fr >> 2) + 4 * nt + (fr & 3)) * 64 + ks * 32 + fq * 8);
#pragma unroll
    for (int q = 0; q < 2; ++q) G.yl[q] = *(const u32x4*)(F.YCAT + m * DBR + h * 64 + 16 * fq + 8 * q);
}
__device__ __forceinline__ void p5_load_b(Frame& F, P5LoadsB& G, int u, int wq, int fr, int fq) {
    const int c = u & 127, h = (u >> 7) & 15, b = u >> 11; const int t = 16 * wq + fr; const size_t m = (size_t)b * SEQ + (size_t)c * 64 + t; const bool hasprev = (c > 0) || (t > 0);
    const int ch0 = h * 64 + 16 * fq;
#pragma unroll
    for (int q = 0; q < 2; ++q) {
        const bf16_t* vp = F.PA + pah(PG_V, b, h) + (size_t)(c * 64 + t) * 64 + 16 * fq + 8 * q;
        G.pv[q] = *(const u32x4*)vp; G.qv[q] = hasprev ? *(const u32x4*)(vp - 64) : (u32x4){0u, 0u, 0u, 0u};
        G.zw[q] = *(const u32x4*)(vp + (size_t)2 * 16 * 8192 * 64); }
#pragma unroll
    for (int nt = 0; nt < 4; ++nt) { const int ch = ch0 + 4 * nt; G.mu4[nt] = *(const f32x4*)(F.mu_rkv + 2 * DBR + ch); G.g4[nt] = *(const f32x4*)(F.lnx_g + ch); G.b4[nt] = *(const f32x4*)(F.lnx_b + ch); }
    G.bon = F.BONUS[m * NH + h];
}
__device__ __forceinline__ void p5_out(Frame& F) {
    const int lane = F.lane, wave = F.wave, fr = lane & 15, fq = lane >> 4, grp = wave >> 2, wq = wave & 3;
    constexpr int NU = BATCH * NH * NCHUNK;
    int u = F.bid * 2 + grp; const int ustep = F.G * 2;
    if (u >= NU) return;
    P5LoadsA GA; p5_load_a(F, GA, u, wq, fr, fq);
    for (; u < NU; u += ustep) {
        const int c = u & 127, h = (u >> 7) & 15, b = u >> 11; const size_t m = (size_t)b * SEQ + (size_t)c * 64 + 16 * wq + fr;
        P5LoadsB GB; p5_load_b(F, GB, u, wq, fr, fq);
        f32x4 y[4];
#pragma unroll
        for (int nt = 0; nt < 4; ++nt) y[nt] = p5_quad(GA.yl, nt);
#pragma unroll
        for (int ks = 0; ks < 2; ++ks)
#pragma unroll
            for (int nt = 0; nt < 4; ++nt) y[nt] = __builtin_amdgcn_mfma_f32_16x16x32_bf16(GA.sb[nt][ks], GA.qa[ks], y[nt], 0, 0, 0);
        if (u + ustep < NU) p5_load_a(F, GA, u + ustep, wq, fr, fq);
        float s = 0.f;
#pragma unroll
        for (int nt = 0; nt < 4; ++nt) s += (y[nt][0] + y[nt][1]) + (y[nt][2] + y[nt][3]);
        const float mean = xrow16_sum(s) * (1.0f / 64.0f);
        float q = 0.f;
#pragma unroll
        for (int nt = 0; nt < 4; ++nt)
#pragma unroll
            for (int r = 0; r < 4; ++r) { const float d = y[nt][r] - mean; q += d * d; }
        const float rstd = 1.0f / sqrtf(xrow16_sum(q) * (1.0f / 64.0f) + GN_EPS);
#pragma unroll
        for (int q2 = 0; q2 < 2; ++q2) { u32x4 ow;
#pragma unroll
            for (int n2 = 0; n2 < 2; ++n2) { const int nt = 2 * q2 + n2;
                const f32x4 pv = p5_quad(GB.pv, nt), qv = p5_quad(GB.qv, nt), z = p5_quad(GB.zw, nt);
                const f32x4 vv = pv + (qv - pv) * GB.mu4[nt];
                f32x4 o4;
#pragma unroll
                for (int r = 0; r < 4; ++r) o4[r] = ((y[nt][r] - mean) * rstd * GB.g4[nt][r] + GB.b4[nt][r] + GB.bon * vv[r]) * (z[r] * sigmoidf_(z[r]));
                if (n2) { ow.z = pk2(o4[0], o4[1]); ow.w = pk2(o4[2], o4[3]); } else { ow.x = pk2(o4[0], o4[1]); ow.y = pk2(o4[2], o4[3]); } }
            *(u32x4*)(F.YCAT + m * DBR + h * 64 + 16 * fq + 8 * q2) = ow; }
    }
}

__device__ __forceinline__ void p8_final(Frame& F) {
    const int gw = F.bid * NWAVES + F.wave, NGW = F.G * NWAVES;
    f32x4 gq[8];
#pragma unroll
    for (int k = 0; k < 8; ++k) gq[k] = ((const f32x4*)F.post_g + F.lane)[64 * k];
    for (int m0 = gw; m0 < M; m0 += 4 * NGW) {
#pragma unroll
        for (int q = 0; q < 4; ++q) { const int m = (m0 + q * NGW < M) ? m0 + q * NGW : m0;
            const f32x4* xr = (const f32x4*)(F.x + (size_t)m * DM) + F.lane;
            const u32x2* orow = (const u32x2*)(F.OBF + (size_t)m * DM) + F.lane;
            f32x4* outr = (f32x4*)(F.out + (size_t)m * DM) + F.lane;
            u32x2 ow[8]; f32x4 xv[8];
#pragma unroll
            for (int k = 0; k < 8; ++k) { ow[k] = __builtin_nontemporal_load(orow + 64 * k); xv[k] = __builtin_nontemporal_load(xr + 64 * k); }
            float ss = (F.lane < 32) ? F.SSP[(size_t)m * 32 + F.lane] : 0.f;
            ss = wave_sum(ss);
            const float rstd = 1.0f / sqrtf(ss * (1.f / DM) + NORM_EPS);
#pragma unroll
            for (int k = 0; k < 8; ++k) { const f32x4 ov = (f32x4){bflo(ow[k].x), bfhi(ow[k].x), bflo(ow[k].y), bfhi(ow[k].y)};
                __builtin_nontemporal_store(xv[k] + ov * rstd * gq[k], outr + 64 * k); }
        }
    }
}

struct Args { const float* in[22]; float* out; unsigned char* ws; int ph_lo, ph_hi, li, pad; };
constexpr int N_PHASES = 9;
__global__ void __launch_bounds__(NTHREADS, 2) mk_fwd(Args args) {
    extern __shared__ __attribute__((aligned(16))) unsigned char lds[];
    Frame F;
    F.lds = (LAS unsigned char*)lds;
    F.tid = threadIdx.x; F.lane = F.tid & 63; F.wave = __builtin_amdgcn_readfirstlane(F.tid >> 6);
    F.G = gridDim.x; F.bid = blockIdx.x;
    unsigned char* ws = args.ws;
    F.x = args.in[0]; F.pre_g = args.in[1]; F.post_g = args.in[2]; F.w_in = args.in[3]; F.mu_rkv = args.in[4]; F.mu_wa = args.in[5]; F.w0 = args.in[6]; F.w1 = args.in[7]; F.w2 = args.in[8];
    F.a0 = args.in[9]; F.a1 = args.in[10]; F.a2 = args.in[11]; F.k_k = args.in[12]; F.k_a = args.in[13]; F.r_k = args.in[14]; F.lnx_g = args.in[15]; F.lnx_b = args.in[16]; F.rel_bias = args.in[17]; F.BT = (float*)(ws + WS_BT);
    F.w_br = args.in[18]; F.w_ba = args.in[19]; F.b_merge = args.in[20]; F.w_out = args.in[21]; F.out = args.out;
    F.HB = (bf16_t*)((unsigned char*)args.out + DO_HB); F.WIN_T = (bf16_t*)((unsigned char*)args.out + DO_WIN); F.STATES = (bf16_t*)((unsigned char*)args.out + DO_STATES);
    F.MD = (bf16_t*)((unsigned char*)args.out + DO_MD); F.ND = (bf16_t*)((unsigned char*)args.out + DO_ND); F.QD = (bf16_t*)((unsigned char*)args.out + DO_QD);
    F.WCAT_T = (bf16_t*)(ws + WS_WCAT); F.WOUT_T = (bf16_t*)(ws + WS_WOUT); F.W2T = (bf16_t*)(ws + WS_W2T); F.A2T = F.W2T + DBR * 64;
    F.BONUS = (float*)(ws + WS_BONUS); F.SSP = (float*)(ws + WS_SSP); F.PL = (bf16_t*)(ws + WS_PLS); F.PG = (bf16_t*)(ws + WS_PG); F.PA = (bf16_t*)(ws + WS_PA);
    F.MERGED = (bf16_t*)(ws + WS_MERGED); F.YCAT = (bf16_t*)(ws + WS_YCAT); F.OBF = (bf16_t*)(ws + WS_OBF); F.queue = (unsigned*)(ws + WS_CTL) + 65536;
    for (int u = F.tid; u < (LDS_BYTES - LDSCTL_OFF) / 4; u += NTHREADS) ((LAS unsigned*)(F.lds + LDSCTL_OFF))[u] = 0u;
    __syncthreads();
    const int lo = args.ph_lo, hi = args.ph_hi;
    XcdBarrier bar; bar.bar = (unsigned*)(ws + WS_CTL) + CW_BAR; bar.x = 0; bar.st = nullptr;
    if (hi - lo > 1) bar = xcd_barrier_post((unsigned*)(ws + WS_CTL) + CW_BAR, (volatile LAS unsigned*)(F.lds + MISC_OFF) + 8);
#define IN(k) (lo <= (k) && (k) < hi)
#define SEAM(k) do { if (IN(k) && IN((k) + 1)) xcd_barrier(bar); } while (0)
#define PHASE(k, ...) do { if (IN(k)) { __VA_ARGS__; SEAM(k); if (PROBE_REP == (k)) { __VA_ARGS__; xcd_barrier(bar); } } } while (0)
    PHASE(0, p0_prologue(F));
    PHASE(1, {
        pg8::Gemm g{F.HB, F.WIN_T, M, NIN, DM}; pg8::SplitOrder S; S.so.init(M, NPA + NPG, F.G, F.bid, DM, WGM_P1); S.extra_pn = (NPA + NPG) / 256;
        LAS float* bml = (LAS float*)(F.lds + RING_BYTES);
        for (int i = F.tid; i < 2 * DM / 4; i += NTHREADS) ((LAS f32x4*)bml)[i] = ((const f32x4*)F.b_merge)[i] * -1.4426950408889634f;
        __syncthreads();
        EpiIn E{F.PA, F.PG, F.PL, bml};
        pg8::gemm_phase<EpiIn, pg8::SplitOrder, P1_ALIGN, P1_SP2>(F.lds, g, S, E);
    });
    PHASE(3, p3_prep(F));
    PHASE(4, { p4_scan(F); p2_attention(F); });
    PHASE(5, p5_out(F));
    PHASE(6, {
        pg8::Gemm g{F.YCAT, F.WCAT_T, 2 * M, 2 * DM, DBR}; pg8::PairOrder S; S.so.init(M, DM, F.G, F.bid, DBR, WGM_P6); S.dpm = M / 256; S.dpn = DM / 256;
        EpiBranch E{F.PG, F.MERGED};
        pg8::gemm_phase<EpiBranch, pg8::PairOrder, true, true>(F.lds, g, S, E);
    });
    PHASE(7, {
        pg8::Gemm g{F.MERGED, F.WOUT_T, M, DM, DM}; pg8::StaticOrder S; S.init(M, DM, F.G, F.bid, DM, WGM_P7);
        EpiOut E{F.OBF, F.SSP};
        pg8::gemm_phase<EpiOut, pg8::StaticOrder, true, true>(F.lds, g, S, E);
    });
    if (IN(8)) { p8_final(F); }
#undef PHASE
#undef IN
#undef SEAM
}

extern "C" void kernel_launch(void* const* d_in, const int* in_sizes, int n_in, void* d_out, int out_size, void* d_ws, size_t ws_size, hipStream_t stream) {
    static int grid = 0;
    if (grid == 0) {
        if (n_in != 22 || in_sizes[0] != M * DM || out_size != M * DM || ws_size < WS_END) { fprintf(stderr, "kernel_launch: unexpected shapes (n_in %d in0 %d out %d ws %zu); nothing launched\n", n_in, n_in > 0 ? in_sizes[0] : -1, out_size, ws_size); grid = -1; return; }
        int dev = 0, cus = 0;
        if (hipGetDevice(&dev) != hipSuccess || hipDeviceGetAttribute(&cus, hipDeviceAttributeMultiprocessorCount, dev) != hipSuccess) { fprintf(stderr, "kernel_launch: device query failed\n"); grid = -1; return; }
        if (hipFuncSetAttribute((const void*)mk_fwd, hipFuncAttributeMaxDynamicSharedMemorySize, LDS_BYTES) != hipSuccess) { fprintf(stderr, "kernel_launch: hipFuncSetAttribute failed\n"); grid = -1; return; }
        int per_cu = 0;
        if (hipOccupancyMaxActiveBlocksPerMultiprocessor(&per_cu, (const void*)mk_fwd, NTHREADS, LDS_BYTES) != hipSuccess || per_cu < 1) fprintf(stderr, "kernel_launch: note: occupancy query reports %d blocks per CU\n", per_cu);
        (void)hipGetLastError();
        grid = cus > 256 ? 256 : cus;
        if (grid != 256) { fprintf(stderr, "kernel_launch: this build needs a 256-CU device (got %d); nothing launched\n", cus); grid = -1; return; }
    }
    if (grid < 0) return;
    (void)hipMemsetAsync((char*)d_ws + WS_CTL, 0, CTL_ZERO_BYTES, stream);
    Args a{};
    for (int i = 0; i < 22; ++i) a.in[i] = (const float*)d_in[i];
    a.out = (float*)d_out; a.ws = (unsigned char*)d_ws;
#if MK_N_LAUNCHES == 1
    a.ph_lo = 0; a.ph_hi = N_PHASES; a.li = 0;
    hipLaunchKernelGGL(mk_fwd, dim3(grid), dim3(NTHREADS), LDS_BYTES, stream, a);
#else
    for (int li = 0; li < N_PHASES; ++li) { a.ph_lo = li; a.ph_hi = li + 1; a.li = li; hipLaunchKernelGGL(mk_fwd, dim3(grid), dim3(NTHREADS), LDS_BYTES, stream, a); }
#endif
}
```
